# Optimizing an MI355X kernel written in HIP

```python
import jax, jax.numpy as jnp
from jax import lax
import numpy as np

D_MODEL = 1024
BATCH = 2
SEQ = 8192
DEPTH = 2

GRID_W = 64
CTX_LEN = 256
HEAD_DIM = 64
ROPE_THETA = 10000.0
RMS_EPS = 1e-6
GN_EPS = 1e-5
A_HEADS = 8
A_KV_HEADS = 2
Q_BLOCK = 128
POOL_WINDOWS = (2, 4, 8, 16)
B_GROUP_WIDTH = 128
B_WIDTH = 512
C_HEADS = 4
C_QK_DIM = 64
C_V_DIM = 128
RET_CHUNK = 128
D_HEADS = 8
D_KV_HEADS = 2
WINDOW = 128
BAND_BLOCK = 128
N_EXPERTS = 16
EC_CAPACITY_FACTOR = 2
D_EXPERT = 2 * D_MODEL

AB_LAYOUT = (("a_q", A_HEADS * HEAD_DIM), ("a_k", A_KV_HEADS * HEAD_DIM), ("a_v", A_KV_HEADS * HEAD_DIM), ("b_u", B_WIDTH))
CD_LAYOUT = (("c_q", C_HEADS * C_QK_DIM), ("c_k", C_HEADS * C_QK_DIM), ("c_v", C_HEADS * C_V_DIM), ("c_g", C_HEADS * C_V_DIM),
             ("d_q", D_HEADS * HEAD_DIM), ("d_k", D_KV_HEADS * HEAD_DIM), ("d_v", D_KV_HEADS * HEAD_DIM))
AB_IN = 1280
CD_IN = 2304
AB_OUT = A_HEADS * HEAD_DIM + B_WIDTH
CD_OUT = C_HEADS * C_V_DIM + D_HEADS * HEAD_DIM
N_EVEN = (DEPTH + 1) // 2
N_ODD = DEPTH // 2

kernel_name = "hybrid_dit_attn_pool_retention_swa_ecmoe"

F32 = jnp.float32


def rms_norm(x, g):
    xf = x.astype(F32)
    y = xf * lax.rsqrt(jnp.mean(xf * xf, axis=-1, keepdims=True) + RMS_EPS)
    return (y * g.astype(F32)).astype(x.dtype)


def modulate(x, g, shift, scale):
    return rms_norm(x, g) * (1 + scale) + shift


def axial_rope_tables(rows):
    row = jnp.repeat(jnp.arange(rows, dtype=F32), GRID_W)
    col = jnp.tile(jnp.arange(GRID_W, dtype=F32), rows)
    n_freq = HEAD_DIM // 4
    freqs = ROPE_THETA ** (-jnp.arange(n_freq, dtype=F32) / n_freq)
    ang = jnp.concatenate([row[:, None] * freqs, col[:, None] * freqs], axis=-1)
    return jnp.cos(ang), jnp.sin(ang)


def apply_rope(x, cos, sin):
    xf = x.astype(F32)
    half = x.shape[-1] // 2
    x1, x2 = xf[..., :half], xf[..., half:]
    cs, sn = cos[None, :, None, :], sin[None, :, None, :]
    return jnp.concatenate([x1 * cs - x2 * sn, x1 * sn + x2 * cs], axis=-1).astype(x.dtype)


def project(h, w, layout, names):
    offsets, o = {}, 0
    for name, width in layout:
        offsets[name] = (o, o + width)
        o += width
    if tuple(names) == tuple(nm for nm, _ in layout):
        y = h @ w
    else:
        y = h @ jnp.concatenate([w[:, offsets[nm][0]:offsets[nm][1]] for nm in names], axis=1)
    sizes = [offsets[nm][1] - offsets[nm][0] for nm in names]
    cuts = [int(s) for s in np.cumsum(sizes)[:-1]]
    return dict(zip(names, jnp.split(y, cuts, axis=-1)))


def gqa_attend(q, k, v):
    s = jnp.einsum('bqkgd,bskd->bkgqs', q, k, preferred_element_type=F32) * (q.shape[-1] ** -0.5)
    p = jax.nn.softmax(s, axis=-1).astype(v.dtype)
    return jnp.einsum('bkgqs,bskd->bqkgd', p, v)


def softmax_with_sink(s, sink):
    sk = jnp.broadcast_to(sink.astype(F32)[:, :, None, None], s.shape[:-1] + (1,))
    return jax.nn.softmax(jnp.concatenate([s, sk], axis=-1), axis=-1)[..., :-1]


def multiscale_pool(u, group_w, scale):
    B, L, _ = u.shape
    ng = len(POOL_WINDOWS)
    uf = u.astype(F32).reshape(B, L, ng, B_GROUP_WIDTH)
    cs = jnp.concatenate([jnp.zeros((B, 1, ng, B_GROUP_WIDTH), F32), jnp.cumsum(uf, axis=1)], axis=1)
    win = jnp.array(POOL_WINDOWS, dtype=jnp.int32)
    t = jnp.arange(L, dtype=jnp.int32)[:, None]
    lo = jnp.clip(t - win // 2, 0, L)
    hi = jnp.clip(t - win // 2 + win, 0, L)
    g_idx = jnp.arange(ng)[None, :]
    mean = (cs[:, hi, g_idx] - cs[:, lo, g_idx]) / (hi - lo).astype(F32)[None, :, :, None]
    y = jnp.einsum('blgc,gcd->blgd', mean - uf, group_w.astype(F32))
    return (y.reshape(B, L, ng * B_GROUP_WIDTH) * scale.astype(F32)).astype(u.dtype)


def retention_log_decay(e):
    return jnp.log1p(-jnp.exp2(-e.astype(F32)))


def retention_chunkwise(q, k, v, lg, r0, inclusive):
    B, L, H, _ = q.shape
    dv = v.shape[-1]
    T = RET_CHUNK
    N = L // T

    def chunks(a):
        return a.reshape(B, N, T, H, a.shape[-1]).transpose(1, 0, 3, 2, 4)

    pos = jnp.arange(T, dtype=F32)
    diff = pos[:, None] - pos[None, :]
    mask = (diff >= 0) if inclusive else (diff > 0)
    dmat = jnp.where(mask[None], jnp.exp(lg[:, None, None] * jnp.maximum(diff, 0.0)[None]), 0.0)
    xi = jnp.exp(lg[:, None] * (pos + 1.0))[None, :, :, None]
    zeta = jnp.exp(lg[:, None] * (T - 1.0 - pos))[None, :, :, None]
    chunk_decay = jnp.exp(lg * T)[None, :, None, None]

    def step(r, inp):
        qi, ki, vi = inp
        inner = jnp.einsum('bhtd,bhsd->bhts', qi, ki) * dmat
        o = jnp.einsum('bhts,bhsv->bhtv', inner, vi) + jnp.einsum('bhtd,bhdv->bhtv', qi, r) * xi
        r = r * chunk_decay + jnp.einsum('bhsd,bhsv->bhdv', ki * zeta, vi)
        return r, o

    r, o = lax.scan(step, r0, (chunks(q), chunks(k), chunks(v)))
    return o.transpose(1, 0, 3, 2, 4).reshape(B, L, H, dv), r


def retention_final_state(k, v, lg):
    L = k.shape[1]
    w = jnp.exp(lg[None, :] * (L - 1.0 - jnp.arange(L, dtype=F32)[:, None]))
    return jnp.einsum('blhd,blhv->bhdv', k * w[None, :, :, None], v)


def bidir_retention(q, k, v, lg_f, lg_b, r_f0, r_b0):
    o_f, r_f = retention_chunkwise(q, k, v, lg_f, r_f0, True)
    o_b, r_b = retention_chunkwise(q[:, ::-1], k[:, ::-1], v[:, ::-1], lg_b, r_b0, False)
    return o_f + o_b[:, ::-1], r_f, r_b


def retention_output(o, gn_g, gate):
    B, L, H, dv = o.shape
    mu = jnp.mean(o, axis=-1, keepdims=True)
    var = jnp.mean(jnp.square(o - mu), axis=-1, keepdims=True)
    y = ((o - mu) * lax.rsqrt(var + GN_EPS)).reshape(B, L, H * dv) * gn_g.astype(F32)
    return (jax.nn.silu(gate.astype(F32)) * y).astype(gate.dtype)


def window_sink_attention(q, k, v, kc, vc, sink):
    B, n, KV, G, d = q.shape
    WB = BAND_BLOCK
    NB = n // WB
    scale = d ** -0.5
    pad = ((0, 0), (WB, WB), (0, 0), (0, 0))
    kp = jnp.pad(k, pad).reshape(B, NB + 2, WB, KV, d)
    vp = jnp.pad(v, pad).reshape(B, NB + 2, WB, KV, d)
    kb = jnp.concatenate([kp[:, :-2], kp[:, 1:-1], kp[:, 2:]], axis=2)
    vb = jnp.concatenate([vp[:, :-2], vp[:, 1:-1], vp[:, 2:]], axis=2)
    qb = q.reshape(B, NB, WB, KV, G, d)
    s_loc = jnp.einsum('bnqkgd,bnskd->bnkgqs', qb, kb, preferred_element_type=F32) * scale
    blk = jnp.arange(NB)[:, None]
    qpos = blk * WB + jnp.arange(WB)[None, :]
    kpos = blk * WB - WB + jnp.arange(3 * WB)[None, :]
    valid = ((jnp.abs(qpos[:, :, None] - kpos[:, None, :]) <= WINDOW)
             & (kpos[:, None, :] >= 0) & (kpos[:, None, :] < n))
    s_loc = jnp.where(valid[None, :, None, None], s_loc, -jnp.inf)
    s_ctx = jnp.einsum('bnqkgd,bckd->bnkgqc', qb, kc, preferred_element_type=F32) * scale
    p = softmax_with_sink(jnp.concatenate([s_loc, s_ctx], axis=-1), sink).astype(v.dtype)
    p_loc, p_ctx = p[..., :3 * WB], p[..., 3 * WB:]
    o = (jnp.einsum('bnkgqs,bnskd->bnqkgd', p_loc, vb)
         + jnp.einsum('bnkgqc,bckd->bnqkgd', p_ctx, vc))
    return o.reshape(B, n, KV * G * d)


def mixer_attn_pool(h, hc, w_in, w_out, q_g, k_g, pool_w, pool_scale, cos, sin, ctx_out):
    B, n, _ = h.shape
    Lc = hc.shape[1]
    G = A_HEADS // A_KV_HEADS
    all_names = [nm for nm, _ in AB_LAYOUT]
    p = project(h, w_in, AB_LAYOUT, all_names)
    pc = project(hc, w_in, AB_LAYOUT, all_names if ctx_out else ["a_k", "a_v"])
    q = apply_rope(rms_norm(p["a_q"].reshape(B, n, A_HEADS, HEAD_DIM), q_g), cos, sin)
    q = q.reshape(B, n, A_KV_HEADS, G, HEAD_DIM)
    k = apply_rope(rms_norm(p["a_k"].reshape(B, n, A_KV_HEADS, HEAD_DIM), k_g), cos, sin)
    v = p["a_v"].reshape(B, n, A_KV_HEADS, HEAD_DIM)
    kc = rms_norm(pc["a_k"].reshape(B, Lc, A_KV_HEADS, HEAD_DIM), k_g)
    vc = pc["a_v"].reshape(B, Lc, A_KV_HEADS, HEAD_DIM)
    k_all = jnp.concatenate([kc, k], axis=1)
    v_all = jnp.concatenate([vc, v], axis=1)
    qb = q.reshape(B, n // Q_BLOCK, Q_BLOCK, A_KV_HEADS, G, HEAD_DIM).transpose(1, 0, 2, 3, 4, 5)
    ob = lax.map(lambda qi: gqa_attend(qi, k_all, v_all), qb)
    a = ob.transpose(1, 0, 2, 3, 4, 5).reshape(B, n, A_HEADS * HEAD_DIM)
    b = multiscale_pool(p["b_u"], pool_w, pool_scale)
    out = jnp.concatenate([a, b], axis=-1) @ w_out
    if not ctx_out:
        return out, None
    qc = rms_norm(pc["a_q"].reshape(B, Lc, A_KV_HEADS, G, HEAD_DIM), q_g)
    ac = gqa_attend(qc, kc, vc).reshape(B, Lc, A_HEADS * HEAD_DIM)
    bc = multiscale_pool(pc["b_u"], pool_w, pool_scale)
    out_c = jnp.concatenate([ac, bc], axis=-1) @ w_out
    return out, out_c


def mixer_retention_window(h, hc, w_in, w_out, e_f, e_b, gn_g, sink, cos, sin, ctx_out):
    B, n, _ = h.shape
    Lc = hc.shape[1]
    G = D_HEADS // D_KV_HEADS
    all_names = [nm for nm, _ in CD_LAYOUT]
    p = project(h, w_in, CD_LAYOUT, all_names)
    pc = project(hc, w_in, CD_LAYOUT, all_names if ctx_out else ["c_k", "c_v", "d_k", "d_v"])
    lg_f = retention_log_decay(e_f)
    lg_b = retention_log_decay(e_b)
    k_scale = C_QK_DIM ** -0.5
    kc_r = pc["c_k"].reshape(B, Lc, C_HEADS, C_QK_DIM).astype(F32) * k_scale
    vc_r = pc["c_v"].reshape(B, Lc, C_HEADS, C_V_DIM).astype(F32)
    if ctx_out:
        zero = jnp.zeros((B, C_HEADS, C_QK_DIM, C_V_DIM), F32)
        qc_r = pc["c_q"].reshape(B, Lc, C_HEADS, C_QK_DIM).astype(F32)
        oc_r, rf_ctx, rb_ctx = bidir_retention(qc_r, kc_r, vc_r, lg_f, lg_b, zero, zero)
    else:
        rf_ctx = retention_final_state(kc_r, vc_r, lg_f)
        rb_ctx = retention_final_state(kc_r[:, ::-1], vc_r[:, ::-1], lg_b)
    q_r = apply_rope(p["c_q"].reshape(B, n, C_HEADS, C_QK_DIM), cos, sin).astype(F32)
    k_r = apply_rope(p["c_k"].reshape(B, n, C_HEADS, C_QK_DIM), cos, sin).astype(F32) * k_scale
    v_r = p["c_v"].reshape(B, n, C_HEADS, C_V_DIM).astype(F32)
    o_r, _, _ = bidir_retention(q_r, k_r, v_r, lg_f, lg_b, rf_ctx, rb_ctx)
    c_out = retention_output(o_r, gn_g, p["c_g"])
    sink_g = sink.reshape(D_KV_HEADS, G)
    qd = apply_rope(p["d_q"].reshape(B, n, D_HEADS, HEAD_DIM), cos, sin).reshape(B, n, D_KV_HEADS, G, HEAD_DIM)
    kd = apply_rope(p["d_k"].reshape(B, n, D_KV_HEADS, HEAD_DIM), cos, sin)
    vd = p["d_v"].reshape(B, n, D_KV_HEADS, HEAD_DIM)
    kdc = pc["d_k"].reshape(B, Lc, D_KV_HEADS, HEAD_DIM)
    vdc = pc["d_v"].reshape(B, Lc, D_KV_HEADS, HEAD_DIM)
    d_out = window_sink_attention(qd, kd, vd, kdc, vdc, sink_g)
    out = jnp.concatenate([c_out, d_out], axis=-1) @ w_out
    if not ctx_out:
        return out, None
    c_out_c = retention_output(oc_r, gn_g, pc["c_g"])
    qdc = pc["d_q"].reshape(B, Lc, D_KV_HEADS, G, HEAD_DIM)
    s = jnp.einsum('bqkgd,bskd->bkgqs', qdc, kdc, preferred_element_type=F32) * (HEAD_DIM ** -0.5)
    pcx = softmax_with_sink(s, sink_g).astype(vdc.dtype)
    d_out_c = jnp.einsum('bkgqs,bskd->bqkgd', pcx, vdc).reshape(B, Lc, D_HEADS * HEAD_DIM)
    out_c = jnp.concatenate([c_out_c, d_out_c], axis=-1) @ w_out
    return out, out_c


def expert_choice_ffn(h, router_w, w_gate, w_up, w_down):
    B, n, D = h.shape
    cap = EC_CAPACITY_FACTOR * n // N_EXPERTS
    aff = jax.nn.softmax(jnp.einsum('bnd,de->bne', h, router_w, preferred_element_type=F32), axis=-1)
    gate_vals, idx = lax.top_k(aff.transpose(0, 2, 1), cap)
    xs = jax.vmap(lambda hb, ib: hb[ib])(h, idx)
    a = jnp.einsum('becd,edf->becf', xs, w_gate)
    u = jnp.einsum('becd,edf->becf', xs, w_up)
    y = jnp.einsum('becf,efd->becd', jax.nn.silu(a) * u, w_down) * gate_vals[..., None].astype(h.dtype)
    return jax.vmap(lambda ib, yb: jnp.zeros((n, D), h.dtype).at[ib.reshape(-1)].add(yb.reshape(-1, D)))(idx, y)


def setup_inputs(seed: int = 0) -> dict:
    key = jax.random.key(seed)
    ks = jax.random.split(key, 32)
    nrm = jax.random.normal
    D = D_MODEL
    return {
        "x": nrm(ks[0], (BATCH, SEQ, D), F32),
        "c": nrm(ks[1], (BATCH, D), F32),
        "ctx": nrm(ks[2], (BATCH, CTX_LEN, D), F32),
        "c_ctx": nrm(ks[3], (D,), F32),
        "ada_w": nrm(ks[4], (DEPTH, D, 6 * D), F32) * D ** -0.5,
        "ada_b": nrm(ks[5], (DEPTH, 6 * D), F32) * 0.02,
        "norm_mix_g": 1.0 + 0.1 * nrm(ks[6], (DEPTH, D), F32),
        "norm_ffn_g": 1.0 + 0.1 * nrm(ks[7], (DEPTH, D), F32),
        "final_norm_g": 1.0 + 0.1 * nrm(ks[8], (D,), F32),
        "ab_w_in": nrm(ks[9], (N_EVEN, D, AB_IN), F32) * D ** -0.5,
        "ab_w_out": nrm(ks[10], (N_EVEN, AB_OUT, D), F32) * AB_OUT ** -0.5,
        "a_q_norm_g": 1.0 + 0.1 * nrm(ks[11], (N_EVEN, HEAD_DIM), F32),
        "a_k_norm_g": 1.0 + 0.1 * nrm(ks[12], (N_EVEN, HEAD_DIM), F32),
        "b_group_w": nrm(ks[13], (N_EVEN, len(POOL_WINDOWS), B_GROUP_WIDTH, B_GROUP_WIDTH), F32) * B_GROUP_WIDTH ** -0.5,
        "b_scale": 1.0 + 0.1 * nrm(ks[14], (N_EVEN, B_WIDTH), F32),
        "cd_w_in": nrm(ks[15], (N_ODD, D, CD_IN), F32) * D ** -0.5,
        "cd_w_out": nrm(ks[16], (N_ODD, CD_OUT, D), F32) * CD_OUT ** -0.5,
        "c_decay_fwd": 5.0 + jnp.arange(C_HEADS, dtype=F32)[None, :] + 0.1 * nrm(ks[17], (N_ODD, C_HEADS), F32),
        "c_decay_bwd": 5.0 + jnp.arange(C_HEADS, dtype=F32)[None, :] + 0.1 * nrm(ks[18], (N_ODD, C_HEADS), F32),
        "c_norm_g": 1.0 + 0.1 * nrm(ks[19], (N_ODD, C_HEADS * C_V_DIM), F32),
        "d_sink": 0.5 * nrm(ks[20], (N_ODD, D_HEADS), F32),
        "moe_router": nrm(ks[21], (DEPTH, D, N_EXPERTS), F32) * D ** -0.5,
        "moe_w_gate": nrm(ks[22], (DEPTH, N_EXPERTS, D, D_EXPERT), F32) * D ** -0.5,
        "moe_w_up": nrm(ks[23], (DEPTH, N_EXPERTS, D, D_EXPERT), F32) * D ** -0.5,
        "moe_w_down": nrm(ks[24], (DEPTH, N_EXPERTS, D_EXPERT, D), F32) * D_EXPERT ** -0.5,
    }


def reference(x, c, ctx, c_ctx, ada_w, ada_b, norm_mix_g, norm_ffn_g, final_norm_g,
              ab_w_in, ab_w_out, a_q_norm_g, a_k_norm_g, b_group_w, b_scale,
              cd_w_in, cd_w_out, c_decay_fwd, c_decay_bwd, c_norm_g, d_sink,
              moe_router, moe_w_gate, moe_w_up, moe_w_down):
    rows = x.shape[1] // GRID_W
    cos, sin = axial_rope_tables(rows)
    for i in range(DEPTH):
        last = i == DEPTH - 1
        mod = jnp.einsum('bd,de->be', jax.nn.silu(c), ada_w[i]) + ada_b[i]
        mod_c = jax.nn.silu(c_ctx) @ ada_w[i] + ada_b[i]
        sh1, sc1, g1, sh2, sc2, g2 = jnp.split(mod[:, None, :], 6, axis=-1)
        csh1, csc1, cg1, csh2, csc2, cg2 = jnp.split(mod_c[None, None, :], 6, axis=-1)
        h = modulate(x, norm_mix_g[i], sh1, sc1)
        hc = modulate(ctx, norm_mix_g[i], csh1, csc1)
        j = i // 2
        if i % 2 == 0:
            m, m_c = mixer_attn_pool(h, hc, ab_w_in[j], ab_w_out[j], a_q_norm_g[j], a_k_norm_g[j],
                                     b_group_w[j], b_scale[j], cos, sin, not last)
        else:
            m, m_c = mixer_retention_window(h, hc, cd_w_in[j], cd_w_out[j], c_decay_fwd[j], c_decay_bwd[j],
                                            c_norm_g[j], d_sink[j], cos, sin, not last)
        x = x + g1 * m
        x = x + g2 * expert_choice_ffn(modulate(x, norm_ffn_g[i], sh2, sc2),
                                       moe_router[i], moe_w_gate[i], moe_w_up[i], moe_w_down[i])
        if not last:
            ctx = ctx + cg1 * m_c
            ctx = ctx + cg2 * expert_choice_ffn(modulate(ctx, norm_ffn_g[i], csh2, csc2),
                                                moe_router[i], moe_w_gate[i], moe_w_up[i], moe_w_down[i])
    return rms_norm(x, final_norm_g)
```

```cpp
#include <hip/hip_runtime.h>
#include <hip/hip_bf16.h>
#include <cmath>
#include <cstdio>
#include <cstdint>
namespace pg8 {
#define PG8_LAS __attribute__((address_space(3)))
typedef unsigned short bf16_t;
typedef short bf16x8 __attribute__((ext_vector_type(8)));
typedef float f32x4 __attribute__((ext_vector_type(4)));
typedef unsigned u32x4 __attribute__((ext_vector_type(4)));
constexpr int BM = 256, BK = 64, HALF = 128, HTB = HALF * BK * 2  , STAGE_BYTES = 8 * HTB, NXCD = 8, WGM = 8;

__host__ __device__ __forceinline__ int lds_byte(int r, int c) { const int st = (r >> 4) * 2 + (c >> 5), rr = r & 15, cc = c & 31, ob = rr * 64 + cc * 2; return st * 1024 + (ob ^ (((ob >> 9) & 1) << 5)); }
__host__ __device__ __forceinline__ void stage_rc(int b, int& R, int& C) { const int st = b / 1024, sb = b % 1024, swz = sb ^ (((sb >> 9) & 1) << 5); R = (st >> 1) * 16 + swz / 64; C = (st & 1) * 32 + (swz % 64) / 2; }
__host__ __device__ __forceinline__ int perm32(int rho) { const int n = rho >> 4, i = rho & 15; return 8 * (i >> 2) + 4 * n + (i & 3); }

struct Unit { int pm, pn; };
struct Gemm { const bf16_t* A; const bf16_t* Bt; int M, N, K; };

struct StaticOrder {
    int nM, nN, nwg, G, c;
    __host__ __device__ void init(int M, int N, int G_, int c_) { nM = M / BM; nN = N / BM; nwg = nM * nN; G = G_; c = c_; }
    __host__ __device__ bool next(int i, Unit& u) const {
        const long L = (long)i * G + c; if (L >= nwg) return false;
        int wgid = (int)L; { const int q = nwg / NXCD, r = nwg % NXCD, xcd = wgid % NXCD, off = wgid / NXCD; wgid = (xcd < r ? xcd * (q + 1) : r * (q + 1) + (xcd - r) * q) + off; }
        const int nig = WGM * nN, gid = wgid / nig, fm = gid * WGM, gsz = (nM - fm) < WGM ? (nM - fm) : WGM;
        u.pm = fm + ((wgid % nig) % gsz); u.pn = (wgid % nig) / gsz; return true;
    }
    __device__ __forceinline__ void a_ready(const Unit&) const {}
    __device__ __forceinline__ void done(const Unit&) const {}
    __device__ __forceinline__ bool half(const Unit&) const { return false; }
};

__device__ __forceinline__ unsigned cvt_pk_bf16(float lo, float hi) { unsigned r; asm volatile("v_cvt_pk_bf16_f32 %0, %1, %2" : "=v"(r) : "v"(lo), "v"(hi)); return r; }
typedef float f32x2e __attribute__((ext_vector_type(2)));
typedef __bf16 bf16x2e __attribute__((ext_vector_type(2)));
__device__ __forceinline__ unsigned cvtpk_e(float lo, float hi) { f32x2e v = {lo, hi}; bf16x2e b = __builtin_convertvector(v, bf16x2e); return __builtin_bit_cast(unsigned, b); }
__device__ __forceinline__ u32x4 pack8(const f32x4 a, const f32x4 b) { u32x4 w; w.x = cvtpk_e(a[0], a[1]); w.y = cvtpk_e(a[2], a[3]); w.z = cvtpk_e(b[0], b[1]); w.w = cvtpk_e(b[2], b[3]); return w; }

struct EpiStoreBf16 {
    static constexpr bool PERM = true, AFTER_DRAIN = false;
    bf16_t* O; int ldc; int ocol0; const float* colscale;
    __device__ __forceinline__ void operator()(const f32x4 (&acc)[2][2][4][2], const Unit& u, int wr, int wc, int fr, int fq) const {
        const int row0 = u.pm * BM + wr * 64 + fr, col0 = u.pn * BM + wc * 32 + 8 * fq;
        f32x4 cs[2][2];
#pragma unroll
        for (int bj = 0; bj < 2; ++bj)
#pragma unroll
            for (int n = 0; n < 2; ++n) cs[bj][n] = colscale ? *(const f32x4*)(colscale + col0 + bj * HALF + 4 * n) : (f32x4){1.f, 1.f, 1.f, 1.f};
#pragma unroll
        for (int ai = 0; ai < 2; ++ai)
#pragma unroll
            for (int m = 0; m < 4; ++m) { bf16_t* rowp = O + (size_t)(row0 + ai * HALF + m * 16) * ldc + ocol0 + col0;
#pragma unroll
                for (int bj = 0; bj < 2; ++bj) *(u32x4*)(rowp + bj * HALF) = pack8(acc[ai][bj][m][0] * cs[bj][0], acc[ai][bj][m][1] * cs[bj][1]); }
    }
};

template <bool SRC_BF16> struct EpiResid {
    static constexpr bool PERM = false, AFTER_DRAIN = false;
    const void* xlat; const void* xctx; const float* modl; int chunk; bf16_t* out;
    typedef unsigned u32x2 __attribute__((ext_vector_type(2)));
    __device__ __forceinline__ void load_group(const float* srcf, const bf16_t* srch, size_t off, f32x4 (&xv)[2][2]) const {
#pragma unroll
        for (int bj = 0; bj < 2; ++bj)
#pragma unroll
            for (int n = 0; n < 2; ++n) {
                if (SRC_BF16) { const u32x2 w = __builtin_nontemporal_load((const u32x2*)(srch + off + bj * HALF + n * 16)); xv[bj][n] = (f32x4){__uint_as_float(w.x << 16), __uint_as_float(w.x & 0xffff0000u), __uint_as_float(w.y << 16), __uint_as_float(w.y & 0xffff0000u)}; }
                else xv[bj][n] = __builtin_nontemporal_load((const f32x4*)(srcf + off + bj * HALF + n * 16)); }
    }
    __device__ __forceinline__ void operator()(const f32x4 (&acc)[2][2][4][2], const Unit& u, int wr, int wc, int fr, int fq) const {
        const int pm = u.pm; const int mi = pm < 64 ? (pm >> 5) : 2;
        const float* g = modl + mi * 6144 + chunk * 1024;
        const size_t rowoff = pm < 64 ? (size_t)pm * 256 * 1024 : (size_t)(pm - 64) * 256 * 1024;
        const float* srcf = (const float*)(pm < 64 ? xlat : xctx) + (SRC_BF16 ? 0 : rowoff);
        const bf16_t* srch = (const bf16_t*)(pm < 64 ? xlat : xctx) + (SRC_BF16 ? rowoff : 0);
        bf16_t* dst = out + (size_t)pm * 256 * 1024;
        const int rl = wr * 64 + fr, col0 = u.pn * BM + wc * 32 + 4 * fq;
        f32x4 gv[2][2];
#pragma unroll
        for (int bj = 0; bj < 2; ++bj)
#pragma unroll
            for (int n = 0; n < 2; ++n) gv[bj][n] = *(const f32x4*)(g + col0 + bj * HALF + n * 16);
        f32x4 xa[2][2], xb[2][2];
        load_group(srcf, srch, (size_t)rl * 1024 + col0, xa);
#define EPIRESID_STEP(q, XC, XN) do { const int ai = (q) >> 2, m = (q) & 3; const size_t off = (size_t)(rl + ai * HALF + m * 16) * 1024 + col0; \
            if ((q) < 7) { const int ai2 = ((q) + 1) >> 2, m2 = ((q) + 1) & 3; load_group(srcf, srch, (size_t)(rl + ai2 * HALF + m2 * 16) * 1024 + col0, XN); } \
            _Pragma("unroll") for (int bj = 0; bj < 2; ++bj) _Pragma("unroll") for (int n = 0; n < 2; ++n) { const f32x4 o = XC[bj][n] + gv[bj][n] * acc[ai][bj][m][n]; \
                u32x2 ow; ow.x = cvtpk_e(o[0], o[1]); ow.y = cvtpk_e(o[2], o[3]); *(u32x2*)(dst + off + bj * HALF + n * 16) = ow; } } while (0)
        EPIRESID_STEP(0, xa, xb); EPIRESID_STEP(1, xb, xa); EPIRESID_STEP(2, xa, xb); EPIRESID_STEP(3, xb, xa);
        EPIRESID_STEP(4, xa, xb); EPIRESID_STEP(5, xb, xa); EPIRESID_STEP(6, xa, xb); EPIRESID_STEP(7, xb, xa);
#undef EPIRESID_STEP
    }
};

struct EpiSwiGLU {
    static constexpr bool PERM = true, AFTER_DRAIN = false;
    bf16_t* ACT;
    __device__ __forceinline__ void operator()(const f32x4 (&acc)[2][2][4][2], const Unit& u, int wr, int wc, int fr, int fq) const {
        const int row0 = u.pm * BM + wr * 64 + fr, col0 = (u.pn & 15) * 128 + wc * 32 + 8 * fq;
#pragma unroll
        for (int ai = 0; ai < 2; ++ai)
#pragma unroll
            for (int m = 0; m < 4; ++m) { bf16_t* rowp = ACT + (size_t)(row0 + ai * HALF + m * 16) * 2048 + col0;
                f32x4 r[2];
#pragma unroll
                for (int n = 0; n < 2; ++n)
#pragma unroll
                    for (int j = 0; j < 4; ++j) { const float a = acc[ai][0][m][n][j], up = acc[ai][1][m][n][j];
                        const float sg = a * __builtin_amdgcn_rcpf(1.0f + __builtin_amdgcn_exp2f(-1.4426950408889634f * a)); r[n][j] = sg * up; }
                *(u32x4*)rowp = pack8(r[0], r[1]); }
    }
};


__device__ __forceinline__ unsigned pk4_fp8(float a, float b, float c, float d) { unsigned w = 0u; w = __builtin_amdgcn_cvt_pk_fp8_f32(a, b, w, false); w = __builtin_amdgcn_cvt_pk_fp8_f32(c, d, w, true); return w; }
struct EpiSwiGLU8 {
    static constexpr bool PERM = true, AFTER_DRAIN = false;
    unsigned char* ACT; float winv;
    __device__ __forceinline__ void operator()(const f32x4 (&acc)[2][2][4][2], const Unit& u, int wr, int wc, int fr, int fq) const {
        const int row0 = u.pm * BM + wr * 64 + fr, col0 = (u.pn & 15) * 128 + wc * 32 + 8 * fq;
#pragma unroll
        for (int ai = 0; ai < 2; ++ai)
#pragma unroll
            for (int m = 0; m < 4; ++m) { unsigned char* rowp = ACT + (size_t)(row0 + ai * HALF + m * 16) * 2048 + col0;
                float r[8];
#pragma unroll
                for (int n = 0; n < 2; ++n)
#pragma unroll
                    for (int j = 0; j < 4; ++j) { const float a = acc[ai][0][m][n][j] * winv, up = acc[ai][1][m][n][j] * winv;
                        const float sg = a * __builtin_amdgcn_rcpf(1.0f + __builtin_amdgcn_exp2f(-1.4426950408889634f * a)); float v = sg * up; v = fminf(fmaxf(v, -448.f), 448.f); r[4 * n + j] = v; }
                typedef unsigned u32x2 __attribute__((ext_vector_type(2)));
                u32x2 w; w.x = pk4_fp8(r[0], r[1], r[2], r[3]); w.y = pk4_fp8(r[4], r[5], r[6], r[7]);
                *(u32x2*)rowp = w; }
    }
};

struct EpiDown {
    static constexpr bool PERM = true, AFTER_DRAIN = false;
    bf16_t* Y; const float* gatev; float winv;
    __device__ __forceinline__ void operator()(const f32x4 (&acc)[2][2][4][2], const Unit& u, int wr, int wc, int fr, int fq) const {
        const int row0 = u.pm * BM + wr * 64 + fr, col0 = (u.pn & 3) * 256 + wc * 32 + 8 * fq;
#pragma unroll
        for (int ai = 0; ai < 2; ++ai)
#pragma unroll
            for (int m = 0; m < 4; ++m) { const int row = row0 + ai * HALF + m * 16; const float gv = gatev[row] * winv; bf16_t* rowp = Y + (size_t)row * 1024 + col0;
#pragma unroll
                for (int bj = 0; bj < 2; ++bj) *(u32x4*)(rowp + bj * HALF) = pack8(acc[ai][bj][m][0] * gv, acc[ai][bj][m][1] * gv); }
    }
};

struct MoeOrder {
    int nMe, nNe, nwg, G, c;
    __device__ __forceinline__ void init(int nMe_, int nNe_, int nExp, int G_, int c_) { nMe = nMe_; nNe = nNe_; nwg = nMe_ * nNe_ * nExp; G = G_; c = c_; }
    __device__ __forceinline__ bool next(int i, Unit& u) const {
        const int L = i * G + c; if (L >= nwg) return false;
        const int per = nMe * nNe, e = L / per, r = L % per;
        u.pm = e * nMe + (r % nMe); u.pn = e * nNe + (r / nMe); return true;
    }
    __device__ __forceinline__ void a_ready(const Unit&) const {}
    __device__ __forceinline__ void done(const Unit&) const {}
    __device__ __forceinline__ bool half(const Unit& u) const { return nMe == 9 && (u.pm % 9) == 8; }
};
template <class Epi, class Sched, bool ALIGN_EPI = false, bool SP2 = false, bool FP8 = false, bool GATHER = false>
__device__ __forceinline__ void gemm_phase(PG8_LAS unsigned char* lds, const Gemm g, const Sched& S, const Epi& E, const PG8_LAS unsigned* gtab = nullptr) {
    static_assert(!GATHER || SP2, "GATHER is wired into the SP2 loop only");
    int tid_o = threadIdx.x; asm volatile("" : "+v"(tid_o) :: "memory");
    const int tid = tid_o, wid = __builtin_amdgcn_readfirstlane(tid >> 6), lane = tid & 63, wr = wid >> 2, wc = wid & 3, fr = lane & 15, fq = lane >> 4;
    const int K = g.K, nt = K / BK;
    unsigned voffA[2], voffB[2]; int rA[2]; unsigned cofA[2];
    unsigned vofC[2][2] = {{0u, 0u}, {0u, 0u}}, vofN[2][2] = {{0u, 0u}, {0u, 0u}};
#pragma unroll
    for (int i = 0; i < 2; ++i) { int R, C; stage_rc(tid * 16 + i * 8192, R, C); const int Rb = Epi::PERM ? ((R & ~31) + perm32(R & 31)) : R;
        voffA[i] = (unsigned)(R * K + C) * 2u; voffB[i] = (unsigned)(Rb * K + C) * 2u; rA[i] = R; cofA[i] = (unsigned)C * 2u; }
    const size_t kstep = (size_t)(BK * 2);
    const size_t hstep = (size_t)HALF * K * 2;
    const size_t tstep = 2 * hstep;
    const unsigned ldsw = (unsigned)wid * 1024u;
    const int aoff = lds_byte(wr * 64 + fr, fq * 8), boff = lds_byte(wc * 32 + fr, fq * 8);
#define PG8_SA(b, h) (((b) * 2 + (h)) * HTB)
#define PG8_SB(b, h) ((4 + (b) * 2 + (h)) * HTB)
#define PG8_STAGE(bufoff, gbase, voff) do { _Pragma("unroll") for (int _i = 0; _i < 2; ++_i) \
        __builtin_amdgcn_global_load_lds((const unsigned*)((const char*)(gbase) + (voff)[_i]), (PG8_LAS unsigned*)(lds + (bufoff) + ldsw + _i * 8192), 16, 0, 0); } while (0)
#define PG8_STAGE_A(bufoff, gbase, h, usenext) do { if constexpr (GATHER) { const unsigned vg_[2] = {(usenext) ? vofN[h][0] : vofC[h][0], (usenext) ? vofN[h][1] : vofC[h][1]}; PG8_STAGE(bufoff, gbase, vg_); } \
        else { PG8_STAGE(bufoff, (gbase) + (h) * hstep, voffA); } } while (0)
#define PG8_GTAB(dst, u_) do { _Pragma("unroll") for (int h_ = 0; h_ < 2; ++h_) _Pragma("unroll") for (int i_ = 0; i_ < 2; ++i_) dst[h_][i_] = gtab[(u_) * 256 + h_ * 128 + rA[i_]] + cofA[i_]; } while (0)
#define PG8_LDA(dst, b, h) do { if constexpr (FP8) { _Pragma("unroll") for (int m = 0; m < 4; ++m) { const v4i_ lo_ = *(const PG8_LAS v4i_*)(lds + PG8_SA(b, h) + aoff + m * 2048), hi_ = *(const PG8_LAS v4i_*)(lds + PG8_SA(b, h) + aoff + m * 2048 + 1024); dst##8[m] = __builtin_shufflevector(lo_, hi_, 0, 1, 2, 3, 4, 5, 6, 7); } } \
        else { _Pragma("unroll") for (int m = 0; m < 4; ++m) _Pragma("unroll") for (int k = 0; k < 2; ++k) dst[m][k] = *(const PG8_LAS bf16x8*)(lds + PG8_SA(b, h) + aoff + m * 2048 + k * 1024); } } while (0)
#define PG8_LDB(dst, b, h) do { if constexpr (FP8) { _Pragma("unroll") for (int n = 0; n < 2; ++n) { const v4i_ lo_ = *(const PG8_LAS v4i_*)(lds + PG8_SB(b, h) + boff + n * 2048), hi_ = *(const PG8_LAS v4i_*)(lds + PG8_SB(b, h) + boff + n * 2048 + 1024); dst##8[n] = __builtin_shufflevector(lo_, hi_, 0, 1, 2, 3, 4, 5, 6, 7); } } \
        else { _Pragma("unroll") for (int n = 0; n < 2; ++n) _Pragma("unroll") for (int k = 0; k < 2; ++k) dst[n][k] = *(const PG8_LAS bf16x8*)(lds + PG8_SB(b, h) + boff + n * 2048 + k * 1024); } } while (0)
#define PG8_MMA(ai, bj, At, Bt) do { __builtin_amdgcn_s_setprio(1); _Pragma("unroll") for (int m = 0; m < 4; ++m) _Pragma("unroll") for (int n = 0; n < 2; ++n) { \
        if constexpr (FP8) { asm volatile("v_mfma_f32_16x16x128_f8f6f4 %0, %1, %2, %0" : "+v"(acc[ai][bj][m][n]) : "v"(Bt##8[n]), "v"(At##8[m])); } \
        else { _Pragma("unroll") for (int k = 0; k < 2; ++k) acc[ai][bj][m][n] = __builtin_amdgcn_mfma_f32_16x16x32_bf16(Bt[n][k], At[m][k], acc[ai][bj][m][n], 0, 0, 0); } } \
        __builtin_amdgcn_s_setprio(0); } while (0)
#define PG8_WAIT_V(n) asm volatile("s_waitcnt vmcnt(" #n ")" ::: "memory")
#define PG8_WAIT_L(n) asm volatile("s_waitcnt lgkmcnt(" #n ")" ::: "memory")
#define PG8_BAR __builtin_amdgcn_s_barrier()
#define PG8_SCHED __builtin_amdgcn_sched_barrier(0)
    Unit cur, nxt; int ui = 0;
    if (!S.next(0, cur)) return;
    f32x4 acc[2][2][4][2];
#pragma unroll
    for (int a = 0; a < 2; ++a)
#pragma unroll
        for (int b = 0; b < 2; ++b)
#pragma unroll
            for (int m = 0; m < 4; ++m)
#pragma unroll
                for (int n = 0; n < 2; ++n) acc[a][b][m][n] = (f32x4){0.f, 0.f, 0.f, 0.f};
    typedef int v4i_ __attribute__((ext_vector_type(4))); typedef int v8i_ __attribute__((ext_vector_type(8)));
    bf16x8 At[4][2], B0[2][2], B1[2][2];
    v8i_ At8[4], B08[2], B18[2];
    const char* cA = (const char*)g.A + (GATHER ? (size_t)0 : (size_t)cur.pm * tstep); const char* cB = (const char*)g.Bt + (size_t)cur.pn * tstep;
    if constexpr (GATHER) PG8_GTAB(vofC, 0);
    S.a_ready(cur);
    if constexpr (SP2) {
        PG8_STAGE(PG8_SB(0, 0), cB, voffB); PG8_STAGE(PG8_SB(0, 1), cB + hstep, voffB); PG8_STAGE_A(PG8_SA(0, 0), cA, 0, false); PG8_STAGE_A(PG8_SA(0, 1), cA, 1, false);
        if (wr == 1) PG8_BAR;
        PG8_WAIT_V(2); PG8_BAR;
        PG8_STAGE(PG8_SB(1, 0), cB + kstep, voffB); PG8_STAGE_A(PG8_SA(1, 0), cA + kstep, 0, false); PG8_STAGE(PG8_SB(1, 1), cB + hstep + kstep, voffB);
        PG8_WAIT_V(6); PG8_BAR;
    } else {
        PG8_STAGE(PG8_SB(0, 0), cB, voffB); PG8_STAGE(PG8_SA(0, 0), cA, voffA); PG8_STAGE(PG8_SB(0, 1), cB + hstep, voffB); PG8_STAGE(PG8_SA(0, 1), cA + hstep, voffA);
        if (wr == 1) PG8_BAR;
        PG8_WAIT_V(4); PG8_BAR;
        PG8_STAGE(PG8_SB(1, 0), cB + kstep, voffB); PG8_STAGE(PG8_SA(1, 0), cA + kstep, voffA); PG8_STAGE(PG8_SB(1, 1), cB + hstep + kstep, voffB);
        PG8_WAIT_V(6); PG8_BAR;
    }
    bool halfu = S.half(cur);
    for (;;) {
        const bool has_next = S.next(ui + 1, nxt);
        if constexpr (GATHER) { if (has_next) PG8_GTAB(vofN, ui + 1); else { vofN[0][0] = vofC[0][0]; vofN[0][1] = vofC[0][1]; vofN[1][0] = vofC[1][0]; vofN[1][1] = vofC[1][1]; } }
        const char* nA = (has_next && !GATHER) ? (const char*)g.A + (size_t)nxt.pm * tstep : cA; const char* nB = has_next ? (const char*)g.Bt + (size_t)nxt.pn * tstep : cB;
        for (int t = 0; t < nt; t += 2) {
            const bool last = (t == nt - 2);
            const char* a1 = cA + (size_t)(t + 1) * kstep;
            const char* a2 = last ? nA : cA + (size_t)(t + 2) * kstep; const char* b2 = last ? nB : cB + (size_t)(t + 2) * kstep;
            const char* a3 = a2 + kstep; const char* b3 = b2 + kstep;
            if (last && has_next) S.a_ready(nxt);
            if constexpr (SP2) {
            PG8_LDB(B0, 0, 0); PG8_LDB(B1, 0, 1); PG8_SCHED; PG8_LDA(At, 0, 0); PG8_STAGE_A(PG8_SA(1, 1), a1, 1, false);
            PG8_WAIT_V(8); PG8_WAIT_L(0); PG8_BAR; if (!(halfu && wr == 1)) { PG8_MMA(0, 0, At, B0); PG8_MMA(0, 1, At, B1); } PG8_BAR; PG8_SCHED;
            PG8_LDA(At, 0, 1); PG8_STAGE(PG8_SB(0, 0), b2, voffB); PG8_STAGE(PG8_SB(0, 1), b2 + hstep, voffB); PG8_STAGE_A(PG8_SA(0, 0), a2, 0, last);
            PG8_WAIT_V(8); PG8_WAIT_L(0); PG8_BAR; if (!halfu) { PG8_MMA(1, 0, At, B0); PG8_MMA(1, 1, At, B1); } PG8_BAR; PG8_SCHED;
            PG8_LDB(B0, 1, 0); PG8_LDB(B1, 1, 1); PG8_SCHED; PG8_LDA(At, 1, 0); PG8_STAGE_A(PG8_SA(0, 1), a2, 1, last);
            PG8_WAIT_V(8); PG8_WAIT_L(0); PG8_BAR; if (!(halfu && wr == 1)) { PG8_MMA(0, 0, At, B0); PG8_MMA(0, 1, At, B1); } PG8_BAR; PG8_SCHED;
            PG8_LDA(At, 1, 1); PG8_STAGE(PG8_SB(1, 0), b3, voffB); PG8_STAGE(PG8_SB(1, 1), b3 + hstep, voffB); PG8_STAGE_A(PG8_SA(1, 0), a3, 0, last);
            PG8_WAIT_V(8); PG8_WAIT_L(0); PG8_BAR; if (!halfu) { PG8_MMA(1, 0, At, B0); PG8_MMA(1, 1, At, B1); } PG8_BAR; PG8_SCHED;
            } else {
            PG8_LDB(B0, 0, 0); PG8_SCHED; PG8_LDA(At, 0, 0); PG8_STAGE(PG8_SA(1, 1), a1 + hstep, voffA);
            PG8_WAIT_L(8); PG8_BAR; PG8_WAIT_L(0); PG8_MMA(0, 0, At, B0); PG8_BAR; PG8_SCHED;
            PG8_LDB(B1, 0, 1); PG8_STAGE(PG8_SB(0, 0), b2, voffB);
            PG8_BAR; PG8_WAIT_L(0); PG8_MMA(0, 1, At, B1); PG8_BAR;
            PG8_LDA(At, 0, 1); PG8_STAGE(PG8_SA(0, 0), a2, voffA);
            PG8_BAR; PG8_WAIT_L(0); PG8_MMA(1, 0, At, B0); PG8_BAR; PG8_SCHED;
            PG8_STAGE(PG8_SB(0, 1), b2 + hstep, voffB);
            PG8_WAIT_V(6); PG8_BAR; PG8_MMA(1, 1, At, B1); PG8_BAR;
            PG8_LDB(B0, 1, 0); PG8_SCHED; PG8_LDA(At, 1, 0); PG8_STAGE(PG8_SA(0, 1), a2 + hstep, voffA);
            PG8_WAIT_L(8); PG8_BAR; PG8_WAIT_L(0); PG8_MMA(0, 0, At, B0); PG8_BAR; PG8_SCHED;
            PG8_LDB(B1, 1, 1); PG8_STAGE(PG8_SB(1, 0), b3, voffB);
            PG8_BAR; PG8_WAIT_L(0); PG8_MMA(0, 1, At, B1); PG8_BAR;
            PG8_LDA(At, 1, 1); PG8_STAGE(PG8_SA(1, 0), a3, voffA);
            PG8_BAR; PG8_WAIT_L(0); PG8_MMA(1, 0, At, B0); PG8_BAR; PG8_SCHED;
            PG8_STAGE(PG8_SB(1, 1), b3 + hstep, voffB);
            PG8_WAIT_V(6); PG8_BAR; PG8_MMA(1, 1, At, B1); PG8_BAR;
            }
        }
        if constexpr (FP8) {
            asm volatile("s_nop 15\n\ts_nop 15" ::: "memory");
#pragma unroll
            for (int a = 0; a < 2; ++a)
#pragma unroll
                for (int b = 0; b < 2; ++b)
#pragma unroll
                    for (int m = 0; m < 4; ++m)
#pragma unroll
                        for (int n = 0; n < 2; ++n) asm volatile("" : "+v"(acc[a][b][m][n]));
        }
        if constexpr (ALIGN_EPI) { if (wr == 0) PG8_BAR; }
        if constexpr (!Epi::AFTER_DRAIN) { E(acc, cur, wr, wc, fr, fq); S.done(cur); }
        if (!has_next) break;
#pragma unroll
        for (int a = 0; a < 2; ++a)
#pragma unroll
            for (int b = 0; b < 2; ++b)
#pragma unroll
                for (int m = 0; m < 4; ++m)
#pragma unroll
                    for (int n = 0; n < 2; ++n) acc[a][b][m][n] = (f32x4){0.f, 0.f, 0.f, 0.f};
        cur = nxt; cA = nA; cB = nB; ++ui; halfu = S.half(cur);
        if constexpr (GATHER) { vofC[0][0] = vofN[0][0]; vofC[0][1] = vofN[0][1]; vofC[1][0] = vofN[1][0]; vofC[1][1] = vofN[1][1]; }
        if constexpr (ALIGN_EPI) { if (wr == 1) PG8_BAR; }
    }
    PG8_WAIT_V(0);
    if constexpr (!ALIGN_EPI) { if (wr == 0) PG8_BAR; }
    PG8_BAR;
    if constexpr (Epi::AFTER_DRAIN) { E.fused(acc, cur, wr, wc, fr, fq, lds, wid, lane); S.done(cur); }
#undef PG8_SA
#undef PG8_SB
#undef PG8_STAGE
#undef PG8_STAGE_A
#undef PG8_GTAB
#undef PG8_LDA
#undef PG8_LDB
#undef PG8_MMA
#undef PG8_WAIT_V
#undef PG8_WAIT_L
#undef PG8_BAR
#undef PG8_SCHED
}
}
namespace attn_body {
using bf16=__hip_bfloat16;
using bf16x8=__attribute__((ext_vector_type(8)))short;
using s16x4=__attribute__((ext_vector_type(4)))short;
using f32x16=__attribute__((ext_vector_type(16)))float;
using u32x4=__attribute__((ext_vector_type(4)))unsigned;
constexpr int D=64;
constexpr int NW=8,QBLK=32,QB=QBLK*NW,KVBLK=64;
constexpr int ATTN_UNIT_ROWS=QB;
__device__ __forceinline__ int crow(int r,int hi){return (r&3)+8*(r>>2)+4*hi;}
#define SBAR() __builtin_amdgcn_sched_barrier(0)
__device__ __forceinline__ void cmask(f32x16&p0,f32x16&p1,int jb,int qrel,int hi){
  const float NEG=-INFINITY; int kb=64*jb+4*hi;
  #pragma unroll
  for(int r=0;r<16;++r){int kv=kb+(r&3)+8*(r>>2); if(kv>qrel)p0[r]=NEG; if(kv+32>qrel)p1[r]=NEG;}
}

constexpr int NSLOT=3, SLOTB=8192;
constexpr int LDS_K=0, LDS_V=NSLOT*SLOTB, LDS_WS=2*NSLOT*SLOTB, LDS_OST=LDS_WS+NW*64*4, LDS_BYTES=LDS_OST+NW*4096;
constexpr float C2=0.125f*1.4426950408889634f;
__device__ __forceinline__ void glds16(const void*gsrc,unsigned lds_dst){unsigned keep;
  asm volatile("s_mov_b32 %0, m0\n\ts_mov_b32 m0, %2\n\ts_nop 0\n\tglobal_load_lds_dwordx4 %1, off\n\ts_mov_b32 m0, %0":"=&s"(keep):"v"(gsrc),"s"(lds_dst):"memory");}
__device__ __forceinline__ float max3f(float a,float b,float c){float r;asm("v_max3_f32 %0, %1, %2, %3":"=v"(r):"v"(a),"v"(b),"v"(c));return r;}
__device__ __forceinline__ float max2f(float a,float b){float r;asm("v_max_f32_e32 %0, %1, %2":"=v"(r):"v"(a),"v"(b));return r;}
__device__ __forceinline__ float fadd_s(float a,float b){float r;asm("v_add_f32_e32 %0, %1, %2":"=v"(r):"v"(a),"v"(b));return r;}
__device__ __forceinline__ float fsub_s(float a,float b){float r;asm("v_sub_f32_e32 %0, %1, %2":"=v"(r):"v"(a),"v"(b));return r;}
typedef float f32x2_t __attribute__((ext_vector_type(2))); typedef __bf16 bf16x2_t __attribute__((ext_vector_type(2)));
__device__ __forceinline__ unsigned cvtpk_s(float lo,float hi){f32x2_t v={lo,hi};bf16x2_t b=__builtin_convertvector(v,bf16x2_t);return __builtin_bit_cast(unsigned,b);}
#define WAIT_BAR(N) asm volatile("s_waitcnt vmcnt(" #N ") lgkmcnt(0)\n\ts_barrier":::"memory")

__device__ __forceinline__ void qkt(f32x16&p0,f32x16&p1,const char*Kslot,const bf16x8*qr,const f32x16&negm,int r32,int hi){
  const char*kb=Kslot+hi*1024+r32*16;
  #pragma unroll
  for(int d0=0;d0<4;++d0){
    const bf16x8 b0=*reinterpret_cast<const bf16x8*>(kb+d0*2048);
    const bf16x8 b1=*reinterpret_cast<const bf16x8*>(kb+d0*2048+512);
    if(d0==0){p0=__builtin_amdgcn_mfma_f32_32x32x16_bf16(b0,qr[0],negm,0,0,0);p1=__builtin_amdgcn_mfma_f32_32x32x16_bf16(b1,qr[0],negm,0,0,0);}
    else{p0=__builtin_amdgcn_mfma_f32_32x32x16_bf16(b0,qr[d0],p0,0,0,0);p1=__builtin_amdgcn_mfma_f32_32x32x16_bf16(b1,qr[d0],p1,0,0,0);}}
}
typedef __attribute__((address_space(3))) const char* lds_cptr;
typedef short v4i16_t __attribute__((ext_vector_type(4)));
__device__ __forceinline__ void kload8(bf16x8*kf,lds_cptr kp){
  kf[0]=*(const __attribute__((address_space(3))) bf16x8*)(kp);      kf[1]=*(const __attribute__((address_space(3))) bf16x8*)(kp+512);
  kf[2]=*(const __attribute__((address_space(3))) bf16x8*)(kp+2048); kf[3]=*(const __attribute__((address_space(3))) bf16x8*)(kp+2560);
  kf[4]=*(const __attribute__((address_space(3))) bf16x8*)(kp+4096); kf[5]=*(const __attribute__((address_space(3))) bf16x8*)(kp+4608);
  kf[6]=*(const __attribute__((address_space(3))) bf16x8*)(kp+6144); kf[7]=*(const __attribute__((address_space(3))) bf16x8*)(kp+6656);
}
__device__ __forceinline__ void kload2(bf16x8*kf,lds_cptr kp,int j){ kf[2*j]=*(const __attribute__((address_space(3))) bf16x8*)(kp+j*2048); kf[2*j+1]=*(const __attribute__((address_space(3))) bf16x8*)(kp+j*2048+512); }
__device__ __forceinline__ s16x4 vtr(lds_cptr p){ return __builtin_bit_cast(s16x4,__builtin_amdgcn_ds_read_tr16_b64_v4i16((__attribute__((address_space(3))) v4i16_t*)p)); }
__device__ __forceinline__ float rowmax(const f32x16&p0,const f32x16&p1){
  float a=max3f(p0[0],p0[1],p1[0]),b=max3f(p0[2],p0[3],p1[1]);a=max3f(a,p1[2],p1[3]);
  #pragma unroll
  for(int r=4;r<16;r+=4){a=max3f(a,p0[r],p0[r+1]);b=max3f(b,p0[r+2],p0[r+3]);a=max3f(a,p1[r],p1[r+1]);b=max3f(b,p1[r+2],p1[r+3]);}
  const float m=max2f(a,b);
  auto rr=__builtin_amdgcn_permlane32_swap(__float_as_uint(m),__float_as_uint(m),false,false);
  return max2f(__uint_as_float(rr[0]),__uint_as_float(rr[1]));
}
__device__ __forceinline__ void pv(f32x16*o,int vb,bf16x8 pa0,bf16x8 pa1,bf16x8 pa2,bf16x8 pa3){
  #pragma unroll
  for(int d0=0;d0<2;++d0){s16x4 lo[4],hi[4];
    #pragma unroll
    for(int ks=0;ks<4;++ks){
      asm volatile("ds_read_b64_tr_b16 %0,%1 offset:%c2":"=&v"(lo[ks]):"v"(vb),"i"(d0*4096+ks*1024):"memory");
      asm volatile("ds_read_b64_tr_b16 %0,%1 offset:%c2":"=&v"(hi[ks]):"v"(vb),"i"(d0*4096+ks*1024+512):"memory");}
    asm volatile("s_waitcnt lgkmcnt(0)":::"memory");SBAR();
    #define PK(k) (bf16x8){lo[k][0],lo[k][1],lo[k][2],lo[k][3],hi[k][0],hi[k][1],hi[k][2],hi[k][3]}
    o[d0]=__builtin_amdgcn_mfma_f32_32x32x16_bf16(pa0,PK(0),o[d0],0,0,0);
    o[d0]=__builtin_amdgcn_mfma_f32_32x32x16_bf16(pa1,PK(1),o[d0],0,0,0);
    o[d0]=__builtin_amdgcn_mfma_f32_32x32x16_bf16(pa2,PK(2),o[d0],0,0,0);
    o[d0]=__builtin_amdgcn_mfma_f32_32x32x16_bf16(pa3,PK(3),o[d0],0,0,0);
    #undef PK
  }
}

#ifndef ATTN_STORE16
#define ATTN_STORE16(p,v) (*(u32x4*)(p)=(v))
#endif
template<int THRL,bool WIN> __device__ __forceinline__ void attn_unit(const bf16*Qu,int QP,const bf16*__restrict__ Kh,const bf16*__restrict__ Vh,int KP,int NT,bf16*Ou,int OP,char*shm,int gap,int qpos0,float sinkl2){
  int tid=threadIdx.x; asm volatile("":"+v"(tid));
  const int lane=tid&63,r32=lane&31,hi=lane>>5; const int wid=__builtin_amdgcn_readfirstlane(tid>>6);
  const bf16*Qw=Qu+(long)(wid*QBLK)*QP;
  const unsigned lds0=(unsigned)(uintptr_t)shm;
  float*wsf=(float*)(shm+LDS_WS)+wid*64;
  const bf16*ksrc=Kh+(long)lane*KP+wid*8;
  const bf16*vsrc=Vh+(long)(16*(wid&3)+(lane>>2))*KP+(wid>>2)*32+(lane&3)*8;
  const unsigned kdst=lds0+LDS_K+wid*1024, vdst=lds0+LDS_V+wid*1024;
  #define KROW(t) ((long)(t)*KVBLK+((WIN&&(t)>=4)?(long)gap:0L))
  #define DMA_K(t,slot) glds16(ksrc+KROW(t)*KP,(unsigned)__builtin_amdgcn_readfirstlane(kdst+(slot)))
  #define DMA_V(t,slot) glds16(vsrc+KROW(t)*KP,(unsigned)__builtin_amdgcn_readfirstlane(vdst+(slot)))
  const int vb0=(int)(lds0+LDS_V)+((lane>>4)&1)*32+(lane&3)*8+(4*hi+((lane&15)>>2))*64;
  const char*Kbase=shm+LDS_K; bf16x8 kf[8];
  const lds_cptr shm3=(lds_cptr)shm; const lds_cptr kp0=shm3+LDS_K+hi*1024+r32*16; const lds_cptr vp0=shm3+LDS_V+((lane>>4)&1)*32+(lane&3)*8+(4*hi+((lane&15)>>2))*64;
  DMA_K(0,0);DMA_V(0,0);DMA_K(1,SLOTB);
  bf16x8 qr[4];
  #pragma unroll
  for(int d0=0;d0<4;++d0)qr[d0]=*reinterpret_cast<const bf16x8*>(&Qw[(long)r32*QP+d0*16+hi*8]);
  if(__builtin_amdgcn_readfirstlane(threadIdx.x)>=256)__builtin_amdgcn_s_setprio(1);
  float mhat=0.f;f32x16 o[2];o[0]=f32x16{};o[1]=f32x16{};f32x16 o2=f32x16{};f32x16 negm=f32x16{};asm volatile("":"+v"(negm));
  u32x4 onesw;asm volatile("v_mov_b32 %0, 0x3f803f80\n\tv_mov_b32 %1, 0x3f803f80\n\tv_mov_b32 %2, 0x3f803f80\n\tv_mov_b32 %3, 0x3f803f80":"=v"(onesw[0]),"=v"(onesw[1]),"=v"(onesw[2]),"=v"(onesw[3]));const bf16x8 ones=__builtin_bit_cast(bf16x8,onesw);
  const int qrel=wid*QBLK+r32;
  #define CMASK(P0,P1,t) do{ if(WIN&&(t)>=4){ const int kb_=gap+64*((t)-4)+4*hi-(qpos0+qrel); _Pragma("unroll") for(int r_=0;r_<16;++r_){ const int df_=kb_+(r_&3)+8*(r_>>2); if(df_>128||df_<-128)P0[r_]=-INFINITY; if(df_+32>128||df_+32<-128)P1[r_]=-INFINITY; } } }while(0)
  bool resc=false;
  #define START(P0,P1) do{ const float rm=rowmax(P0,P1); resc=false; \
    { const float dl=rm; mhat=fadd_s(mhat,dl); \
      _Pragma("unroll") for(int r=0;r<16;++r){P0[r]=fsub_s(P0[r],dl);P1[r]=fsub_s(P1[r],dl);} \
      _Pragma("unroll") for(int r=0;r<16;++r)negm[r]=-mhat; asm volatile("":"+v"(negm)); } \
    _Pragma("unroll") for(int r=0;r<16;++r)P0[r]=__builtin_amdgcn_exp2f(P0[r]); }while(0)
  #define RESC() do{ if(resc){ asm volatile("s_waitcnt lgkmcnt(0)":::"memory"); \
      _Pragma("unroll") for(int r=0;r<16;++r){const float f_=wsf[crow(r,hi)];o[0][r]*=f_;o[1][r]*=f_;o2[r]*=f_;} } }while(0)
  f32x16 pA0,pA1,pB0,pB1;
  int sl_prev=0,sl_cur=0,sl_next=SLOTB;
  #define ROT() do{sl_prev=sl_cur;sl_cur=sl_next;sl_next=(sl_next==(NSLOT-1)*SLOTB)?0:sl_next+SLOTB;}while(0)
  DMA_K(2,2*SLOTB);
  WAIT_BAR(3);
  qkt(pA0,pA1,Kbase,qr,negm,r32,hi);asm volatile("s_nop 15\n\ts_nop 7":"+v"(pA0),"+v"(pA1));CMASK(pA0,pA1,0);
  START(pA0,pA1);
  _Pragma("unroll") for(int r=0;r<16;++r)pA1[r]=__builtin_amdgcn_exp2f(pA1[r]);
  WAIT_BAR(0);
  DMA_K(3,0);DMA_V(1,SLOTB);
  ROT();
  kload8(kf,kp0+sl_cur);
  WAIT_BAR(2);
  s16x4 vlo[8],vhi[8]; u32x4 pw0,pw1,pw2,pw3;
  #define PKW(P,B) cvtpk_s(P[B],P[B+1])
  #define PAF(k) __builtin_bit_cast(bf16x8,pw##k)
  #define VFR(i) (bf16x8){vlo[i][0],vlo[i][1],vlo[i][2],vlo[i][3],vhi[i][0],vhi[i][1],vhi[i][2],vhi[i][3]}
  #define PIN(x) asm volatile("":"+v"(x))
  #define MX3(a,b,c) __builtin_fmaxf(__builtin_fmaxf((a),(b)),(c))
  #define GAPA(MF,A0,A1,A2,A3,W0,W1,PW) do{ MF; W0; W1; PIN(PW); SBAR(); }while(0)
  #define EX(v) __builtin_amdgcn_exp2f(v)
  #define GAPB(MF,X,B) do{ MF; X[B]=EX(X[B]); X[B+1]=EX(X[B+1]); X[B+2]=EX(X[B+2]); X[B+3]=EX(X[B+3]); PIN(X); SBAR(); }while(0)
  #define ONE(k) o2=__builtin_amdgcn_mfma_f32_32x32x16_bf16(PAF(k),ones,o2,0,0,0)
  #define VRD(i) do{ vlo[i]=vtr(vp_+(((i)>>2)*4096+((i)&3)*1024)); vhi[i]=vtr(vp_+(((i)>>2)*4096+((i)&3)*1024+512)); }while(0)
  #define KRD(G,j) do{ if(G){ kload2(kf,kp0+sl_next,j); SBAR(); } }while(0)
  #define STEP(C0,C1,P0,P1,t,GK,GV,GL) do{ SBAR(); \
    const lds_cptr vp_=vp0+sl_prev; \
    VRD(0); SBAR(); \
    GAPA(C0=__builtin_amdgcn_mfma_f32_32x32x16_bf16(kf[0],qr[0],negm,0,0,0), P0[2],P0[3],P0[4],P0[5],     pw0[0]=PKW(P0,0), pw0[1]=PKW(P0,2), pw0); \
    VRD(4); SBAR(); GAPA(C1=__builtin_amdgcn_mfma_f32_32x32x16_bf16(kf[1],qr[0],negm,0,0,0), P0[6],P0[7],P0[8],P0[9],     pw0[2]=PKW(P0,4), pw0[3]=PKW(P0,6), pw0); \
    VRD(1); SBAR(); GAPA(C0=__builtin_amdgcn_mfma_f32_32x32x16_bf16(kf[2],qr[1],C0,0,0,0),   P0[10],P0[11],P0[12],P0[13], pw1[0]=PKW(P0,8), pw1[1]=PKW(P0,10), pw1); \
    VRD(5); SBAR(); GAPA(C1=__builtin_amdgcn_mfma_f32_32x32x16_bf16(kf[3],qr[1],C1,0,0,0),   P0[14],P0[15],P1[0],P1[1],   pw1[2]=PKW(P0,12),pw1[3]=PKW(P0,14), pw1); \
    VRD(2); SBAR(); GAPA(C0=__builtin_amdgcn_mfma_f32_32x32x16_bf16(kf[4],qr[2],C0,0,0,0),   P1[2],P1[3],P1[4],P1[5],     pw2[0]=PKW(P1,0), pw2[1]=PKW(P1,2), pw2); \
    VRD(6); SBAR(); GAPA(C1=__builtin_amdgcn_mfma_f32_32x32x16_bf16(kf[5],qr[2],C1,0,0,0),   P1[6],P1[7],P1[8],P1[9],     pw2[2]=PKW(P1,4), pw2[3]=PKW(P1,6), pw2); \
    VRD(3); SBAR(); GAPA(C0=__builtin_amdgcn_mfma_f32_32x32x16_bf16(kf[6],qr[3],C0,0,0,0),   P1[10],P1[11],P1[12],P1[13], pw3[0]=PKW(P1,8), pw3[1]=PKW(P1,10), pw3); \
    VRD(7); SBAR(); GAPA(C1=__builtin_amdgcn_mfma_f32_32x32x16_bf16(kf[7],qr[3],C1,0,0,0),   P1[14],P1[15],0.f,0.f,       pw3[2]=PKW(P1,12),pw3[3]=PKW(P1,14), pw3); \
    if(GK){DMA_K((t)+3,sl_cur);} if(GV){DMA_V((t)+1,sl_next);} \
    CMASK(C0,C1,t); \
    { float a=MX3(C0[0],C0[1],C1[0]),b=MX3(C0[2],C0[3],C1[1]); a=MX3(a,C1[2],C1[3]); \
      _Pragma("unroll") for(int r=4;r<16;r+=4){a=MX3(a,C0[r],C0[r+1]);b=MX3(b,C0[r+2],C0[r+3]);a=MX3(a,C1[r],C1[r+1]);b=MX3(b,C1[r+2],C1[r+3]);} \
      float rm=__builtin_fmaxf(a,b); { auto rr=__builtin_amdgcn_permlane32_swap(__float_as_uint(rm),__float_as_uint(rm),false,false); rm=__builtin_fmaxf(__uint_as_float(rr[0]),__uint_as_float(rr[1])); } \
      resc=false; \
      if(__builtin_expect(__any(rm>(float)THRL),0)){ const float dl=__builtin_fmaxf(rm,0.f); mhat+=dl; \
        _Pragma("unroll") for(int r=0;r<16;++r){C0[r]-=dl;C1[r]-=dl;} \
        _Pragma("unroll") for(int r=0;r<16;++r)negm[r]=-mhat; asm volatile("":"+v"(negm)); \
        const float f=__builtin_amdgcn_exp2f(-dl); if(hi==0)wsf[r32]=f; resc=true; } } \
    SBAR(); \
    GAPB(o[0]=__builtin_amdgcn_mfma_f32_32x32x16_bf16(PAF(0),VFR(0),o[0],0,0,0), C0,0); \
    GAPB(o[1]=__builtin_amdgcn_mfma_f32_32x32x16_bf16(PAF(0),VFR(4),o[1],0,0,0);ONE(0), C0,4); \
    KRD(GL,0); GAPB(o[0]=__builtin_amdgcn_mfma_f32_32x32x16_bf16(PAF(1),VFR(1),o[0],0,0,0), C0,8); \
    KRD(GL,1); GAPB(o[1]=__builtin_amdgcn_mfma_f32_32x32x16_bf16(PAF(1),VFR(5),o[1],0,0,0);ONE(1), C0,12); \
    KRD(GL,2); GAPB(o[0]=__builtin_amdgcn_mfma_f32_32x32x16_bf16(PAF(2),VFR(2),o[0],0,0,0), C1,0); \
    KRD(GL,3); GAPB(o[1]=__builtin_amdgcn_mfma_f32_32x32x16_bf16(PAF(2),VFR(6),o[1],0,0,0);ONE(2), C1,4); \
    GAPB(o[0]=__builtin_amdgcn_mfma_f32_32x32x16_bf16(PAF(3),VFR(3),o[0],0,0,0), C1,8); \
    GAPB(o[1]=__builtin_amdgcn_mfma_f32_32x32x16_bf16(PAF(3),VFR(7),o[1],0,0,0);ONE(3), C1,12); \
    }while(0)
  int t=1;
  #undef CMASK
  #define CMASK(P0,P1,t) do{ if(WIN&&(t)>=4){ const int kb_=gap+64*((t)-4)+4*hi-(qpos0+qrel); _Pragma("unroll") for(int r_=0;r_<16;++r_){ const int df_=kb_+(r_&3)+8*(r_>>2); if(df_>128||df_<-128)P0[r_]=-INFINITY; if(df_+32>128||df_+32<-128)P1[r_]=-INFINITY; } } }while(0)
  for(;t+5<NT;t+=2){
    STEP(pB0,pB1,pA0,pA1,t,true,true,true);     WAIT_BAR(2); RESC(); ROT();
    STEP(pA0,pA1,pB0,pB1,t+1,true,true,true);   WAIT_BAR(2); RESC(); ROT();
  }
  #undef CMASK
  #define CMASK(P0,P1,t) do{ if(WIN&&(t)>=4){ const int kb_=gap+64*((t)-4)+4*hi-(qpos0+qrel); _Pragma("unroll") for(int r_=0;r_<16;++r_){ const int df_=kb_+(r_&3)+8*(r_>>2); if(df_>128||df_<-128)P0[r_]=-INFINITY; if(df_+32>128||df_+32<-128)P1[r_]=-INFINITY; } } }while(0)
  #define ENDW(tt) do{ if((tt)+3<NT){WAIT_BAR(2);} else if((tt)+2<NT){WAIT_BAR(1);} else {WAIT_BAR(0);} }while(0)
  for(;t+1<NT;t+=2){
    STEP(pB0,pB1,pA0,pA1,t,(t+3<NT),(t+1<NT),(t+1<NT));       ENDW(t);   RESC(); ROT();
    STEP(pA0,pA1,pB0,pB1,t+1,(t+4<NT),(t+2<NT),(t+2<NT));     ENDW(t+1); RESC(); ROT();
  }
  STEP(pB0,pB1,pA0,pA1,NT-1,false,false,false); RESC();
  { pw0=(u32x4){PKW(pB0,0),PKW(pB0,2),PKW(pB0,4),PKW(pB0,6)};pw1=(u32x4){PKW(pB0,8),PKW(pB0,10),PKW(pB0,12),PKW(pB0,14)};pw2=(u32x4){PKW(pB1,0),PKW(pB1,2),PKW(pB1,4),PKW(pB1,6)};pw3=(u32x4){PKW(pB1,8),PKW(pB1,10),PKW(pB1,12),PKW(pB1,14)};
    SBAR(); ONE(0);ONE(1);ONE(2);ONE(3); pv(o,vb0+sl_cur,PAF(0),PAF(1),PAF(2),PAF(3)); }
  #undef PKW
  #undef PAF
  #undef VFR
  #undef PIN
  #undef MX3
  #undef GAPA
  #undef GAPB
  #undef ONE
  #undef EX
  #undef VRD
  #undef KRD
  #undef STEP
  #undef ENDW
  float rli[16];
  if(WIN){ if(hi==0)wsf[32+r32]=__builtin_amdgcn_exp2f(sinkl2-mhat);asm volatile("s_waitcnt lgkmcnt(0)":::"memory");
    #pragma unroll
    for(int r=0;r<16;++r)rli[r]=__builtin_amdgcn_rcpf(o2[r]+wsf[32+crow(r,hi)]); }
  else{
    #pragma unroll
    for(int r=0;r<16;++r)rli[r]=__builtin_amdgcn_rcpf(o2[r]); }
  bf16*Ow=Ou+(long)(wid*QBLK)*OP;
  { bf16*stg=(bf16*)(shm+LDS_OST)+wid*2048;
    #pragma unroll
    for(int r=0;r<16;++r){const int orow=crow(r,hi);
      #pragma unroll
      for(int d0=0;d0<2;++d0)stg[orow*64+d0*32+r32]=__float2bfloat16(o[d0][r]*rli[r]);}
    asm volatile("s_waitcnt lgkmcnt(0)":::"memory");
    #pragma unroll
    for(int i=0;i<4;++i){const int row=i*8+(lane>>3),ch=lane&7; const u32x4 v=*(const u32x4*)(stg+row*64+ch*8); ATTN_STORE16(Ow+(long)row*OP+ch*8,v);} }
  asm volatile("s_waitcnt lgkmcnt(0)\n\ts_barrier":::"memory");
  __builtin_amdgcn_s_setprio(0);
  #undef DMA_K
  #undef KROW
  #undef DMA_V
  #undef CMASK
  #undef START
  #undef RESC
  #undef ROT
}
constexpr int ATTN_LDS_BYTES=LDS_BYTES;
#undef SBAR
#undef WAIT_BAR
}

#define DI __device__ __forceinline__
#define LAS __attribute__((address_space(3)))
typedef unsigned short bf16;
typedef unsigned v4u __attribute__((ext_vector_type(4)));
typedef unsigned v2u __attribute__((ext_vector_type(2)));
typedef float f32x4 __attribute__((ext_vector_type(4)));
typedef float f32x2 __attribute__((ext_vector_type(2)));
typedef float f32x16 __attribute__((ext_vector_type(16)));
typedef short bf16x8 __attribute__((ext_vector_type(8)));
typedef __bf16 bf16x2_t __attribute__((ext_vector_type(2)));

constexpr int NWAVES = 8, NTHR = 512;
constexpr int BATCH = 2, SEQ = 8192, DM = 1024, LC = 256;
constexpr int NLAT = BATCH * SEQ;
constexpr int NROW = NLAT + BATCH * LC;
constexpr int KT = LC + SEQ;
constexpr int NEXP = 16;
constexpr float LOG2E = 1.4426950408889634f;
constexpr float QSCALE = 0.125f * LOG2E;
constexpr bool MOE_FP8 = true;
constexpr float WSCALE = 32.0f, WINV = 1.0f / 32.0f;

constexpr size_t MiB = 1u << 20;
constexpr size_t WS_CTL = 0, CTL_BYTES = 64 * 1024;
constexpr size_t WS_MOD = 1 * MiB;
constexpr size_t WS_COS = 2 * MiB, WS_SIN = 3 * MiB;
constexpr size_t WS_AFFT = 4 * MiB;
constexpr size_t WS_SLOT = 6 * MiB;
constexpr size_t WS_IDX = 8 * MiB;
constexpr size_t WS_GATEV = 9 * MiB;
constexpr size_t WS_SCH = 10 * MiB;
constexpr size_t WS_RST = 46 * MiB;
constexpr size_t WS_WABIN = 80 * MiB;
constexpr size_t WS_WABOUT = 83 * MiB;
constexpr size_t WS_WCDIN = 86 * MiB;
constexpr size_t WS_WCDOUT = 91 * MiB;
constexpr size_t WS_WGU = 96 * MiB;
constexpr size_t WS_WD = 352 * MiB;
constexpr size_t WS_XN = 480 * MiB;
constexpr size_t WS_X1 = 514 * MiB;
constexpr size_t WS_X2 = 580 * MiB;
constexpr size_t WS_XS = 646 * MiB;
constexpr size_t WS_ACT = 718 * MiB;
constexpr size_t WS_P = 718 * MiB;
constexpr size_t WS_CAT = 793 * MiB;
constexpr size_t WS_QA = 826 * MiB;
constexpr size_t WS_KA = 843 * MiB;
constexpr size_t WS_VTA = 848 * MiB;
constexpr size_t WS_END = 862 * MiB;

constexpr int LDS_BYTES = 147456;
constexpr int LDS_MISC = LDS_BYTES - 256;

struct Params { const float* in[25]; float* out; unsigned char* ws; unsigned long long pad; };

DI float bf2f(unsigned short b) { return __uint_as_float(((unsigned)b) << 16); }
DI unsigned cvtpk(float lo, float hi) { f32x2 v = {lo, hi}; bf16x2_t b = __builtin_convertvector(v, bf16x2_t); return __builtin_bit_cast(unsigned, b); }
DI unsigned short f2bf(float f) { return (unsigned short)(cvtpk(f, 0.f) & 0xffffu); }
DI float shx(float v, int o, int lane) { return __builtin_bit_cast(float, __builtin_amdgcn_ds_bpermute(((lane ^ o) & 63) << 2, __builtin_bit_cast(int, v))); }
DI int shxi(int v, int o, int lane) { return __builtin_amdgcn_ds_bpermute(((lane ^ o) & 63) << 2, v); }
DI float wave_sum(float v, int lane) {
#pragma unroll
    for (int o = 1; o < 64; o <<= 1) v += shx(v, o, lane);
    return v;
}
DI int crow(int i, int hi) { return (i & 3) + 8 * (i >> 2) + 4 * hi; }
#define MFMA32(a, b, c) __builtin_amdgcn_mfma_f32_32x32x16_bf16((a), (b), (c), 0, 0, 0)
#define LDS_WAIT() asm volatile("s_waitcnt lgkmcnt(0)" ::: "memory")

struct Ctx {
    int tid, lane, wave, vcu, G, gw, NGW;
    LAS unsigned char* lds;
};
typedef const __attribute__((address_space(4))) Params* KP;
DI void env(Params& p, Ctx& C, unsigned char* lds_raw) {
    KP kp = (KP)__builtin_amdgcn_kernarg_segment_ptr(); asm volatile("" : "+s"(kp) :: "memory");
#pragma unroll
    for (int i = 0; i < 25; ++i) p.in[i] = kp->in[i];
    p.out = kp->out; p.ws = kp->ws; p.pad = 0ull;
    int tid = threadIdx.x; asm volatile("" : "+v"(tid) :: "memory");
    C.lds = (LAS unsigned char*)lds_raw;
    C.tid = tid; C.lane = tid & 63; C.wave = __builtin_amdgcn_readfirstlane(tid >> 6);
    C.G = gridDim.x; { const int bx = blockIdx.x; C.vcu = (C.G % 8 == 0) ? (bx % 8) * (C.G / 8) + bx / 8 : bx; }
    C.gw = C.vcu * NWAVES + C.wave; C.NGW = C.G * NWAVES;
}

DI void transpose_item(const float* W, int N, int k0, int n0, bf16* dst, int dpitch, LAS float* scr  , int lane) {
    f32x4 t[16];
    const float* wp = W + (size_t)(k0 + (lane >> 4)) * N + n0 + (lane & 15) * 4;
#pragma unroll
    for (int i = 0; i < 16; ++i) t[i] = __builtin_nontemporal_load((const f32x4*)(wp + (size_t)(4 * i) * N));
#pragma unroll
    for (int i = 0; i < 16; ++i) { LAS float* sp = scr + ((lane >> 4) + 4 * i) * 65 + (lane & 15) * 4; sp[0] = t[i].x; sp[1] = t[i].y; sp[2] = t[i].z; sp[3] = t[i].w; }
    LDS_WAIT(); asm volatile("" ::: "memory");
    const int c = lane & 7;
#pragma unroll
    for (int j = 0; j < 8; ++j) { const int n = (lane >> 3) + 8 * j; const LAS float* s = scr + (8 * c) * 65 + n;
        v4u o; o.x = cvtpk(s[0 * 65], s[1 * 65]); o.y = cvtpk(s[2 * 65], s[3 * 65]); o.z = cvtpk(s[4 * 65], s[5 * 65]); o.w = cvtpk(s[6 * 65], s[7 * 65]);
        __builtin_nontemporal_store(o, (v4u*)(dst + (size_t)n * dpitch + 8 * c)); }
    LDS_WAIT(); asm volatile("" ::: "memory");
}

DI unsigned pk4f8(float a, float b, float c, float d) { unsigned w = 0u; w = __builtin_amdgcn_cvt_pk_fp8_f32(a, b, w, false); w = __builtin_amdgcn_cvt_pk_fp8_f32(c, d, w, true); return w; }
DI void transpose_item_f8(const float* W, int N, int k0, int n0, unsigned char* dst, int dpitch, LAS float* scr  , int lane) {
    f32x4 t[16];
    const float* wp = W + (size_t)(k0 + (lane >> 4)) * N + n0 + (lane & 15) * 4;
#pragma unroll
    for (int i = 0; i < 16; ++i) t[i] = __builtin_nontemporal_load((const f32x4*)(wp + (size_t)(4 * i) * N));
#pragma unroll
    for (int i = 0; i < 16; ++i) { LAS float* sp = scr + ((lane >> 4) + 4 * i) * 65 + (lane & 15) * 4; sp[0] = t[i].x * WSCALE; sp[1] = t[i].y * WSCALE; sp[2] = t[i].z * WSCALE; sp[3] = t[i].w * WSCALE; }
    LDS_WAIT(); asm volatile("" ::: "memory");
    const int c = lane & 3;
#pragma unroll
    for (int j = 0; j < 4; ++j) { const int n = (lane >> 2) + 16 * j; const LAS float* s = scr + (16 * c) * 65 + n;
        v4u o; o.x = pk4f8(s[0 * 65], s[1 * 65], s[2 * 65], s[3 * 65]); o.y = pk4f8(s[4 * 65], s[5 * 65], s[6 * 65], s[7 * 65]);
        o.z = pk4f8(s[8 * 65], s[9 * 65], s[10 * 65], s[11 * 65]); o.w = pk4f8(s[12 * 65], s[13 * 65], s[14 * 65], s[15 * 65]);
        __builtin_nontemporal_store(o, (v4u*)(dst + (size_t)n * dpitch + 16 * c)); }
    LDS_WAIT(); asm volatile("" ::: "memory");
}

constexpr int MOE_ITEMS = 3 * 16 * 512;
DI void convert_moe_item(const Params& p, int l, int it, LAS float* scr, int lane) {
    const int kind = it >> 13, r = it & 8191, mat = l * 16 + (r >> 9), rr = r & 511;
    if (kind < 2) { const int kb = rr >> 5, nb = rr & 31, n0 = 64 * nb; const float* src = (kind ? p.in[23] : p.in[22]) + (size_t)mat * 1024 * 2048;
        const int drow = mat * 4096 + (n0 >> 7) * 256 + (n0 & 127) + (kind ? 128 : 0);
        if (MOE_FP8) transpose_item_f8(src, 2048, 64 * kb, n0, (unsigned char*)(p.ws + WS_WGU) + (size_t)drow * 1024 + 64 * kb, 1024, scr, lane);
        else transpose_item(src, 2048, 64 * kb, n0, (bf16*)(p.ws + WS_WGU) + (size_t)drow * 1024 + 64 * kb, 1024, scr, lane); }
    else { const int kb = rr >> 4, nb = rr & 15; const float* src = p.in[24] + (size_t)mat * 2048 * 1024;
        if (MOE_FP8) transpose_item_f8(src, 1024, 64 * kb, 64 * nb, (unsigned char*)(p.ws + WS_WD) + (size_t)(mat * 1024 + 64 * nb) * 2048 + 64 * kb, 2048, scr, lane);
        else transpose_item(src, 1024, 64 * kb, 64 * nb, (bf16*)(p.ws + WS_WD) + (size_t)(mat * 1024 + 64 * nb) * 2048 + 64 * kb, 2048, scr, lane); }
}
struct SlotPlan { int base[6], nidle[6], q[6], covered[2]; };
DI SlotPlan make_slot_plan(int G) {
    SlotPlan sp; const int nunits[6] = {330, 264, 64, 576, 594, 32}; const int qq[6] = {40, 40, 40, 32, 32, 32};
#pragma unroll
    for (int st = 0; st < 2; ++st) { int acc = 0;
#pragma unroll
        for (int k = 3 * st; k < 3 * st + 3; ++k) { const int rounds = (nunits[k] + G - 1) / G; const int busy = nunits[k] - (rounds - 1) * G; const int ni = G - busy; sp.nidle[k] = ni; sp.base[k] = acc;
            sp.q[k] = qq[k]; acc += (ni > 0 ? ni : 0) * qq[k]; if (acc > MOE_ITEMS) acc = MOE_ITEMS; }
        sp.covered[st] = acc; }
    return sp;
}
DI void convert_slot(const Ctx& C, const Params& p, int k, int c) {
    const SlotPlan sp = make_slot_plan(C.G);
    const int ii = c - (C.G - sp.nidle[k]); if (ii < 0) return;
    const int first = sp.base[k] + ii * sp.q[k]; int last = first + sp.q[k]; if (last > MOE_ITEMS) last = MOE_ITEMS;
    LAS float* scr = (LAS float*)(C.lds + C.wave * 16640);
    for (int it = first + C.wave; it < last; it += NWAVES) convert_moe_item(p, k < 3 ? 0 : 1, it, scr, C.lane);
}

DI void ph0_prologue(const Ctx& C, const Params& p) {
    unsigned char* ws = p.ws;
    float* MOD = (float*)(ws + WS_MOD);
    {
        LAS float* sv = (LAS float*)(C.lds);
        LAS float* red = (LAS float*)(C.lds + 12288);
        for (int i = C.tid; i < 3 * 1024; i += NTHR) { const int r = i >> 10, k = i & 1023; const float cv = (r < 2) ? p.in[1][r * 1024 + k] : p.in[3][k]; sv[i] = cv / (1.f + __expf(-cv)); }
        __syncthreads();
        for (int item = C.vcu; item < 192; item += C.G) {
            const int l = item / 96, n0 = (item % 96) * 64;
            const float* W = p.in[4] + (size_t)l * 1024 * 6144 + n0 + C.lane;
            float a0 = 0.f, a1 = 0.f, a2 = 0.f;
            const int kb = C.wave * 128;
#pragma unroll 32
            for (int k = 0; k < 128; ++k) { const float w = __builtin_nontemporal_load(W + (size_t)(kb + k) * 6144); a0 += sv[kb + k] * w; a1 += sv[1024 + kb + k] * w; a2 += sv[2048 + kb + k] * w; }
            red[(C.wave * 3 + 0) * 64 + C.lane] = a0; red[(C.wave * 3 + 1) * 64 + C.lane] = a1; red[(C.wave * 3 + 2) * 64 + C.lane] = a2;
            __syncthreads();
            if (C.tid < 192) { const int r = C.tid >> 6, ln = C.tid & 63; float s = 0.f;
#pragma unroll
                for (int w = 0; w < 8; ++w) s += red[(w * 3 + r) * 64 + ln];
                MOD[(size_t)(l * 3 + r) * 6144 + n0 + ln] = s + p.in[5][l * 6144 + n0 + ln]; }
            __syncthreads();
        }
        __syncthreads();
    }
    {
        float* COS = (float*)(ws + WS_COS); float* SIN = (float*)(ws + WS_SIN);
        for (int i = C.vcu * NTHR + C.tid; i < SEQ * 32; i += C.G * NTHR) {
            const int t = i >> 5, j = i & 31; const int pos = (j < 16) ? (t >> 6) : (t & 63); const int fi = j & 15;
            const float freq = powf(10000.0f, -(float)fi / 16.0f); const float ang = (float)pos * freq;
            COS[i] = cosf(ang); SIN[i] = sinf(ang);
        }
    }
    {
        LAS float* scr = (LAS float*)(C.lds + C.wave * 16640);
        bf16* WABIN = (bf16*)(ws + WS_WABIN); bf16* WABOUT = (bf16*)(ws + WS_WABOUT);
        bf16* WCDIN = (bf16*)(ws + WS_WCDIN); bf16* WCDOUT = (bf16*)(ws + WS_WCDOUT); bf16* WGU = (bf16*)(ws + WS_WGU); bf16* WD = (bf16*)(ws + WS_WD);
        constexpr int I0 = 16 * 20, I1 = 8 * 16, I2 = 16 * 36, I3 = 16 * 16, I4 = 1024, I5 = 0, I6 = 16 * 512, I7 = 16 * 512, I8 = 16 * 512;
        constexpr int NITEMS = I0 + I1 + I2 + I3 + I4 + I5;
        for (int it = C.gw; it < NITEMS; it += C.NGW) {
            int r = it;
            if (r < I0) { const int kb = r / 20, nb = r % 20; transpose_item(p.in[9], 1280, 64 * kb, 64 * nb, WABIN + (size_t)(64 * nb) * 1024 + 64 * kb, 1024, scr, C.lane); continue; } r -= I0;
            if (r < I1) { const int kb = r / 16, nb = r % 16; transpose_item(p.in[10], 1024, 64 * kb, 64 * nb, WABOUT + (size_t)(64 * nb) * 1024 + 64 * kb, 1024, scr, C.lane); continue; } r -= I1;
            if (r < I2) { const int kb = r / 36, nb = r % 36; transpose_item(p.in[15], 2304, 64 * kb, 64 * nb, WCDIN + (size_t)(64 * nb) * 1024 + 64 * kb, 1024, scr, C.lane); continue; } r -= I2;
            if (r < I3) { const int kb = r / 16, nb = r % 16; transpose_item(p.in[16], 1024, 64 * kb, 64 * nb, WCDOUT + (size_t)(64 * nb) * 1024 + 64 * kb, 1024, scr, C.lane); continue; } r -= I3;
            if (r < I4) {
                const int g = r >> 8, cb = (r >> 4) & 15, nb = r & 15, c0 = 8 * cb, n0 = 64 * nb;
                const float* Wg = p.in[13] + (size_t)g * 128 * 128 + (size_t)c0 * 128; const float* bs = p.in[14] + g * 128; const float* Wo = p.in[10] + (size_t)(512 + g * 128) * 1024 + n0 + C.lane;
                float a8[8];
#pragma unroll
                for (int ci = 0; ci < 8; ++ci) a8[ci] = 0.f;
#pragma unroll 8
                for (int d = 0; d < 128; ++d) { const float w = Wo[(size_t)d * 1024] * bs[d];
#pragma unroll
                    for (int ci = 0; ci < 8; ++ci) a8[ci] += Wg[ci * 128 + d] * w; }
                v4u o; o.x = cvtpk(a8[0], a8[1]); o.y = cvtpk(a8[2], a8[3]); o.z = cvtpk(a8[4], a8[5]); o.w = cvtpk(a8[6], a8[7]);
                *(v4u*)(WABOUT + (size_t)(n0 + C.lane) * 1024 + 512 + g * 128 + c0) = o; continue; } r -= I4;
        }
        { const SlotPlan sp = make_slot_plan(C.G);
          const int n0 = MOE_ITEMS - sp.covered[0], n1 = MOE_ITEMS - sp.covered[1];
          for (int it = C.gw; it < n0 + n1; it += C.NGW) { if (it < n0) convert_moe_item(p, 0, sp.covered[0] + it, scr, C.lane); else convert_moe_item(p, 1, sp.covered[1] + (it - n0), scr, C.lane); } }
    }
}

DI void load_row(const float* src, int lane, f32x4 (&v)[4]) {
#pragma unroll
    for (int j = 0; j < 4; ++j) v[j] = __builtin_nontemporal_load((const f32x4*)src + lane + 64 * j);
}
DI void load_row_h(const bf16* src, int lane, f32x4 (&v)[4]) {
#pragma unroll
    for (int j = 0; j < 4; ++j) { const v2u w = __builtin_nontemporal_load((const v2u*)src + lane + 64 * j); v[j] = (f32x4){__uint_as_float(w.x << 16), __uint_as_float(w.x & 0xffff0000u), __uint_as_float(w.y << 16), __uint_as_float(w.y & 0xffff0000u)}; }
}
DI float row_rstd(const f32x4 (&v)[4], float eps, int lane) {
    float s = 0.f;
#pragma unroll
    for (int j = 0; j < 4; ++j) s += (v[j].x * v[j].x + v[j].y * v[j].y) + (v[j].z * v[j].z + v[j].w * v[j].w);
    s = wave_sum(s, lane);
    return rsqrtf(s * (1.0f / 1024.0f) + eps);
}
template <bool OUT_FP8 = false>
DI void modulate_row(f32x4 (&v)[4], const float* g, const float* shift, const float* scale, bf16* dst, int lane) {
    const float rstd = row_rstd(v, 1e-6f, lane);
#pragma unroll
    for (int j = 0; j < 4; ++j) {
        const f32x4 gg = ((const f32x4*)g)[lane + 64 * j], sh = ((const f32x4*)shift)[lane + 64 * j], sc = ((const f32x4*)scale)[lane + 64 * j];
        v[j] = v[j] * rstd * gg * (sc + 1.0f) + sh;
        if (OUT_FP8) ((unsigned*)dst)[lane + 64 * j] = pk4f8(v[j].x, v[j].y, v[j].z, v[j].w);
        else { v2u w; w.x = cvtpk(v[j].x, v[j].y); w.y = cvtpk(v[j].z, v[j].w); ((v2u*)dst)[lane + 64 * j] = w; }
    }
}

DI void ph_modulate0(const Ctx& C, const Params& p) {
    const float* MOD = (const float*)(p.ws + WS_MOD); bf16* XN = (bf16*)(p.ws + WS_XN);
    for (int r0 = C.gw; r0 < NROW; r0 += 2 * C.NGW) {
        int rr[2] = {r0, r0 + C.NGW}; if (rr[1] >= NROW) rr[1] = r0;
        f32x4 v[2][4];
#pragma unroll
        for (int q = 0; q < 2; ++q) { const int r = rr[q]; const float* src = r < NLAT ? p.in[0] + (size_t)r * DM : p.in[2] + (size_t)(r - NLAT) * DM; load_row(src, C.lane, v[q]); }
#pragma unroll
        for (int q = 0; q < 2; ++q) { const int r = rr[q]; const int mi = r < NLAT ? (r >> 13) : 2; const float* mp = MOD + (size_t)(0 * 3 + mi) * 6144;
            modulate_row(v[q], p.in[6], mp, mp + 1024, XN + (size_t)r * DM, C.lane); }
    }
}

struct HeadRegs { v2u a, b; };
DI HeadRegs heads8_load(const bf16* src, int nheads, int lane) {
    const int hd = lane >> 3, hdc = hd < nheads ? hd : nheads - 1, j0 = (lane & 7) * 4;
    HeadRegs h; h.a = __builtin_nontemporal_load((const v2u*)(src + hdc * 64 + j0)); h.b = __builtin_nontemporal_load((const v2u*)(src + hdc * 64 + 32 + j0)); return h;
}
DI void heads8_finish(const HeadRegs h, int nheads, bool donorm, const f32x4 g1, const f32x4 g2, bool dorope, const f32x4 c, const f32x4 sv, float scale, bf16* dst, int lane) {
    const int hd = lane >> 3, j0 = (lane & 7) * 4;
    float x1[4] = {__uint_as_float(h.a.x << 16), __uint_as_float(h.a.x & 0xffff0000u), __uint_as_float(h.a.y << 16), __uint_as_float(h.a.y & 0xffff0000u)};
    float x2[4] = {__uint_as_float(h.b.x << 16), __uint_as_float(h.b.x & 0xffff0000u), __uint_as_float(h.b.y << 16), __uint_as_float(h.b.y & 0xffff0000u)};
    if (donorm) { float ss = 0.f;
#pragma unroll
        for (int i = 0; i < 4; ++i) ss += x1[i] * x1[i] + x2[i] * x2[i];
        ss += shx(ss, 1, lane); ss += shx(ss, 2, lane); ss += shx(ss, 4, lane);
        const float rs = rsqrtf(ss * (1.0f / 64.0f) + 1e-6f);
#pragma unroll
        for (int i = 0; i < 4; ++i) { x1[i] *= rs * g1[i]; x2[i] *= rs * g2[i]; } }
    if (dorope) {
#pragma unroll
        for (int i = 0; i < 4; ++i) { const float o1 = x1[i] * c[i] - x2[i] * sv[i], o2 = x1[i] * sv[i] + x2[i] * c[i]; x1[i] = o1; x2[i] = o2; } }
    if (hd < nheads) { v2u o1, o2; o1.x = cvtpk(x1[0] * scale, x1[1] * scale); o1.y = cvtpk(x1[2] * scale, x1[3] * scale); o2.x = cvtpk(x2[0] * scale, x2[1] * scale); o2.y = cvtpk(x2[2] * scale, x2[3] * scale);
        *(v2u*)(dst + hd * 64 + j0) = o1; *(v2u*)(dst + hd * 64 + 32 + j0) = o2; }
}

DI void ph_post0(const Ctx& C, const Params& p) {
    const bf16* P = (const bf16*)(p.ws + WS_P); bf16* QA = (bf16*)(p.ws + WS_QA); bf16* KA = (bf16*)(p.ws + WS_KA); bf16* VA = (bf16*)(p.ws + WS_VTA); bf16* CATB = (bf16*)(p.ws + WS_CAT) + 512;
    const float* COS = (const float*)(p.ws + WS_COS); const float* SIN = (const float*)(p.ws + WS_SIN);
    const int j0 = (C.lane & 7) * 4;
    const f32x4 qg1 = *(const f32x4*)(p.in[11] + j0), qg2 = *(const f32x4*)(p.in[11] + 32 + j0), kg1 = *(const f32x4*)(p.in[12] + j0), kg2 = *(const f32x4*)(p.in[12] + 32 + j0);
    for (int r0 = C.gw; r0 < NROW; r0 += 2 * C.NGW) {
        int rr[2] = {r0, r0 + C.NGW}; if (rr[1] >= NROW) rr[1] = r0;
        bool isctx[2]; int bb[2], pos[2], kk[2]; const bf16* prow[2];
#pragma unroll
        for (int q = 0; q < 2; ++q) { const int r = rr[q]; isctx[q] = r >= NLAT; bb[q] = isctx[q] ? ((r - NLAT) >> 8) : (r >> 13); pos[q] = isctx[q] ? ((r - NLAT) & 255) : (r & 8191);
            kk[q] = isctx[q] ? pos[q] : LC + pos[q]; prow[q] = P + (size_t)r * 1280; }
        HeadRegs hq[2], hk[2]; v4u vc[2], uu[2]; f32x4 c4[2], s4[2];
#pragma unroll
        for (int q = 0; q < 2; ++q) { hq[q] = heads8_load(prow[q], 8, C.lane); hk[q] = heads8_load(prow[q] + 512, 2, C.lane);
            vc[q] = *(const v4u*)(prow[q] + 640 + (C.lane & 15) * 8); uu[q] = *(const v4u*)(prow[q] + 768 + C.lane * 8);
            const size_t tp = (size_t)(isctx[q] ? 0 : pos[q]) * 32 + j0; c4[q] = *(const f32x4*)(COS + tp); s4[q] = *(const f32x4*)(SIN + tp); }
        const int c0 = C.lane * 8, g = C.lane >> 4, w = 2 << g;
        int lo[2], hi[2]; float s[2][8];
#pragma unroll
        for (int q = 0; q < 2; ++q) { const int L = isctx[q] ? LC : SEQ; lo[q] = max(pos[q] - (w >> 1), 0); hi[q] = min(pos[q] - (w >> 1) + w, L);
#pragma unroll
            for (int i = 0; i < 8; ++i) s[q][i] = 0.f; }
#pragma unroll
        for (int bt = 0; bt < 2; ++bt) {
            if (bt == 1 && !__any((lo[0] + 8 < hi[0]) || (lo[1] + 8 < hi[1]))) break;
            v4u vv[2][8];
#pragma unroll
            for (int q = 0; q < 2; ++q) { const size_t rowbase = (size_t)rr[q] - pos[q];
#pragma unroll
                for (int k = 0; k < 8; ++k) { const int rw = min(lo[q] + 8 * bt + k, hi[q] - 1); vv[q][k] = *(const v4u*)(P + (rowbase + rw) * 1280 + 768 + c0); } }
            if (bt == 0) {
#pragma unroll
                for (int q = 0; q < 2; ++q) {
                    heads8_finish(hq[q], 8, true, qg1, qg2, !isctx[q], c4[q], s4[q], QSCALE, QA + (size_t)rr[q] * 512, C.lane);
                    heads8_finish(hk[q], 2, true, kg1, kg2, !isctx[q], c4[q], s4[q], 1.0f, KA + ((size_t)bb[q] * KT + kk[q]) * 128, C.lane);
                    if (C.lane < 16) *(v4u*)(VA + ((size_t)bb[q] * KT + kk[q]) * 128 + C.lane * 8) = vc[q]; }
            }
#pragma unroll
            for (int q = 0; q < 2; ++q)
#pragma unroll
                for (int k = 0; k < 8; ++k) { const float wgt = (lo[q] + 8 * bt + k < hi[q]) ? 1.0f : 0.0f;
#pragma unroll
                    for (int i = 0; i < 4; ++i) { s[q][2 * i] += wgt * __uint_as_float(vv[q][k][i] << 16); s[q][2 * i + 1] += wgt * __uint_as_float(vv[q][k][i] & 0xffff0000u); } }
        }
#pragma unroll
        for (int q = 0; q < 2; ++q) { const float inv = 1.0f / (float)(hi[q] - lo[q]); v4u o;
#pragma unroll
            for (int i = 0; i < 4; ++i) o[i] = cvtpk(s[q][2 * i] * inv - __uint_as_float(uu[q][i] << 16), s[q][2 * i + 1] * inv - __uint_as_float(uu[q][i] & 0xffff0000u));
            *(v4u*)(CATB + (size_t)rr[q] * 1024 + c0) = o; }
    }
}

DI void ph_post1(const Ctx& C, const Params& p) {
    bf16* P = (bf16*)(p.ws + WS_P); bf16* KA = (bf16*)(p.ws + WS_KA); bf16* VTA = (bf16*)(p.ws + WS_VTA);
    const float* COS = (const float*)(p.ws + WS_COS); const float* SIN = (const float*)(p.ws + WS_SIN);
    const int j0 = (C.lane & 7) * 4; const f32x4 one = (f32x4){1.f, 1.f, 1.f, 1.f};
    for (int r0 = C.gw; r0 < NROW; r0 += 2 * C.NGW) {
        int rr[2] = {r0, r0 + C.NGW}; const bool dup = rr[1] >= NROW; if (dup) rr[1] = r0;
        bool isctx[2]; int bb[2], kk[2]; bf16* prow[2];
        HeadRegs hcq[2], hck[2], hdq[2], hdk[2]; v4u vc[2]; f32x4 c4[2], s4[2];
#pragma unroll
        for (int q = 0; q < 2; ++q) { const int r = rr[q]; isctx[q] = r >= NLAT; bb[q] = isctx[q] ? ((r - NLAT) >> 8) : (r >> 13); const int pos = isctx[q] ? ((r - NLAT) & 255) : (r & 8191);
            kk[q] = isctx[q] ? pos : LC + pos; prow[q] = P + (size_t)r * 2304;
            hcq[q] = heads8_load(prow[q], 4, C.lane); hck[q] = heads8_load(prow[q] + 256, 4, C.lane); hdq[q] = heads8_load(prow[q] + 1536, 8, C.lane); hdk[q] = heads8_load(prow[q] + 2048, 2, C.lane);
            vc[q] = *(const v4u*)(prow[q] + 2176 + (C.lane & 15) * 8);
            const size_t tp = (size_t)(isctx[q] ? 0 : pos) * 32 + j0; c4[q] = *(const f32x4*)(COS + tp); s4[q] = *(const f32x4*)(SIN + tp); }
#pragma unroll
        for (int q = 0; q < 2; ++q) { if (q == 1 && dup) break;
            if (!isctx[q]) { heads8_finish(hcq[q], 4, false, one, one, true, c4[q], s4[q], 1.0f, prow[q], C.lane); heads8_finish(hdq[q], 8, false, one, one, true, c4[q], s4[q], QSCALE, prow[q] + 1536, C.lane); }
            heads8_finish(hck[q], 4, false, one, one, !isctx[q], c4[q], s4[q], 0.125f, prow[q] + 256, C.lane);
            heads8_finish(hdk[q], 2, false, one, one, !isctx[q], c4[q], s4[q], 1.0f, KA + ((size_t)bb[q] * KT + kk[q]) * 128, C.lane);
            if (C.lane < 16) *(v4u*)(VTA + ((size_t)bb[q] * KT + kk[q]) * 128 + C.lane * 8) = vc[q]; }
    }
}

DI void ph_attn_dense(const Ctx& C, const Params& p, unsigned char* lds_raw) {
    typedef attn_body::bf16 abf;
    const abf* QA = (const abf*)(p.ws + WS_QA); const abf* KA = (const abf*)(p.ws + WS_KA); const abf* VA = (const abf*)(p.ws + WS_VTA); abf* CAT = (abf*)(p.ws + WS_CAT);
    for (int u = C.vcu; u < 512 + 16; u += C.G) {
        if (u < 512) { const int qb = u & 31, h = (u >> 5) & 7, b = u >> 8; const size_t row0 = (size_t)b * SEQ + 256 * qb; const size_t kv0 = (size_t)b * KT * 128 + (h >> 2) * 64;
            attn_body::attn_unit<8, false>(QA + row0 * 512 + h * 64, 512, KA + kv0, VA + kv0, 128, KT / 64, CAT + row0 * 1024 + h * 64, 1024, (char*)lds_raw, 0, 0, 0.f); }
        else { const int v = u - 512; const int h = v & 7, b = v >> 3; const size_t row0 = (size_t)NLAT + b * LC; const size_t kv0 = (size_t)b * KT * 128 + (h >> 2) * 64;
            attn_body::attn_unit<8, false>(QA + row0 * 512 + h * 64, 512, KA + kv0, VA + kv0, 128, LC / 64, CAT + row0 * 1024 + h * 64, 1024, (char*)lds_raw, 0, 0, 0.f); }
    }
}
DI void ph_attn_window(const Ctx& C, const Params& p, unsigned char* lds_raw) {
    typedef attn_body::bf16 abf;
    const abf* P = (const abf*)(p.ws + WS_P); const abf* KA = (const abf*)(p.ws + WS_KA); const abf* VA = (const abf*)(p.ws + WS_VTA); abf* CAT = (abf*)(p.ws + WS_CAT);
    for (int u = C.vcu; u < 512; u += C.G) {
        const int qb = u & 31, h = (u >> 5) & 7, b = u >> 8; const int q0 = 256 * qb; const size_t row0 = (size_t)b * SEQ + q0; const size_t kv0 = (size_t)b * KT * 128 + (h >> 2) * 64;
        const int lo = max(q0 - 128, 0), hi = min(q0 + 384, SEQ);
        attn_body::attn_unit<8, true>(P + row0 * 2304 + 1536 + h * 64, 2304, KA + kv0, VA + kv0, 128, 4 + (hi - lo) / 64, CAT + row0 * 1024 + 512 + h * 64, 1024, (char*)lds_raw, lo, q0, p.in[20][h] * LOG2E);
    }
}

DI void ph_ffn_norm_router(const Ctx& C, const Params& p, int l, int nrows) {
    const float* MOD = (const float*)(p.ws + WS_MOD); unsigned char* XN8 = p.ws + WS_XN; const bf16* X1 = (const bf16*)(p.ws + WS_X1); float* AFFT = (float*)(p.ws + WS_AFFT);
    LAS bf16* Bh = (LAS bf16*)C.lds;
    LAS bf16* Bl = Bh + 16384;
    LAS float* GS = (LAS float*)(C.lds + 65536);
    LAS float* SH = GS + 1024;
    LAS float* cb = SH + 1024;
    const int G = C.G, w = C.vcu;
    int mi, t0, t1, rbase;
    { const int gc = nrows == NROW ? (G >= 32 ? G / 32 : 1) : 0, gl = (G - gc) / 2;
      if (w < gl) { mi = 0; rbase = 0; t0 = (w * 512) / gl; t1 = ((w + 1) * 512) / gl; }
      else if (nrows != NROW || w < 2 * gl) { const int n = nrows == NROW ? gl : G - gl, i = w - gl; mi = 1; rbase = SEQ; t0 = (i * 512) / n; t1 = ((i + 1) * 512) / n; }
      else { const int n = G - 2 * gl, i = w - 2 * gl; mi = 2; rbase = NLAT; t0 = (i * 32) / n; t1 = ((i + 1) * 32) / n; } }
    const float* mp = MOD + (size_t)(l * 3 + mi) * 6144; const float* gw = p.in[7] + l * 1024; const float* shp = mp + 3 * 1024; const float* scp = mp + 4 * 1024;
    const float* RW = p.in[21] + (size_t)l * 1024 * 16;
    const int wv = __builtin_amdgcn_readfirstlane(C.wave);
    const int row = C.lane & 15, kg = C.lane >> 4;
    unsigned xo = (unsigned)(row * 1024 + 32 * kg); asm volatile("" : "+v"(xo));
    v4u xq[8][4];
    int t = t0 + wv;
    if (t < t1) { const bf16* xt = X1 + (size_t)(rbase + 16 * t) * DM;
#pragma unroll
        for (int q = 0; q < 8; ++q)
#pragma unroll
            for (int c = 0; c < 4; ++c) xq[q][c] = __builtin_nontemporal_load((const v4u*)(xt + xo + 128 * q + 8 * c)); }
    { float wr[32];
#pragma unroll
      for (int it = 0; it < 32; ++it) wr[it] = RW[C.tid + NTHR * it];
#pragma unroll
      for (int h = 0; h < 2; ++h) { const int k = C.tid + NTHR * h; GS[k] = gw[k] * (scp[k] + 1.0f); SH[k] = shp[k]; }
      __syncthreads();
      float cacc = 0.f;
      unsigned tq = (unsigned)C.tid; asm volatile("" : "+v"(tq));
      const unsigned e = tq & 15u, kb = tq >> 4;
      unsigned ob = ((((kb >> 3) * 4u) * 16u + e) * 8u + (kb & 7u)); asm volatile("" : "+v"(ob));
#pragma unroll
      for (int it = 0; it < 32; ++it) {
          const float gk = GS[kb + 32 * it], shk = SH[kb + 32 * it];
          const float bf = gk * wr[it]; const unsigned short hi = f2bf(bf); const unsigned short lo = f2bf(bf - bf2f(hi));
          const int o = ((4 * (it >> 2)) * 4 + (it & 3)) * 16 * 8;
          Bh[ob + o] = hi; Bl[ob + o] = lo; cacc += shk * wr[it]; }
      cacc += shx(cacc, 16, C.lane); cacc += shx(cacc, 32, C.lane);
      if (C.lane < 16) cb[wv * 16 + C.lane] = cacc; }
    __syncthreads();
    float cbias = 0.f;
#pragma unroll
    for (int ww = 0; ww < 8; ++ww) cbias += cb[ww * 16 + row];
    while (t < t1) {
        const int r0 = rbase + 16 * t;
        f32x4 acc = (f32x4){0.f, 0.f, 0.f, 0.f}; float ssq = 0.f;
        int ln = C.lane; asm volatile("" : "+v"(ln));
        unsigned lb = (unsigned)ln * 8u;
#pragma unroll
        for (int q = 0; q < 8; ++q)
#pragma unroll
            for (int c = 0; c < 4; ++c) {
                const bf16x8 bh = *(const LAS bf16x8*)(Bh + lb + (4 * q + c) * 512), bl = *(const LAS bf16x8*)(Bl + lb + (4 * q + c) * 512);
                const bf16x8 a = __builtin_bit_cast(bf16x8, xq[q][c]);
                acc = __builtin_amdgcn_mfma_f32_16x16x32_bf16(a, bh, acc, 0, 0, 0);
                acc = __builtin_amdgcn_mfma_f32_16x16x32_bf16(a, bl, acc, 0, 0, 0);
#pragma unroll
                for (int d = 0; d < 4; ++d) { const float x0 = __uint_as_float(xq[q][c][d] << 16), x1 = __uint_as_float(xq[q][c][d] & 0xffff0000u); ssq += x0 * x0 + x1 * x1; }
            }
        ssq += shx(ssq, 16, ln); ssq += shx(ssq, 32, ln);
        const float rstd = rsqrtf(ssq * (1.0f / 1024.0f) + 1e-6f);
        f32x4 af;
#pragma unroll
        for (int i = 0; i < 4; ++i) {
            const float rs = __builtin_bit_cast(float, __builtin_amdgcn_ds_bpermute((((ln >> 4) * 4 + i) << 2), __builtin_bit_cast(int, rstd)));
            const float lgt = acc[i] * rs + cbias;
            float mx = lgt; mx = fmaxf(mx, shx(mx, 1, ln)); mx = fmaxf(mx, shx(mx, 2, ln)); mx = fmaxf(mx, shx(mx, 4, ln)); mx = fmaxf(mx, shx(mx, 8, ln));
            const float ex = __expf(lgt - mx);
            float den = ex; den += shx(den, 1, ln); den += shx(den, 2, ln); den += shx(den, 4, ln); den += shx(den, 8, ln);
            af[i] = ex / den;
        }
        *(f32x4*)(AFFT + (size_t)row * NROW + r0 + 4 * kg) = af;
        unsigned char* ho = XN8 + (size_t)r0 * DM;
#pragma unroll
        for (int q = 0; q < 8; ++q)
#pragma unroll
            for (int c = 0; c < 4; ++c) asm volatile("" : "+v"(xq[q][c]));
        unsigned go = (unsigned)(32 * (ln >> 4));
#pragma unroll
        for (int q = 0; q < 8; ++q) {
            v4u o0, o1;
#pragma unroll
            for (int c = 0; c < 4; ++c) {
                const f32x4 g0 = *(const LAS f32x4*)(GS + go + 128 * q + 8 * c), g1 = *(const LAS f32x4*)(GS + go + 128 * q + 8 * c + 4);
                const f32x4 s0 = *(const LAS f32x4*)(SH + go + 128 * q + 8 * c), s1 = *(const LAS f32x4*)(SH + go + 128 * q + 8 * c + 4);
                const v4u xx = xq[q][c];
                const float h0 = __uint_as_float(xx.x << 16) * rstd * g0.x + s0.x, h1 = __uint_as_float(xx.x & 0xffff0000u) * rstd * g0.y + s0.y;
                const float h2 = __uint_as_float(xx.y << 16) * rstd * g0.z + s0.z, h3 = __uint_as_float(xx.y & 0xffff0000u) * rstd * g0.w + s0.w;
                const float h4 = __uint_as_float(xx.z << 16) * rstd * g1.x + s1.x, h5 = __uint_as_float(xx.z & 0xffff0000u) * rstd * g1.y + s1.y;
                const float h6 = __uint_as_float(xx.w << 16) * rstd * g1.z + s1.z, h7 = __uint_as_float(xx.w & 0xffff0000u) * rstd * g1.w + s1.w;
                const unsigned p0 = pk4f8(h0, h1, h2, h3), p1 = pk4f8(h4, h5, h6, h7);
                if (c == 0) { o0.x = p0; o0.y = p1; } else if (c == 1) { o0.z = p0; o0.w = p1; } else if (c == 2) { o1.x = p0; o1.y = p1; } else { o1.z = p0; o1.w = p1; }
            }
            *(v4u*)(ho + xo + 128 * q) = o0; *(v4u*)(ho + xo + 128 * q + 16) = o1;
        }
        t += 8;
        if (t < t1) { const bf16* xt = X1 + (size_t)(rbase + 16 * t) * DM;
#pragma unroll
            for (int q = 0; q < 8; ++q)
#pragma unroll
                for (int c = 0; c < 4; ++c) xq[q][c] = __builtin_nontemporal_load((const v4u*)(xt + xo + 128 * q + 8 * c)); }
    }
    __syncthreads();
}

DI int block_exscan_i(int v, LAS int* wt  , int wave, int lane, int& tot) {
    int x = v;
#pragma unroll
    for (int o = 1; o < 64; o <<= 1) { const int y = __builtin_amdgcn_ds_bpermute(((lane - o) & 63) << 2, x); if (lane >= o) x += y; }
    __syncthreads();
    if (lane == 63) wt[wave] = x;
    __syncthreads();
    int base = 0; tot = 0;
#pragma unroll
    for (int w = 0; w < 8; ++w) { const int t = wt[w]; tot += t; if (w < wave) base += t; }
    return base + x - v;
}

DI void ph_select(const Ctx& C, const Params& p, int nsets, int RPE) {
    const float* AFFT = (const float*)(p.ws + WS_AFFT); int* SLOT = (int*)(p.ws + WS_SLOT); int* IDX = (int*)(p.ws + WS_IDX); float* GATEV = (float*)(p.ws + WS_GATEV);
    LAS int* red = (LAS int*)C.lds; LAS int* wt = (LAS int*)(C.lds + 256);
    { const int nvalid = nsets == 4 ? 2112 : 2048, npad = RPE - nvalid;
      for (int i = C.vcu * NTHR + C.tid; i < NEXP * npad; i += C.G * NTHR) { const int e = i / npad, j = i % npad; IDX[e * RPE + nvalid + j] = 0; GATEV[e * RPE + nvalid + j] = 0.f; } }
    for (int task = C.vcu; task < nsets * NEXP; task += C.G) {
        const int set = task >> 4, e = task & 15;
        const int n = set < 2 ? SEQ : LC, cap = set < 2 ? 1024 : 32;
        const int rowbase = set < 2 ? set * SEQ : NLAT + (set - 2) * LC;
        const int slotbase = set < 2 ? set * 1024 : 2048 + (set - 2) * 32;
        unsigned key[16];
        const int tok0 = C.tid * 16;
#pragma unroll
        for (int q = 0; q < 4; ++q) { v4u kv = (v4u){0u, 0u, 0u, 0u}; if (tok0 + 4 * q < n) kv = *(const v4u*)(AFFT + (size_t)e * NROW + rowbase + tok0 + 4 * q); key[4 * q] = kv.x; key[4 * q + 1] = kv.y; key[4 * q + 2] = kv.z; key[4 * q + 3] = kv.w; }
        unsigned prefix = 0u;
        __syncthreads();
        for (int bit = 30; bit >= 0; --bit) {
            const unsigned cand = prefix | (1u << bit); int cnt = 0;
#pragma unroll
            for (int i = 0; i < 16; ++i) cnt += __popcll(__ballot(key[i] >= cand));
            if (C.lane == 0) red[(bit & 1) * 8 + C.wave] = cnt;
            __syncthreads();
            int total = 0;
#pragma unroll
            for (int w = 0; w < 8; ++w) total += red[(bit & 1) * 8 + w];
            if (total >= cap) prefix = cand;
        }
        const unsigned T = prefix;
        int gtc = 0, eqc = 0;
#pragma unroll
        for (int i = 0; i < 16; ++i) { gtc += (key[i] > T) ? 1 : 0; eqc += (key[i] == T) ? 1 : 0; }
        int totgt, toteq;
        (void)block_exscan_i(gtc, wt, C.wave, C.lane, totgt);
        int eqrank = block_exscan_i(eqc, wt, C.wave, C.lane, toteq);
        const int need_eq = cap - totgt;
        unsigned selmask = 0u; int selc = 0;
#pragma unroll
        for (int i = 0; i < 16; ++i) { bool s = key[i] > T; if (key[i] == T) { s = eqrank < need_eq; ++eqrank; } if (s) { selmask |= 1u << i; ++selc; } }
        int totsel;
        int slot = block_exscan_i(selc, wt, C.wave, C.lane, totsel);
#pragma unroll
        for (int i = 0; i < 16; ++i) { const int tok = tok0 + i;
            if (tok < n) { const int row = rowbase + tok;
                if (selmask & (1u << i)) { const int sp = slotbase + slot; SLOT[(size_t)row * 16 + e] = sp; IDX[e * RPE + sp] = row; GATEV[e * RPE + sp] = __uint_as_float(key[i]); ++slot; }
                else SLOT[(size_t)row * 16 + e] = -1; } }
        __syncthreads();
    }
}

DI void ph_combine(const Ctx& C, const Params& p, int l, int nrows, int RPE) {
    const float* MOD = (const float*)(p.ws + WS_MOD); const bf16* X1 = (const bf16*)(p.ws + WS_X1); const int* SLOT = (const int*)(p.ws + WS_SLOT); const bf16* Y = (const bf16*)(p.ws + WS_XS);
    bf16* X2 = (bf16*)(p.ws + WS_X2); bf16* XN = (bf16*)(p.ws + WS_XN);
    int svn[2]; f32x4 vn[2][4];
    if (C.gw < nrows) {
#pragma unroll
        for (int q = 0; q < 2; ++q) { int r = C.gw + q * C.NGW; if (r >= nrows) r = C.gw; svn[q] = (C.lane < 16) ? SLOT[(size_t)r * 16 + C.lane] : -1; load_row_h(X1 + (size_t)r * DM, C.lane, vn[q]); } }
    for (int r0 = C.gw; r0 < nrows; r0 += 2 * C.NGW) {
        int rr[2] = {r0, r0 + C.NGW}; if (rr[1] >= nrows) rr[1] = r0;
        int sv[2]; f32x4 v[2][4], acc[2][4];
#pragma unroll
        for (int q = 0; q < 2; ++q) { sv[q] = svn[q];
#pragma unroll
            for (int j = 0; j < 4; ++j) v[q][j] = vn[q][j]; }
        { const int rn0 = r0 + 2 * C.NGW;
          if (rn0 < nrows) {
#pragma unroll
            for (int q = 0; q < 2; ++q) { int r = rn0 + q * C.NGW; if (r >= nrows) r = rn0; svn[q] = (C.lane < 16) ? SLOT[(size_t)r * 16 + C.lane] : -1; load_row_h(X1 + (size_t)r * DM, C.lane, vn[q]); } } }
        unsigned msk[2]; const v2u* yp[2][4]; float fw[2][4];
#pragma unroll
        for (int q = 0; q < 2; ++q) { msk[q] = (unsigned)__ballot(sv[q] >= 0);
#pragma unroll
            for (int k = 0; k < 4; ++k) { const bool has = msk[q] != 0u; const int e = has ? __builtin_amdgcn_readfirstlane(__builtin_ctz(msk[q])) : 0; const int sl = __builtin_amdgcn_readlane(sv[q], e);
                yp[q][k] = has ? (const v2u*)(Y + ((size_t)e * RPE + sl) * DM) : (const v2u*)Y; fw[q][k] = has ? 1.0f : 0.0f; if (has) msk[q] &= msk[q] - 1; } }
        v2u w[2][4][4];
#pragma unroll
        for (int q = 0; q < 2; ++q)
#pragma unroll
            for (int k = 0; k < 4; ++k)
#pragma unroll
                for (int j = 0; j < 4; ++j) w[q][k][j] = __builtin_nontemporal_load(yp[q][k] + C.lane + 64 * j);
#pragma unroll
        for (int q = 0; q < 2; ++q)
#pragma unroll
            for (int j = 0; j < 4; ++j) { f32x4 a = (f32x4){0.f, 0.f, 0.f, 0.f};
#pragma unroll
                for (int k = 0; k < 4; ++k) { const float f = fw[q][k]; const v2u ww = w[q][k][j];
                    a.x += f * __uint_as_float(ww.x << 16); a.y += f * __uint_as_float(ww.x & 0xffff0000u); a.z += f * __uint_as_float(ww.y << 16); a.w += f * __uint_as_float(ww.y & 0xffff0000u); }
                acc[q][j] = a; }
#pragma unroll
        for (int q = 0; q < 2; ++q)
            while (msk[q]) { const int e = __builtin_amdgcn_readfirstlane(__builtin_ctz(msk[q])); msk[q] &= msk[q] - 1; const int sl = __builtin_amdgcn_readlane(sv[q], e);
                const v2u* y0 = (const v2u*)(Y + ((size_t)e * RPE + sl) * DM);
#pragma unroll
                for (int j = 0; j < 4; ++j) { const v2u ww = __builtin_nontemporal_load(y0 + C.lane + 64 * j);
                    acc[q][j].x += __uint_as_float(ww.x << 16); acc[q][j].y += __uint_as_float(ww.x & 0xffff0000u); acc[q][j].z += __uint_as_float(ww.y << 16); acc[q][j].w += __uint_as_float(ww.y & 0xffff0000u); } }
#pragma unroll
        for (int q = 0; q < 2; ++q) { const int r = rr[q]; const int mi = r < NLAT ? (r >> 13) : 2;
            const float* g2 = MOD + (size_t)(l * 3 + mi) * 6144 + 5 * 1024;
#pragma unroll
            for (int j = 0; j < 4; ++j) v[q][j] = v[q][j] + ((const f32x4*)g2)[C.lane + 64 * j] * acc[q][j];
            if (l == 0) {
#pragma unroll
                for (int j = 0; j < 4; ++j) { v2u w; w.x = cvtpk(v[q][j].x, v[q][j].y); w.y = cvtpk(v[q][j].z, v[q][j].w); __builtin_nontemporal_store(w, (v2u*)(X2 + (size_t)r * DM) + C.lane + 64 * j); }
                const float* mp = MOD + (size_t)(1 * 3 + mi) * 6144;
                modulate_row(v[q], p.in[6] + 1024, mp, mp + 1024, XN + (size_t)r * DM, C.lane);
            } else {
                const float rstd = row_rstd(v[q], 1e-6f, C.lane);
#pragma unroll
                for (int j = 0; j < 4; ++j) __builtin_nontemporal_store(v[q][j] * rstd * ((const f32x4*)p.in[8])[C.lane + 64 * j], (f32x4*)(p.out + (size_t)r * DM) + C.lane + 64 * j);
            }
        }
    }
}

constexpr int RT = 128;
constexpr int TP = 136;
DI float ret_lg2(const float* e, int hh) { return log1pf(-exp2f(-e[hh])) * LOG2E; }

DI void ph_ret_chunk_states(const Ctx& C, const Params& p) {
    const bf16* P = (const bf16*)(p.ws + WS_P); float* SCH = (float*)(p.ws + WS_SCH);
    LAS bf16* Ktf = (LAS bf16*)C.lds; LAS bf16* Ktb = Ktf + 64 * TP; LAS bf16* Vt = Ktb + 64 * TP;
    const int r32 = C.lane & 31, hi = C.lane >> 5;
    for (int u = C.vcu; u < 2 * 4 * 66; u += C.G) {
        const int cc = u % 66, hh = (u / 66) & 3, b = u / 264;
        const size_t row0 = cc < 64 ? (size_t)b * SEQ + cc * RT : (size_t)NLAT + b * LC + (cc - 64) * RT;
        const float lgf = ret_lg2(p.in[17], hh), lgb = ret_lg2(p.in[18], hh);
        v4u kv2[2], vv4[4];
#pragma unroll
        for (int k = 0; k < 2; ++k) { const int q = C.tid + k * NTHR; const int pp = q & 127, d0 = (q >> 7) * 8; kv2[k] = *(const v4u*)(P + (row0 + pp) * 2304 + 256 + hh * 64 + d0); }
#pragma unroll
        for (int k = 0; k < 4; ++k) { const int q = C.tid + k * NTHR; const int pp = q & 127, v0 = (q >> 7) * 8; vv4[k] = *(const v4u*)(P + (row0 + pp) * 2304 + 512 + hh * 128 + v0); }
#pragma unroll
        for (int k = 0; k < 2; ++k) { const int q = C.tid + k * NTHR; const int pp = q & 127, d0 = (q >> 7) * 8; const v4u kv = kv2[k];
            const float wf = exp2f(lgf * (float)(127 - pp)), wb = exp2f(lgb * (float)pp);
#pragma unroll
            for (int i = 0; i < 4; ++i) { const float k0 = __uint_as_float(kv[i] << 16), k1 = __uint_as_float(kv[i] & 0xffff0000u);
                Ktf[(d0 + 2 * i) * TP + pp] = f2bf(k0 * wf); Ktf[(d0 + 2 * i + 1) * TP + pp] = f2bf(k1 * wf); Ktb[(d0 + 2 * i) * TP + pp] = f2bf(k0 * wb); Ktb[(d0 + 2 * i + 1) * TP + pp] = f2bf(k1 * wb); } }
#pragma unroll
        for (int k = 0; k < 4; ++k) { const int q = C.tid + k * NTHR; const int pp = q & 127, v0 = (q >> 7) * 8; const v4u vv = vv4[k];
#pragma unroll
            for (int i = 0; i < 4; ++i) { Vt[(v0 + 2 * i) * TP + pp] = (bf16)(vv[i] & 0xffffu); Vt[(v0 + 2 * i + 1) * TP + pp] = (bf16)(vv[i] >> 16); } }
        __syncthreads();
        const int db = C.wave & 1, vb = C.wave >> 1;
        f32x16 sf, sb;
#pragma unroll
        for (int i = 0; i < 16; ++i) { sf[i] = 0.f; sb[i] = 0.f; }
#pragma unroll
        for (int ks = 0; ks < 8; ++ks) {
            const bf16x8 af = *(const LAS bf16x8*)(Ktf + (32 * db + r32) * TP + 16 * ks + 8 * hi);
            const bf16x8 ab = *(const LAS bf16x8*)(Ktb + (32 * db + r32) * TP + 16 * ks + 8 * hi);
            const bf16x8 bv = *(const LAS bf16x8*)(Vt + (32 * vb + r32) * TP + 16 * ks + 8 * hi);
            sf = MFMA32(af, bv, sf); sb = MFMA32(ab, bv, sb);
        }
        float* of = SCH + ((((size_t)0 * 2 + b) * 4 + hh) * 66 + cc) * 8192; float* ob = SCH + ((((size_t)1 * 2 + b) * 4 + hh) * 66 + cc) * 8192;
#pragma unroll
        for (int i = 0; i < 16; ++i) { const int d = 32 * db + crow(i, hi); of[d * 128 + 32 * vb + r32] = sf[i]; ob[d * 128 + 32 * vb + r32] = sb[i]; }
        __syncthreads();
    }
}

DI void ph_ret_scan(const Ctx& C, const Params& p) {
    const float* SCH = (const float*)(p.ws + WS_SCH); float* RST = (float*)(p.ws + WS_RST);
    for (int i = C.vcu * NTHR + C.tid; i < 2 * 2 * 4 * 8192; i += C.G * NTHR) {
        const int el = i & 8191, hh = (i >> 13) & 3, b = (i >> 15) & 1, dir = i >> 16;
        const float g128 = exp2f(ret_lg2(dir == 0 ? p.in[17] : p.in[18], hh) * 128.0f);
        const float* S = SCH + (((size_t)dir * 2 + b) * 4 + hh) * 66 * 8192 + el;
        float* R = RST + (((size_t)dir * 2 + b) * 4 + hh) * 64 * 8192 + el;
        float st;
        if (dir == 0) { st = S[64 * 8192]; st = st * g128 + S[65 * 8192]; }
        else { st = S[65 * 8192]; st = st * g128 + S[64 * 8192]; }
        const long step = dir == 0 ? 8192 : -8192;
        const float* Sp = S + (dir == 0 ? 0 : (size_t)63 * 8192); float* Rp = R + (dir == 0 ? 0 : (size_t)63 * 8192);
#pragma unroll 1
        for (int c0 = 0; c0 < 64; c0 += 8) {
            float sv[8];
#pragma unroll
            for (int j = 0; j < 8; ++j) sv[j] = __builtin_nontemporal_load(Sp + j * step);
#pragma unroll
            for (int j = 0; j < 8; ++j) { Rp[j * step] = st; st = st * g128 + sv[j]; }
            Sp += 8 * step; Rp += 8 * step;
        }
    }
}

DI void ph_ret_output(const Ctx& C, const Params& p) {
    const bf16* P = (const bf16*)(p.ws + WS_P); const float* RST = (const float*)(p.ws + WS_RST); bf16* CAT = (bf16*)(p.ws + WS_CAT);
    constexpr int T2 = 256, KP = 72, VP = 260;
    LAS bf16* Ks = (LAS bf16*)C.lds;
    LAS bf16* Vt = Ks + T2 * KP;
    LAS bf16* Rtf = Vt + 128 * VP;
    LAS bf16* Rtb = Rtf + 128 * 72;
    const int r32 = C.lane & 31, hi = C.lane >> 5;
    const float* gn = p.in[19];
    for (int u = C.vcu; u < 2 * 4 * 32; u += C.G) {
        const int c2 = u & 31, hh = (u >> 5) & 3, b = u >> 7;
        const size_t row0 = (size_t)b * SEQ + c2 * T2;
        const float lgf = ret_lg2(p.in[17], hh), lgb = ret_lg2(p.in[18], hh);
        const float* Rf = RST + ((((size_t)0 * 2 + b) * 4 + hh) * 64 + 2 * c2) * 8192; const float* Rb = RST + ((((size_t)1 * 2 + b) * 4 + hh) * 64 + 2 * c2 + 1) * 8192;
        const int pl = 32 * C.wave + r32;
        const bf16* Pu = P + row0 * 2304 + hh * 64;
        unsigned tq = (unsigned)C.tid; asm volatile("" : "+v"(tq));
        unsigned gK = (tq >> 3) * 2304u + 256u + (tq & 7u) * 8u;            asm volatile("" : "+v"(gK));
        unsigned gV = (tq & 255u) * 2304u + 512u + (tq >> 8) * 8u;          asm volatile("" : "+v"(gV));
        unsigned gR = (tq & 63u) * 128u + (tq >> 6) * 4u;                   asm volatile("" : "+v"(gR));
        unsigned gQ = (unsigned)pl * 2304u + 8u * (unsigned)hi;             asm volatile("" : "+v"(gQ));
        unsigned lK = (tq >> 3) * (unsigned)KP + (tq & 7u) * 8u;            asm volatile("" : "+v"(lK));
        unsigned lV = (tq >> 8) * 8u * (unsigned)VP + (tq & 255u);          asm volatile("" : "+v"(lV));
        unsigned lR = (tq >> 6) * 4u * 72u + (tq & 63u);                    asm volatile("" : "+v"(lR));
        v4u kk4[4], vv8[8]; f32x4 ra[4], rb4[4]; bf16x8 qf[4];
#pragma unroll
        for (int k = 0; k < 4; ++k) kk4[k] = *(const v4u*)((Pu + (size_t)k * 64 * 2304) + gK);
        { const bf16* Pv = Pu + hh * 64;
#pragma unroll
          for (int k = 0; k < 8; ++k) vv8[k] = *(const v4u*)(Pv + gV + 16 * k); }
#pragma unroll
        for (int k = 0; k < 4; ++k) { ra[k] = *(const f32x4*)(Rf + gR + 32 * k); rb4[k] = *(const f32x4*)(Rb + gR + 32 * k); }
#pragma unroll
        for (int d0 = 0; d0 < 4; ++d0) qf[d0] = *(const bf16x8*)(Pu + gQ + 16 * d0);
#pragma unroll
        for (int k = 0; k < 4; ++k) *(LAS v4u*)(Ks + lK + 64 * k * KP) = kk4[k];
#pragma unroll
        for (int k = 0; k < 8; ++k) { const v4u vv = vv8[k];
#pragma unroll
            for (int i = 0; i < 4; ++i) { Vt[lV + (16 * k + 2 * i) * VP] = (bf16)(vv[i] & 0xffffu); Vt[lV + (16 * k + 2 * i + 1) * VP] = (bf16)(vv[i] >> 16); } }
#pragma unroll
        for (int k = 0; k < 4; ++k) {
#pragma unroll
            for (int i = 0; i < 4; ++i) { Rtf[lR + (32 * k + i) * 72] = f2bf(ra[k][i]); Rtb[lR + (32 * k + i) * 72] = f2bf(rb4[k][i]); } }
        __syncthreads();
        unsigned lKr = (unsigned)(r32 * KP + 8 * hi);  asm volatile("" : "+v"(lKr));
        unsigned lVr = (unsigned)(r32 * VP + 4 * hi);  asm volatile("" : "+v"(lVr));
        unsigned lRr = (unsigned)(r32 * 72 + 8 * hi);  asm volatile("" : "+v"(lRr));
        f32x16 o[4];
#pragma unroll
        for (int vb = 0; vb < 4; ++vb)
#pragma unroll
            for (int i = 0; i < 16; ++i) o[vb][i] = 0.f;
#pragma unroll 1
        for (int sb = 0; sb < 8; ++sb) {
            bf16x8 kf[4];
#pragma unroll
            for (int d0 = 0; d0 < 4; ++d0) kf[d0] = *(const LAS bf16x8*)(Ks + lKr + 32 * sb * KP + 16 * d0);
            f32x16 st;
#pragma unroll
            for (int i = 0; i < 16; ++i) st[i] = 0.f;
#pragma unroll
            for (int d0 = 0; d0 < 4; ++d0) st = MFMA32(kf[d0], qf[d0], st);
#pragma unroll
            for (int i = 0; i < 16; ++i) { const int sx = 32 * sb + crow(i, hi); const int df = pl - sx; const float w = df >= 0 ? exp2f(lgf * (float)df) : exp2f(lgb * (float)(-df)); st[i] *= w; }
#pragma unroll
            for (int ks = 0; ks < 2; ++ks) {
                v4u pw; pw.x = cvtpk(st[8 * ks + 0], st[8 * ks + 1]); pw.y = cvtpk(st[8 * ks + 2], st[8 * ks + 3]); pw.z = cvtpk(st[8 * ks + 4], st[8 * ks + 5]); pw.w = cvtpk(st[8 * ks + 6], st[8 * ks + 7]);
                const bf16x8 pa = __builtin_bit_cast(bf16x8, pw);
                const int s0 = 32 * sb + 16 * ks;
#pragma unroll
                for (int vb = 0; vb < 4; ++vb) { const LAS bf16* vp = Vt + lVr + s0 + 32 * vb * VP; const v2u lo = *(const LAS v2u*)vp, hh2 = *(const LAS v2u*)(vp + 8);
                    v4u vw; vw.x = lo.x; vw.y = lo.y; vw.z = hh2.x; vw.w = hh2.y; o[vb] = MFMA32(pa, __builtin_bit_cast(bf16x8, vw), o[vb]); }
            }
        }
        {
            const float xf = exp2f(lgf * (float)(pl + 1)), xb = exp2f(lgb * (float)(T2 - pl));
#pragma unroll
            for (int d0 = 0; d0 < 4; ++d0) {
                const v4u qw = __builtin_bit_cast(v4u, qf[d0]); v4u af, ab;
#pragma unroll
                for (int i = 0; i < 4; ++i) { const float q0 = __uint_as_float(qw[i] << 16), q1 = __uint_as_float(qw[i] & 0xffff0000u); af[i] = cvtpk(q0 * xf, q1 * xf); ab[i] = cvtpk(q0 * xb, q1 * xb); }
                const bf16x8 aF = __builtin_bit_cast(bf16x8, af), aB = __builtin_bit_cast(bf16x8, ab);
#pragma unroll
                for (int vb = 0; vb < 4; ++vb) { const bf16x8 rf = *(const LAS bf16x8*)(Rtf + lRr + 32 * vb * 72 + 16 * d0); const bf16x8 rb = *(const LAS bf16x8*)(Rtb + lRr + 32 * vb * 72 + 16 * d0);
                    o[vb] = MFMA32(aF, rf, o[vb]); o[vb] = MFMA32(aB, rb, o[vb]); }
            }
        }
        {
            float gnv[4];
#pragma unroll
            for (int vb = 0; vb < 4; ++vb) gnv[vb] = gn[hh * 128 + 32 * vb + r32];
            unsigned gpk[32];
            { const bf16* gu = P + row0 * 2304 + 1024 + hh * 128; unsigned gl = (unsigned)((32 * C.wave + 4 * hi) * 2304 + r32); asm volatile("" : "+v"(gl));
#pragma unroll
              for (int i = 0; i < 16; ++i) { const bf16* gp = (gu + ((i & 3) + 8 * (i >> 2)) * 2304) + gl; gpk[2 * i] = (unsigned)gp[0] | ((unsigned)gp[32] << 16); gpk[2 * i + 1] = (unsigned)gp[64] | ((unsigned)gp[96] << 16); } }
            float mu[16], var[16];
            unsigned ol = (unsigned)((32 * C.wave + 4 * hi) * 1024 + r32); asm volatile("" : "+v"(ol));
#pragma unroll
            for (int i = 0; i < 16; ++i) mu[i] = (o[0][i] + o[1][i]) + (o[2][i] + o[3][i]);
#pragma unroll
            for (int ofs = 1; ofs < 32; ofs <<= 1) {
#pragma unroll
                for (int i = 0; i < 16; ++i) mu[i] += shx(mu[i], ofs, C.lane); }
#pragma unroll
            for (int i = 0; i < 16; ++i) { mu[i] *= (1.0f / 128.0f); float a = 0.f;
#pragma unroll
                for (int vb = 0; vb < 4; ++vb) { o[vb][i] -= mu[i]; a += o[vb][i] * o[vb][i]; }
                var[i] = a; }
#pragma unroll
            for (int ofs = 1; ofs < 32; ofs <<= 1) {
#pragma unroll
                for (int i = 0; i < 16; ++i) var[i] += shx(var[i], ofs, C.lane); }
#pragma unroll
            for (int i = 0; i < 16; ++i) { const float rs = rsqrtf(var[i] * (1.0f / 128.0f) + 1e-5f);
                bf16* op = (CAT + row0 * 1024 + hh * 128 + ((i & 3) + 8 * (i >> 2)) * 1024) + ol;
#pragma unroll
                for (int vb = 0; vb < 4; ++vb) { const unsigned gw2 = gpk[2 * i + (vb >> 1)]; const float g = (vb & 1) ? __uint_as_float(gw2 & 0xffff0000u) : __uint_as_float(gw2 << 16);
                    op[32 * vb] = f2bf(o[vb][i] * rs * gnv[vb] * (g / (1.f + __expf(-g)))); } }
        }
        __syncthreads();
    }
}

typedef __attribute__((address_space(1))) unsigned gu32;
#define XB_TMO      128
#define XB_XCNT(j)  (256  + 64 * (j))
#define XB_XSUB(j)  (1280 + 64 * (j))
#define XB_XGEN(j)  (2304 + 64 * (j))
#define XB_TOP      3328
#define XB_TOPGEN   3392
#define XCD_BAR_WORDS 3456
#define XB_SPIN_CAP (1u << 18)

__device__ __forceinline__ unsigned xb_ld(unsigned* p)              { return __hip_atomic_load(p, __ATOMIC_RELAXED, __HIP_MEMORY_SCOPE_AGENT); }
__device__ __forceinline__ unsigned xb_add(unsigned* p, unsigned v) { return __hip_atomic_fetch_add(p, v, __ATOMIC_RELAXED, __HIP_MEMORY_SCOPE_AGENT); }
__device__ __forceinline__ unsigned xb_xcc_id() { return (unsigned)__builtin_amdgcn_s_getreg((3 << 11) | 20) & 0xFu; }
#define XB_SPIN(cond, bar) do { unsigned _sp = 0; while (cond) { __builtin_amdgcn_s_sleep(1); \
    if ((++_sp & 255u) == 0u) { if (xb_ld(&(bar)[XB_TMO])) break; if (_sp > XB_SPIN_CAP) { atomicAdd(&(bar)[XB_TMO], 1u); break; } } } } while (0)

struct XcdBarrier {
    unsigned* bar; unsigned x;
    volatile LAS unsigned* st;
};

__device__ __forceinline__ XcdBarrier xcd_barrier_post(unsigned* bar, volatile LAS unsigned* st) {
    XcdBarrier b; b.bar = bar; b.x = xb_xcc_id(); b.st = st;
    if (threadIdx.x == 0) (void)xb_add(&bar[XB_XCNT(b.x)], 1u);
    return b;
}
__device__ __forceinline__ void xcd_barrier_complete(unsigned* bar, unsigned x, unsigned& nloc, unsigned& nx) {
    const unsigned G = gridDim.x * gridDim.y * gridDim.z;
    unsigned sum, cnt, mine, sp = 0u;
    for (;;) {
        sum = 0u; cnt = 0u; mine = 0u;
#pragma unroll
        for (unsigned j = 0; j < 16; ++j) { const unsigned c = xb_ld(&bar[XB_XCNT(j)]); sum += c; cnt += (c > 0u) ? 1u : 0u; mine = (j == x) ? c : mine; }
        if (sum == G) break;
        __builtin_amdgcn_s_sleep(1);
        if ((++sp & 255u) == 0u) { if (xb_ld(&bar[XB_TMO])) break; if (sp > XB_SPIN_CAP) { atomicAdd(&bar[XB_TMO], 1u); break; } }
    }
    nloc = mine > 0u ? mine : 1u; nx = cnt > 0u ? cnt : 1u;
}

__device__ __forceinline__ void xcd_barrier(const XcdBarrier& b) {
    asm volatile("s_waitcnt vmcnt(0)" ::: "memory");
    __syncthreads();
    if (threadIdx.x == 0) {
        unsigned* bar = b.bar;
        __builtin_amdgcn_s_waitcnt(0);
        unsigned nloc = b.st[0], nx = b.st[1];
        if (nloc == 0u) { xcd_barrier_complete(bar, b.x, nloc, nx); b.st[0] = nloc; b.st[1] = nx; }
        const unsigned old = xb_add(&bar[XB_XSUB(b.x)], 1u);
        const unsigned gen = old / nloc;
        if (old + 1u == (gen + 1u) * nloc) {
            __builtin_amdgcn_fence(__ATOMIC_RELEASE, "agent");
            asm volatile("s_waitcnt vmcnt(0)" ::: "memory");
            const unsigned og = xb_add(&bar[XB_TOP], 1u);
            const unsigned tg = og / nx;
            if (og + 1u == (tg + 1u) * nx) xb_add(&bar[XB_TOPGEN], 1u);
            else XB_SPIN(xb_ld(&bar[XB_TOPGEN]) == tg, bar);
            __builtin_amdgcn_fence(__ATOMIC_ACQUIRE, "agent");
            xb_add(&bar[XB_XGEN(b.x)], 1u);
            asm volatile("s_waitcnt vmcnt(0)" ::: "memory");
        } else {
            XB_SPIN(xb_ld(&bar[XB_XGEN(b.x)]) == gen, bar);
            __builtin_amdgcn_fence(__ATOMIC_ACQUIRE, "agent");
            asm volatile("s_waitcnt vmcnt(0)" ::: "memory");
        }
    }
    __syncthreads();
}

__global__ void __launch_bounds__(NTHR, 2) fwd_megakernel(Params p_unused) {
    extern __shared__ __attribute__((aligned(16))) unsigned char lds_raw[];
    {
        volatile LAS unsigned* st = (volatile LAS unsigned*)((LAS unsigned char*)lds_raw + LDS_MISC);
        if (threadIdx.x < 8) st[threadIdx.x] = 0u;
        __syncthreads();
        KP kp0 = (KP)__builtin_amdgcn_kernarg_segment_ptr();
        (void)xcd_barrier_post((unsigned*)(kp0->ws + WS_CTL), st);
    }
#define GRID_SYNC() do { KP kpb = (KP)__builtin_amdgcn_kernarg_segment_ptr(); asm volatile("" : "+s"(kpb) :: "memory"); XcdBarrier bb; bb.bar = (unsigned*)(kpb->ws + WS_CTL); bb.x = xb_xcc_id(); \
        bb.st = (volatile LAS unsigned*)((LAS unsigned char*)lds_raw + LDS_MISC); xcd_barrier(bb); } while (0)
#define ENV() Params p; Ctx C; env(p, C, lds_raw); unsigned char* ws = p.ws; LAS unsigned char* ring = C.lds; (void)ws; (void)ring

    { ENV(); ph0_prologue(C, p); }
    GRID_SYNC();
    { ENV(); ph_modulate0(C, p); }
    GRID_SYNC();
    {
        ENV();
        pg8::Gemm g{(const pg8::bf16_t*)(ws + WS_XN), (const pg8::bf16_t*)(ws + WS_WABIN), NROW, 1280, 1024}; pg8::StaticOrder S; S.init(NROW, 1280, C.G, (int)blockIdx.x);
        pg8::EpiStoreBf16 E{(pg8::bf16_t*)(ws + WS_P), 1280, 0, nullptr};
        pg8::gemm_phase<pg8::EpiStoreBf16, pg8::StaticOrder, true, true>(ring, g, S, E);
    }
    { ENV(); convert_slot(C, p, 0, (int)blockIdx.x); }
    GRID_SYNC();
    { ENV(); ph_post0(C, p); }
    GRID_SYNC();
    { ENV(); ph_attn_dense(C, p, lds_raw); }
    GRID_SYNC();
    {
        ENV();
        pg8::Gemm g{(const pg8::bf16_t*)(ws + WS_CAT), (const pg8::bf16_t*)(ws + WS_WABOUT), NROW, 1024, 1024}; pg8::StaticOrder S; S.init(NROW, 1024, C.G, (int)blockIdx.x);
        pg8::EpiResid<false> E{p.in[0], p.in[2], (const float*)(ws + WS_MOD), 2, (pg8::bf16_t*)(ws + WS_X1)};
        pg8::gemm_phase<pg8::EpiResid<false>, pg8::StaticOrder, true, true>(ring, g, S, E);
    }
    { ENV(); convert_slot(C, p, 1, (int)blockIdx.x); }
    GRID_SYNC();
    { ENV(); ph_ffn_norm_router(C, p, 0, NROW); }
    GRID_SYNC();
    { ENV(); ph_select(C, p, 4, 2304); }
    { ENV(); convert_slot(C, p, 2, C.vcu); }
    GRID_SYNC();
    {
        ENV();
        pg8::Gemm g{(const pg8::bf16_t*)(ws + WS_XN), (const pg8::bf16_t*)(ws + WS_WGU), NEXP * 2304, NEXP * 4096, 512}; pg8::MoeOrder S; S.init(9, 16, NEXP, C.G, C.vcu);
        LAS unsigned* gtab = (LAS unsigned*)(C.lds + 131072);
        { const int* IDX = (const int*)(ws + WS_IDX); pg8::Unit u; for (int i = 0; S.next(i, u); ++i) if (C.tid < 256) gtab[i * 256 + C.tid] = (unsigned)IDX[u.pm * 256 + C.tid] * 1024u; }
        __syncthreads();
        pg8::EpiSwiGLU8 E{(unsigned char*)(ws + WS_ACT), WINV};
        pg8::gemm_phase<pg8::EpiSwiGLU8, pg8::MoeOrder, true, true, true, true>(ring, g, S, E, gtab);
    }
    GRID_SYNC();
    {
        ENV();
        pg8::Gemm g{(const pg8::bf16_t*)(ws + WS_ACT), (const pg8::bf16_t*)(ws + WS_WD), NEXP * 2304, NEXP * 1024, 1024}; pg8::MoeOrder S; S.init(9, 4, NEXP, C.G, C.vcu);
        pg8::EpiDown E{(pg8::bf16_t*)(ws + WS_XS), (const float*)(ws + WS_GATEV), WINV};
        pg8::gemm_phase<pg8::EpiDown, pg8::MoeOrder, true, true, true>(ring, g, S, E);
    }
    { ENV(); convert_slot(C, p, 3, C.vcu); }
    GRID_SYNC();
    { ENV(); ph_combine(C, p, 0, NROW, 2304); }
    GRID_SYNC();
    {
        ENV();
        pg8::Gemm g{(const pg8::bf16_t*)(ws + WS_XN), (const pg8::bf16_t*)(ws + WS_WCDIN), NROW, 2304, 1024}; pg8::StaticOrder S; S.init(NROW, 2304, C.G, (int)blockIdx.x);
        pg8::EpiStoreBf16 E{(pg8::bf16_t*)(ws + WS_P), 2304, 0, nullptr};
        pg8::gemm_phase<pg8::EpiStoreBf16, pg8::StaticOrder, true, true>(ring, g, S, E);
    }
    { ENV(); convert_slot(C, p, 4, (int)blockIdx.x); }
    GRID_SYNC();
    { ENV(); ph_post1(C, p); }
    GRID_SYNC();
    { ENV(); ph_ret_chunk_states(C, p); }
    GRID_SYNC();
    { ENV(); ph_ret_scan(C, p); }
    GRID_SYNC();
    { ENV(); ph_ret_output(C, p); }
    { ENV(); ph_attn_window(C, p, lds_raw); }
    GRID_SYNC();
    {
        ENV();
        pg8::Gemm g{(const pg8::bf16_t*)(ws + WS_CAT), (const pg8::bf16_t*)(ws + WS_WCDOUT), NLAT, 1024, 1024}; pg8::StaticOrder S; S.init(NLAT, 1024, C.G, (int)blockIdx.x);
        pg8::EpiResid<true> E{(const void*)(ws + WS_X2), (const void*)((const pg8::bf16_t*)(ws + WS_X2) + (size_t)NLAT * DM), (const float*)(ws + WS_MOD) + 3 * 6144, 2, (pg8::bf16_t*)(ws + WS_X1)};
        pg8::gemm_phase<pg8::EpiResid<true>, pg8::StaticOrder, true, true>(ring, g, S, E);
    }
    GRID_SYNC();
    { ENV(); ph_ffn_norm_router(C, p, 1, NLAT); }
    GRID_SYNC();
    { ENV(); ph_select(C, p, 2, 2048); }
    { ENV(); convert_slot(C, p, 5, C.vcu); }
    GRID_SYNC();
    {
        ENV();
        pg8::Gemm g{(const pg8::bf16_t*)(ws + WS_XN), (const pg8::bf16_t*)(ws + WS_WGU + (size_t)NEXP * 4096 * 1024), NEXP * 2048, NEXP * 4096, 512}; pg8::MoeOrder S; S.init(8, 16, NEXP, C.G, C.vcu);
        LAS unsigned* gtab = (LAS unsigned*)(C.lds + 131072);
        { const int* IDX = (const int*)(ws + WS_IDX); pg8::Unit u; for (int i = 0; S.next(i, u); ++i) if (C.tid < 256) gtab[i * 256 + C.tid] = (unsigned)IDX[u.pm * 256 + C.tid] * 1024u; }
        __syncthreads();
        pg8::EpiSwiGLU8 E{(unsigned char*)(ws + WS_ACT), WINV};
        pg8::gemm_phase<pg8::EpiSwiGLU8, pg8::MoeOrder, true, true, true, true>(ring, g, S, E, gtab);
    }
    GRID_SYNC();
    {
        ENV();
        pg8::Gemm g{(const pg8::bf16_t*)(ws + WS_ACT), (const pg8::bf16_t*)(ws + WS_WD + (size_t)NEXP * 1024 * 2048), NEXP * 2048, NEXP * 1024, 1024}; pg8::MoeOrder S; S.init(8, 4, NEXP, C.G, C.vcu);
        pg8::EpiDown E{(pg8::bf16_t*)(ws + WS_XS), (const float*)(ws + WS_GATEV), WINV};
        pg8::gemm_phase<pg8::EpiDown, pg8::MoeOrder, true, true, true>(ring, g, S, E);
    }
    GRID_SYNC();
    { ENV(); ph_combine(C, p, 1, NLAT, 2048); }
}

extern "C" void kernel_launch(void* const* d_in, const int* in_sizes, int n_in, void* d_out, int out_size, void* d_ws, size_t ws_size, hipStream_t stream) {
    static int grid = 0;
    if (grid == 0) {
        if (n_in != 25 || ws_size < WS_END) { fprintf(stderr, "kernel_launch: unexpected inputs (n_in %d, ws %zu)\n", n_in, ws_size); grid = -1; return; }
        int dev = 0, cus = 0, per_cu = 0;
        if (hipGetDevice(&dev) != hipSuccess || hipDeviceGetAttribute(&cus, hipDeviceAttributeMultiprocessorCount, dev) != hipSuccess) { grid = -1; return; }
        if (hipFuncSetAttribute((const void*)fwd_megakernel, hipFuncAttributeMaxDynamicSharedMemorySize, LDS_BYTES) != hipSuccess) { fprintf(stderr, "kernel_launch: hipFuncSetAttribute failed\n"); grid = -1; return; }
        if (hipOccupancyMaxActiveBlocksPerMultiprocessor(&per_cu, (const void*)fwd_megakernel, NTHR, LDS_BYTES) != hipSuccess || per_cu < 1) { fprintf(stderr, "kernel_launch: occupancy query says %d\n", per_cu); (void)hipGetLastError(); grid = -1; return; }
        grid = cus;
    }
    if (grid < 0) return;
    if (hipMemsetAsync((char*)d_ws + WS_CTL, 0, CTL_BYTES, stream) != hipSuccess) { fprintf(stderr, "kernel_launch: hipMemsetAsync failed\n"); return; }
    Params prm{};
    for (int i = 0; i < 25; ++i) prm.in[i] = (const float*)d_in[i];
    prm.out = (float*)d_out; prm.ws = (unsigned char*)d_ws; prm.pad = 0ull;
    void* args[] = {&prm};
    hipError_t e = hipLaunchCooperativeKernel((const void*)fwd_megakernel, dim3(grid), dim3(NTHR), args, LDS_BYTES, stream);
    if (e != hipSuccess) fprintf(stderr, "kernel_launch: cooperative launch failed: %s (grid %d)\n", hipGetErrorString(e), grid);
}
```

```cpp
#include <hip/hip_runtime.h>
#include <hip/hip_bf16.h>
#include <cmath>
#include <cstdio>
#include <cstdint>
namespace pg8 {
#define PG8_LAS __attribute__((address_space(3)))
typedef unsigned short bf16_t;
typedef short bf16x8 __attribute__((ext_vector_type(8)));
typedef float f32x4 __attribute__((ext_vector_type(4)));
typedef unsigned u32x4 __attribute__((ext_vector_type(4)));
constexpr int BM = 256, BK = 64, HALF = 128, HTB = HALF * BK * 2  , STAGE_BYTES = 8 * HTB, NXCD = 8, WGM = 8;

__host__ __device__ __forceinline__ int lds_byte(int r, int c) { const int st = (r >> 4) * 2 + (c >> 5), rr = r & 15, cc = c & 31, ob = rr * 64 + cc * 2; return st * 1024 + (ob ^ (((ob >> 9) & 1) << 5)); }
__host__ __device__ __forceinline__ void stage_rc(int b, int& R, int& C) { const int st = b / 1024, sb = b % 1024, swz = sb ^ (((sb >> 9) & 1) << 5); R = (st >> 1) * 16 + swz / 64; C = (st & 1) * 32 + (swz % 64) / 2; }
__host__ __device__ __forceinline__ int perm32(int rho) { const int n = rho >> 4, i = rho & 15; return 8 * (i >> 2) + 4 * n + (i & 3); }

struct Unit { int pm, pn; };
struct Gemm { const bf16_t* A; const bf16_t* Bt; int M, N, K; };

struct StaticOrder {
    int nM, nN, nwg, G, c;
    __host__ __device__ void init(int M, int N, int G_, int c_) { nM = M / BM; nN = N / BM; nwg = nM * nN; G = G_; c = c_; }
    __host__ __device__ bool next(int i, Unit& u) const {
        const long L = (long)i * G + c; if (L >= nwg) return false;
        int wgid = (int)L; { const int q = nwg / NXCD, r = nwg % NXCD, xcd = wgid % NXCD, off = wgid / NXCD; wgid = (xcd < r ? xcd * (q + 1) : r * (q + 1) + (xcd - r) * q) + off; }
        const int nig = WGM * nN, gid = wgid / nig, fm = gid * WGM, gsz = (nM - fm) < WGM ? (nM - fm) : WGM;
        u.pm = fm + ((wgid % nig) % gsz); u.pn = (wgid % nig) / gsz; return true;
    }
    __device__ __forceinline__ void a_ready(const Unit&) const {}
    __device__ __forceinline__ void done(const Unit&) const {}
    __device__ __forceinline__ bool half(const Unit&) const { return false; }
};

__device__ __forceinline__ unsigned cvt_pk_bf16(float lo, float hi) { unsigned r; asm volatile("v_cvt_pk_bf16_f32 %0, %1, %2" : "=v"(r) : "v"(lo), "v"(hi)); return r; }
typedef float f32x2e __attribute__((ext_vector_type(2)));
typedef __bf16 bf16x2e __attribute__((ext_vector_type(2)));
__device__ __forceinline__ unsigned cvtpk_e(float lo, float hi) { f32x2e v = {lo, hi}; bf16x2e b = __builtin_convertvector(v, bf16x2e); return __builtin_bit_cast(unsigned, b); }
__device__ __forceinline__ u32x4 pack8(const f32x4 a, const f32x4 b) { u32x4 w; w.x = cvtpk_e(a[0], a[1]); w.y = cvtpk_e(a[2], a[3]); w.z = cvtpk_e(b[0], b[1]); w.w = cvtpk_e(b[2], b[3]); return w; }

struct EpiStoreBf16 {
    static constexpr bool PERM = true, AFTER_DRAIN = false;
    bf16_t* O; int ldc; int ocol0; const float* colscale;
    __device__ __forceinline__ void operator()(const f32x4 (&acc)[2][2][4][2], const Unit& u, int wr, int wc, int fr, int fq) const {
        const int row0 = u.pm * BM + wr * 64 + fr, col0 = u.pn * BM + wc * 32 + 8 * fq;
        f32x4 cs[2][2];
#pragma unroll
        for (int bj = 0; bj < 2; ++bj)
#pragma unroll
            for (int n = 0; n < 2; ++n) cs[bj][n] = colscale ? *(const f32x4*)(colscale + col0 + bj * HALF + 4 * n) : (f32x4){1.f, 1.f, 1.f, 1.f};
#pragma unroll
        for (int ai = 0; ai < 2; ++ai)
#pragma unroll
            for (int m = 0; m < 4; ++m) { bf16_t* rowp = O + (size_t)(row0 + ai * HALF + m * 16) * ldc + ocol0 + col0;
#pragma unroll
                for (int bj = 0; bj < 2; ++bj) *(u32x4*)(rowp + bj * HALF) = pack8(acc[ai][bj][m][0] * cs[bj][0], acc[ai][bj][m][1] * cs[bj][1]); }
    }
};

template <bool SRC_BF16> struct EpiResid {
    static constexpr bool PERM = false, AFTER_DRAIN = false;
    const void* xlat; const void* xctx; const float* modl; int chunk; bf16_t* out;
    typedef unsigned u32x2 __attribute__((ext_vector_type(2)));
    __device__ __forceinline__ void load_group(const float* srcf, const bf16_t* srch, size_t off, f32x4 (&xv)[2][2]) const {
#pragma unroll
        for (int bj = 0; bj < 2; ++bj)
#pragma unroll
            for (int n = 0; n < 2; ++n) {
                if (SRC_BF16) { const u32x2 w = __builtin_nontemporal_load((const u32x2*)(srch + off + bj * HALF + n * 16)); xv[bj][n] = (f32x4){__uint_as_float(w.x << 16), __uint_as_float(w.x & 0xffff0000u), __uint_as_float(w.y << 16), __uint_as_float(w.y & 0xffff0000u)}; }
                else xv[bj][n] = __builtin_nontemporal_load((const f32x4*)(srcf + off + bj * HALF + n * 16)); }
    }
    __device__ __forceinline__ void operator()(const f32x4 (&acc)[2][2][4][2], const Unit& u, int wr, int wc, int fr, int fq) const {
        const int pm = u.pm; const int mi = pm < 64 ? (pm >> 5) : 2;
        const float* g = modl + mi * 6144 + chunk * 1024;
        const size_t rowoff = pm < 64 ? (size_t)pm * 256 * 1024 : (size_t)(pm - 64) * 256 * 1024;
        const float* srcf = (const float*)(pm < 64 ? xlat : xctx) + (SRC_BF16 ? 0 : rowoff);
        const bf16_t* srch = (const bf16_t*)(pm < 64 ? xlat : xctx) + (SRC_BF16 ? rowoff : 0);
        bf16_t* dst = out + (size_t)pm * 256 * 1024;
        const int rl = wr * 64 + fr, col0 = u.pn * BM + wc * 32 + 4 * fq;
        f32x4 gv[2][2];
#pragma unroll
        for (int bj = 0; bj < 2; ++bj)
#pragma unroll
            for (int n = 0; n < 2; ++n) gv[bj][n] = *(const f32x4*)(g + col0 + bj * HALF + n * 16);
        f32x4 xa[2][2], xb[2][2];
        load_group(srcf, srch, (size_t)rl * 1024 + col0, xa);
#define EPIRESID_STEP(q, XC, XN) do { const int ai = (q) >> 2, m = (q) & 3; const size_t off = (size_t)(rl + ai * HALF + m * 16) * 1024 + col0; \
            if ((q) < 7) { const int ai2 = ((q) + 1) >> 2, m2 = ((q) + 1) & 3; load_group(srcf, srch, (size_t)(rl + ai2 * HALF + m2 * 16) * 1024 + col0, XN); } \
            _Pragma("unroll") for (int bj = 0; bj < 2; ++bj) _Pragma("unroll") for (int n = 0; n < 2; ++n) { const f32x4 o = XC[bj][n] + gv[bj][n] * acc[ai][bj][m][n]; \
                u32x2 ow; ow.x = cvtpk_e(o[0], o[1]); ow.y = cvtpk_e(o[2], o[3]); *(u32x2*)(dst + off + bj * HALF + n * 16) = ow; } } while (0)
        EPIRESID_STEP(0, xa, xb); EPIRESID_STEP(1, xb, xa); EPIRESID_STEP(2, xa, xb); EPIRESID_STEP(3, xb, xa);
        EPIRESID_STEP(4, xa, xb); EPIRESID_STEP(5, xb, xa); EPIRESID_STEP(6, xa, xb); EPIRESID_STEP(7, xb, xa);
#undef EPIRESID_STEP
    }
};

struct EpiSwiGLU {
    static constexpr bool PERM = true, AFTER_DRAIN = false;
    bf16_t* ACT;
    __device__ __forceinline__ void operator()(const f32x4 (&acc)[2][2][4][2], const Unit& u, int wr, int wc, int fr, int fq) const {
        const int row0 = u.pm * BM + wr * 64 + fr, col0 = (u.pn & 15) * 128 + wc * 32 + 8 * fq;
#pragma unroll
        for (int ai = 0; ai < 2; ++ai)
#pragma unroll
            for (int m = 0; m < 4; ++m) { bf16_t* rowp = ACT + (size_t)(row0 + ai * HALF + m * 16) * 2048 + col0;
                f32x4 r[2];
#pragma unroll
                for (int n = 0; n < 2; ++n)
#pragma unroll
                    for (int j = 0; j < 4; ++j) { const float a = acc[ai][0][m][n][j], up = acc[ai][1][m][n][j];
                        const float sg = a * __builtin_amdgcn_rcpf(1.0f + __builtin_amdgcn_exp2f(-1.4426950408889634f * a)); r[n][j] = sg * up; }
                *(u32x4*)rowp = pack8(r[0], r[1]); }
    }
};


__device__ __forceinline__ unsigned pk4_fp8(float a, float b, float c, float d) { unsigned w = 0u; w = __builtin_amdgcn_cvt_pk_fp8_f32(a, b, w, false); w = __builtin_amdgcn_cvt_pk_fp8_f32(c, d, w, true); return w; }
struct EpiSwiGLU8 {
    static constexpr bool PERM = true, AFTER_DRAIN = false;
    unsigned char* ACT; float winv;
    __device__ __forceinline__ void operator()(const f32x4 (&acc)[2][2][4][2], const Unit& u, int wr, int wc, int fr, int fq) const {
        const int row0 = u.pm * BM + wr * 64 + fr, col0 = (u.pn & 15) * 128 + wc * 32 + 8 * fq;
#pragma unroll
        for (int ai = 0; ai < 2; ++ai)
#pragma unroll
            for (int m = 0; m < 4; ++m) { unsigned char* rowp = ACT + (size_t)(row0 + ai * HALF + m * 16) * 2048 + col0;
                float r[8];
#pragma unroll
                for (int n = 0; n < 2; ++n)
#pragma unroll
                    for (int j = 0; j < 4; ++j) { const float a = acc[ai][0][m][n][j] * winv, up = acc[ai][1][m][n][j] * winv;
                        const float sg = a * __builtin_amdgcn_rcpf(1.0f + __builtin_amdgcn_exp2f(-1.4426950408889634f * a)); float v = sg * up; v = fminf(fmaxf(v, -448.f), 448.f); r[4 * n + j] = v; }
                typedef unsigned u32x2 __attribute__((ext_vector_type(2)));
                u32x2 w; w.x = pk4_fp8(r[0], r[1], r[2], r[3]); w.y = pk4_fp8(r[4], r[5], r[6], r[7]);
                *(u32x2*)rowp = w; }
    }
};

struct EpiDown {
    static constexpr bool PERM = true, AFTER_DRAIN = false;
    bf16_t* Y; const float* gatev; float winv;
    __device__ __forceinline__ void operator()(const f32x4 (&acc)[2][2][4][2], const Unit& u, int wr, int wc, int fr, int fq) const {
        const int row0 = u.pm * BM + wr * 64 + fr, col0 = (u.pn & 3) * 256 + wc * 32 + 8 * fq;
#pragma unroll
        for (int ai = 0; ai < 2; ++ai)
#pragma unroll
            for (int m = 0; m < 4; ++m) { const int row = row0 + ai * HALF + m * 16; const float gv = gatev[row] * winv; bf16_t* rowp = Y + (size_t)row * 1024 + col0;
#pragma unroll
                for (int bj = 0; bj < 2; ++bj) *(u32x4*)(rowp + bj * HALF) = pack8(acc[ai][bj][m][0] * gv, acc[ai][bj][m][1] * gv); }
    }
};

struct MoeOrder {
    int nMe, nNe, nwg, G, c;
    __device__ __forceinline__ void init(int nMe_, int nNe_, int nExp, int G_, int c_) { nMe = nMe_; nNe = nNe_; nwg = nMe_ * nNe_ * nExp; G = G_; c = c_; }
    __device__ __forceinline__ bool next(int i, Unit& u) const {
        const int L = i * G + c; if (L >= nwg) return false;
        const int per = nMe * nNe, e = L / per, r = L % per;
        u.pm = e * nMe + (r % nMe); u.pn = e * nNe + (r / nMe); return true;
    }
    __device__ __forceinline__ void a_ready(const Unit&) const {}
    __device__ __forceinline__ void done(const Unit&) const {}
    __device__ __forceinline__ bool half(const Unit& u) const { return nMe == 9 && (u.pm % 9) == 8; }
};
template <class Epi, class Sched, bool ALIGN_EPI = false, bool SP2 = false, bool FP8 = false, bool GATHER = false>
__device__ __forceinline__ void gemm_phase(PG8_LAS unsigned char* lds, const Gemm g, const Sched& S, const Epi& E, const PG8_LAS unsigned* gtab = nullptr) {
    static_assert(!GATHER || SP2, "GATHER is wired into the SP2 loop only");
    int tid_o = threadIdx.x; asm volatile("" : "+v"(tid_o) :: "memory");
    const int tid = tid_o, wid = __builtin_amdgcn_readfirstlane(tid >> 6), lane = tid & 63, wr = wid >> 2, wc = wid & 3, fr = lane & 15, fq = lane >> 4;
    const int K = g.K, nt = K / BK;
    unsigned voffA[2], voffB[2]; int rA[2]; unsigned cofA[2];
    unsigned vofC[2][2] = {{0u, 0u}, {0u, 0u}}, vofN[2][2] = {{0u, 0u}, {0u, 0u}};
#pragma unroll
    for (int i = 0; i < 2; ++i) { int R, C; stage_rc(tid * 16 + i * 8192, R, C); const int Rb = Epi::PERM ? ((R & ~31) + perm32(R & 31)) : R;
        voffA[i] = (unsigned)(R * K + C) * 2u; voffB[i] = (unsigned)(Rb * K + C) * 2u; rA[i] = R; cofA[i] = (unsigned)C * 2u; }
    const size_t kstep = (size_t)(BK * 2);
    const size_t hstep = (size_t)HALF * K * 2;
    const size_t tstep = 2 * hstep;
    const unsigned ldsw = (unsigned)wid * 1024u;
    const int aoff = lds_byte(wr * 64 + fr, fq * 8), boff = lds_byte(wc * 32 + fr, fq * 8);
#define PG8_SA(b, h) (((b) * 2 + (h)) * HTB)
#define PG8_SB(b, h) ((4 + (b) * 2 + (h)) * HTB)
#define PG8_STAGE(bufoff, gbase, voff) do { _Pragma("unroll") for (int _i = 0; _i < 2; ++_i) \
        __builtin_amdgcn_global_load_lds((const unsigned*)((const char*)(gbase) + (voff)[_i]), (PG8_LAS unsigned*)(lds + (bufoff) + ldsw + _i * 8192), 16, 0, 0); } while (0)
#define PG8_STAGE_A(bufoff, gbase, h, usenext) do { if constexpr (GATHER) { const unsigned vg_[2] = {(usenext) ? vofN[h][0] : vofC[h][0], (usenext) ? vofN[h][1] : vofC[h][1]}; PG8_STAGE(bufoff, gbase, vg_); } \
        else { PG8_STAGE(bufoff, (gbase) + (h) * hstep, voffA); } } while (0)
#define PG8_GTAB(dst, u_) do { _Pragma("unroll") for (int h_ = 0; h_ < 2; ++h_) _Pragma("unroll") for (int i_ = 0; i_ < 2; ++i_) dst[h_][i_] = gtab[(u_) * 256 + h_ * 128 + rA[i_]] + cofA[i_]; } while (0)
#define PG8_LDA(dst, b, h) do { if constexpr (FP8) { _Pragma("unroll") for (int m = 0; m < 4; ++m) { const v4i_ lo_ = *(const PG8_LAS v4i_*)(lds + PG8_SA(b, h) + aoff + m * 2048), hi_ = *(const PG8_LAS v4i_*)(lds + PG8_SA(b, h) + aoff + m * 2048 + 1024); dst##8[m] = __builtin_shufflevector(lo_, hi_, 0, 1, 2, 3, 4, 5, 6, 7); } } \
        else { _Pragma("unroll") for (int m = 0; m < 4; ++m) _Pragma("unroll") for (int k = 0; k < 2; ++k) dst[m][k] = *(const PG8_LAS bf16x8*)(lds + PG8_SA(b, h) + aoff + m * 2048 + k * 1024); } } while (0)
#define PG8_LDB(dst, b, h) do { if constexpr (FP8) { _Pragma("unroll") for (int n = 0; n < 2; ++n) { const v4i_ lo_ = *(const PG8_LAS v4i_*)(lds + PG8_SB(b, h) + boff + n * 2048), hi_ = *(const PG8_LAS v4i_*)(lds + PG8_SB(b, h) + boff + n * 2048 + 1024); dst##8[n] = __builtin_shufflevector(lo_, hi_, 0, 1, 2, 3, 4, 5, 6, 7); } } \
        else { _Pragma("unroll") for (int n = 0; n < 2; ++n) _Pragma("unroll") for (int k = 0; k < 2; ++k) dst[n][k] = *(const PG8_LAS bf16x8*)(lds + PG8_SB(b, h) + boff + n * 2048 + k * 1024); } } while (0)
#define PG8_MMA(ai, bj, At, Bt) do { __builtin_amdgcn_s_setprio(1); _Pragma("unroll") for (int m = 0; m < 4; ++m) _Pragma("unroll") for (int n = 0; n < 2; ++n) { \
        if constexpr (FP8) { asm volatile("v_mfma_f32_16x16x128_f8f6f4 %0, %1, %2, %0" : "+v"(acc[ai][bj][m][n]) : "v"(Bt##8[n]), "v"(At##8[m])); } \
        else { _Pragma("unroll") for (int k = 0; k < 2; ++k) acc[ai][bj][m][n] = __builtin_amdgcn_mfma_f32_16x16x32_bf16(Bt[n][k], At[m][k], acc[ai][bj][m][n], 0, 0, 0); } } \
        __builtin_amdgcn_s_setprio(0); } while (0)
#define PG8_WAIT_V(n) asm volatile("s_waitcnt vmcnt(" #n ")" ::: "memory")
#define PG8_WAIT_L(n) asm volatile("s_waitcnt lgkmcnt(" #n ")" ::: "memory")
#define PG8_BAR __builtin_amdgcn_s_barrier()
#define PG8_SCHED __builtin_amdgcn_sched_barrier(0)
    Unit cur, nxt; int ui = 0;
    if (!S.next(0, cur)) return;
    f32x4 acc[2][2][4][2];
#pragma unroll
    for (int a = 0; a < 2; ++a)
#pragma unroll
        for (int b = 0; b < 2; ++b)
#pragma unroll
            for (int m = 0; m < 4; ++m)
#pragma unroll
                for (int n = 0; n < 2; ++n) acc[a][b][m][n] = (f32x4){0.f, 0.f, 0.f, 0.f};
    typedef int v4i_ __attribute__((ext_vector_type(4))); typedef int v8i_ __attribute__((ext_vector_type(8)));
    bf16x8 At[4][2], B0[2][2], B1[2][2];
    v8i_ At8[4], B08[2], B18[2];
    const char* cA = (const char*)g.A + (GATHER ? (size_t)0 : (size_t)cur.pm * tstep); const char* cB = (const char*)g.Bt + (size_t)cur.pn * tstep;
    if constexpr (GATHER) PG8_GTAB(vofC, 0);
    S.a_ready(cur);
    if constexpr (SP2) {
        PG8_STAGE(PG8_SB(0, 0), cB, voffB); PG8_STAGE(PG8_SB(0, 1), cB + hstep, voffB); PG8_STAGE_A(PG8_SA(0, 0), cA, 0, false); PG8_STAGE_A(PG8_SA(0, 1), cA, 1, false);
        if (wr == 1) PG8_BAR;
        PG8_WAIT_V(2); PG8_BAR;
        PG8_STAGE(PG8_SB(1, 0), cB + kstep, voffB); PG8_STAGE_A(PG8_SA(1, 0), cA + kstep, 0, false); PG8_STAGE(PG8_SB(1, 1), cB + hstep + kstep, voffB);
        PG8_WAIT_V(6); PG8_BAR;
    } else {
        PG8_STAGE(PG8_SB(0, 0), cB, voffB); PG8_STAGE(PG8_SA(0, 0), cA, voffA); PG8_STAGE(PG8_SB(0, 1), cB + hstep, voffB); PG8_STAGE(PG8_SA(0, 1), cA + hstep, voffA);
        if (wr == 1) PG8_BAR;
        PG8_WAIT_V(4); PG8_BAR;
        PG8_STAGE(PG8_SB(1, 0), cB + kstep, voffB); PG8_STAGE(PG8_SA(1, 0), cA + kstep, voffA); PG8_STAGE(PG8_SB(1, 1), cB + hstep + kstep, voffB);
        PG8_WAIT_V(6); PG8_BAR;
    }
    bool halfu = S.half(cur);
    for (;;) {
        const bool has_next = S.next(ui + 1, nxt);
        if constexpr (GATHER) { if (has_next) PG8_GTAB(vofN, ui + 1); else { vofN[0][0] = vofC[0][0]; vofN[0][1] = vofC[0][1]; vofN[1][0] = vofC[1][0]; vofN[1][1] = vofC[1][1]; } }
        const char* nA = (has_next && !GATHER) ? (const char*)g.A + (size_t)nxt.pm * tstep : cA; const char* nB = has_next ? (const char*)g.Bt + (size_t)nxt.pn * tstep : cB;
        for (int t = 0; t < nt; t += 2) {
            const bool last = (t == nt - 2);
            const char* a1 = cA + (size_t)(t + 1) * kstep;
            const char* a2 = last ? nA : cA + (size_t)(t + 2) * kstep; const char* b2 = last ? nB : cB + (size_t)(t + 2) * kstep;
            const char* a3 = a2 + kstep; const char* b3 = b2 + kstep;
            if (last && has_next) S.a_ready(nxt);
            if constexpr (SP2) {
            PG8_LDB(B0, 0, 0); PG8_LDB(B1, 0, 1); PG8_SCHED; PG8_LDA(At, 0, 0); PG8_STAGE_A(PG8_SA(1, 1), a1, 1, false);
            PG8_WAIT_V(8); PG8_WAIT_L(0); PG8_BAR; if (!(halfu && wr == 1)) { PG8_MMA(0, 0, At, B0); PG8_MMA(0, 1, At, B1); } PG8_BAR; PG8_SCHED;
            PG8_LDA(At, 0, 1); PG8_STAGE(PG8_SB(0, 0), b2, voffB); PG8_STAGE(PG8_SB(0, 1), b2 + hstep, voffB); PG8_STAGE_A(PG8_SA(0, 0), a2, 0, last);
            PG8_WAIT_V(8); PG8_WAIT_L(0); PG8_BAR; if (!halfu) { PG8_MMA(1, 0, At, B0); PG8_MMA(1, 1, At, B1); } PG8_BAR; PG8_SCHED;
            PG8_LDB(B0, 1, 0); PG8_LDB(B1, 1, 1); PG8_SCHED; PG8_LDA(At, 1, 0); PG8_STAGE_A(PG8_SA(0, 1), a2, 1, last);
            PG8_WAIT_V(8); PG8_WAIT_L(0); PG8_BAR; if (!(halfu && wr == 1)) { PG8_MMA(0, 0, At, B0); PG8_MMA(0, 1, At, B1); } PG8_BAR; PG8_SCHED;
            PG8_LDA(At, 1, 1); PG8_STAGE(PG8_SB(1, 0), b3, voffB); PG8_STAGE(PG8_SB(1, 1), b3 + hstep, voffB); PG8_STAGE_A(PG8_SA(1, 0), a3, 0, last);
            PG8_WAIT_V(8); PG8_WAIT_L(0); PG8_BAR; if (!halfu) { PG8_MMA(1, 0, At, B0); PG8_MMA(1, 1, At, B1); } PG8_BAR; PG8_SCHED;
            } else {
            PG8_LDB(B0, 0, 0); PG8_SCHED; PG8_LDA(At, 0, 0); PG8_STAGE(PG8_SA(1, 1), a1 + hstep, voffA);
            PG8_WAIT_L(8); PG8_BAR; PG8_WAIT_L(0); PG8_MMA(0, 0, At, B0); PG8_BAR; PG8_SCHED;
            PG8_LDB(B1, 0, 1); PG8_STAGE(PG8_SB(0, 0), b2, voffB);
            PG8_BAR; PG8_WAIT_L(0); PG8_MMA(0, 1, At, B1); PG8_BAR;
            PG8_LDA(At, 0, 1); PG8_STAGE(PG8_SA(0, 0), a2, voffA);
            PG8_BAR; PG8_WAIT_L(0); PG8_MMA(1, 0, At, B0); PG8_BAR; PG8_SCHED;
            PG8_STAGE(PG8_SB(0, 1), b2 + hstep, voffB);
            PG8_WAIT_V(6); PG8_BAR; PG8_MMA(1, 1, At, B1); PG8_BAR;
            PG8_LDB(B0, 1, 0); PG8_SCHED; PG8_LDA(At, 1, 0); PG8_STAGE(PG8_SA(0, 1), a2 + hstep, voffA);
            PG8_WAIT_L(8); PG8_BAR; PG8_WAIT_L(0); PG8_MMA(0, 0, At, B0); PG8_BAR; PG8_SCHED;
            PG8_LDB(B1, 1, 1); PG8_STAGE(PG8_SB(1, 0), b3, voffB);
            PG8_BAR; PG8_WAIT_L(0); PG8_MMA(0, 1, At, B1); PG8_BAR;
            PG8_LDA(At, 1, 1); PG8_STAGE(PG8_SA(1, 0), a3, voffA);
            PG8_BAR; PG8_WAIT_L(0); PG8_MMA(1, 0, At, B0); PG8_BAR; PG8_SCHED;
            PG8_STAGE(PG8_SB(1, 1), b3 + hstep, voffB);
            PG8_WAIT_V(6); PG8_BAR; PG8_MMA(1, 1, At, B1); PG8_BAR;
            }
        }
        if constexpr (FP8) {
            asm volatile("s_nop 15\n\ts_nop 15" ::: "memory");
#pragma unroll
            for (int a = 0; a < 2; ++a)
#pragma unroll
                for (int b = 0; b < 2; ++b)
#pragma unroll
                    for (int m = 0; m < 4; ++m)
#pragma unroll
                        for (int n = 0; n < 2; ++n) asm volatile("" : "+v"(acc[a][b][m][n]));
        }
        if constexpr (ALIGN_EPI) { if (wr == 0) PG8_BAR; }
        if constexpr (!Epi::AFTER_DRAIN) { E(acc, cur, wr, wc, fr, fq); S.done(cur); }
        if (!has_next) break;
#pragma unroll
        for (int a = 0; a < 2; ++a)
#pragma unroll
            for (int b = 0; b < 2; ++b)
#pragma unroll
                for (int m = 0; m < 4; ++m)
#pragma unroll
                    for (int n = 0; n < 2; ++n) acc[a][b][m][n] = (f32x4){0.f, 0.f, 0.f, 0.f};
        cur = nxt; cA = nA; cB = nB; ++ui; halfu = S.half(cur);
        if constexpr (GATHER) { vofC[0][0] = vofN[0][0]; vofC[0][1] = vofN[0][1]; vofC[1][0] = vofN[1][0]; vofC[1][1] = vofN[1][1]; }
        if constexpr (ALIGN_EPI) { if (wr == 1) PG8_BAR; }
    }
    PG8_WAIT_V(0);
    if constexpr (!ALIGN_EPI) { if (wr == 0) PG8_BAR; }
    PG8_BAR;
    if constexpr (Epi::AFTER_DRAIN) { E.fused(acc, cur, wr, wc, fr, fq, lds, wid, lane); S.done(cur); }
#undef PG8_SA
#undef PG8_SB
#undef PG8_STAGE
#undef PG8_STAGE_A
#undef PG8_GTAB
#undef PG8_LDA
#undef PG8_LDB
#undef PG8_MMA
#undef PG8_WAIT_V
#undef PG8_WAIT_L
#undef PG8_BAR
#undef PG8_SCHED
}
}
namespace attn_body {
using bf16=__hip_bfloat16;
using bf16x8=__attribute__((ext_vector_type(8)))short;
using s16x4=__attribute__((ext_vector_type(4)))short;
using f32x16=__attribute__((ext_vector_type(16)))float;
using u32x4=__attribute__((ext_vector_type(4)))unsigned;
constexpr int D=64;
constexpr int NW=8,QBLK=32,QB=QBLK*NW,KVBLK=64;
constexpr int ATTN_UNIT_ROWS=QB;
__device__ __forceinline__ int crow(int r,int hi){return (r&3)+8*(r>>2)+4*hi;}
#define SBAR() __builtin_amdgcn_sched_barrier(0)
__device__ __forceinline__ void cmask(f32x16&p0,f32x16&p1,int jb,int qrel,int hi){
  const float NEG=-INFINITY; int kb=64*jb+4*hi;
  #pragma unroll
  for(int r=0;r<16;++r){int kv=kb+(r&3)+8*(r>>2); if(kv>qrel)p0[r]=NEG; if(kv+32>qrel)p1[r]=NEG;}
}

constexpr int NSLOT=3, SLOTB=8192;
constexpr int LDS_K=0, LDS_V=NSLOT*SLOTB, LDS_WS=2*NSLOT*SLOTB, LDS_OST=LDS_WS+NW*64*4, LDS_BYTES=LDS_OST+NW*4096;
constexpr float C2=0.125f*1.4426950408889634f;
__device__ __forceinline__ void glds16(const void*gsrc,unsigned lds_dst){unsigned keep;
  asm volatile("s_mov_b32 %0, m0\n\ts_mov_b32 m0, %2\n\ts_nop 0\n\tglobal_load_lds_dwordx4 %1, off\n\ts_mov_b32 m0, %0":"=&s"(keep):"v"(gsrc),"s"(lds_dst):"memory");}
__device__ __forceinline__ float max3f(float a,float b,float c){float r;asm("v_max3_f32 %0, %1, %2, %3":"=v"(r):"v"(a),"v"(b),"v"(c));return r;}
__device__ __forceinline__ float max2f(float a,float b){float r;asm("v_max_f32_e32 %0, %1, %2":"=v"(r):"v"(a),"v"(b));return r;}
__device__ __forceinline__ float fadd_s(float a,float b){float r;asm("v_add_f32_e32 %0, %1, %2":"=v"(r):"v"(a),"v"(b));return r;}
__device__ __forceinline__ float fsub_s(float a,float b){float r;asm("v_sub_f32_e32 %0, %1, %2":"=v"(r):"v"(a),"v"(b));return r;}
typedef float f32x2_t __attribute__((ext_vector_type(2))); typedef __bf16 bf16x2_t __attribute__((ext_vector_type(2)));
__device__ __forceinline__ unsigned cvtpk_s(float lo,float hi){f32x2_t v={lo,hi};bf16x2_t b=__builtin_convertvector(v,bf16x2_t);return __builtin_bit_cast(unsigned,b);}
#define WAIT_BAR(N) asm volatile("s_waitcnt vmcnt(" #N ") lgkmcnt(0)\n\ts_barrier":::"memory")

__device__ __forceinline__ void qkt(f32x16&p0,f32x16&p1,const char*Kslot,const bf16x8*qr,const f32x16&negm,int r32,int hi){
  const char*kb=Kslot+hi*1024+r32*16;
  #pragma unroll
  for(int d0=0;d0<4;++d0){
    const bf16x8 b0=*reinterpret_cast<const bf16x8*>(kb+d0*2048);
    const bf16x8 b1=*reinterpret_cast<const bf16x8*>(kb+d0*2048+512);
    if(d0==0){p0=__builtin_amdgcn_mfma_f32_32x32x16_bf16(b0,qr[0],negm,0,0,0);p1=__builtin_amdgcn_mfma_f32_32x32x16_bf16(b1,qr[0],negm,0,0,0);}
    else{p0=__builtin_amdgcn_mfma_f32_32x32x16_bf16(b0,qr[d0],p0,0,0,0);p1=__builtin_amdgcn_mfma_f32_32x32x16_bf16(b1,qr[d0],p1,0,0,0);}}
}
typedef __attribute__((address_space(3))) const char* lds_cptr;
typedef short v4i16_t __attribute__((ext_vector_type(4)));
__device__ __forceinline__ void kload8(bf16x8*kf,lds_cptr kp){
  kf[0]=*(const __attribute__((address_space(3))) bf16x8*)(kp);      kf[1]=*(const __attribute__((address_space(3))) bf16x8*)(kp+512);
  kf[2]=*(const __attribute__((address_space(3))) bf16x8*)(kp+2048); kf[3]=*(const __attribute__((address_space(3))) bf16x8*)(kp+2560);
  kf[4]=*(const __attribute__((address_space(3))) bf16x8*)(kp+4096); kf[5]=*(const __attribute__((address_space(3))) bf16x8*)(kp+4608);
  kf[6]=*(const __attribute__((address_space(3))) bf16x8*)(kp+6144); kf[7]=*(const __attribute__((address_space(3))) bf16x8*)(kp+6656);
}
__device__ __forceinline__ void kload2(bf16x8*kf,lds_cptr kp,int j){ kf[2*j]=*(const __attribute__((address_space(3))) bf16x8*)(kp+j*2048); kf[2*j+1]=*(const __attribute__((address_space(3))) bf16x8*)(kp+j*2048+512); }
__device__ __forceinline__ s16x4 vtr(lds_cptr p){ return __builtin_bit_cast(s16x4,__builtin_amdgcn_ds_read_tr16_b64_v4i16((__attribute__((address_space(3))) v4i16_t*)p)); }
__device__ __forceinline__ float rowmax(const f32x16&p0,const f32x16&p1){
  float a=max3f(p0[0],p0[1],p1[0]),b=max3f(p0[2],p0[3],p1[1]);a=max3f(a,p1[2],p1[3]);
  #pragma unroll
  for(int r=4;r<16;r+=4){a=max3f(a,p0[r],p0[r+1]);b=max3f(b,p0[r+2],p0[r+3]);a=max3f(a,p1[r],p1[r+1]);b=max3f(b,p1[r+2],p1[r+3]);}
  const float m=max2f(a,b);
  auto rr=__builtin_amdgcn_permlane32_swap(__float_as_uint(m),__float_as_uint(m),false,false);
  return max2f(__uint_as_float(rr[0]),__uint_as_float(rr[1]));
}
__device__ __forceinline__ void pv(f32x16*o,int vb,bf16x8 pa0,bf16x8 pa1,bf16x8 pa2,bf16x8 pa3){
  #pragma unroll
  for(int d0=0;d0<2;++d0){s16x4 lo[4],hi[4];
    #pragma unroll
    for(int ks=0;ks<4;++ks){
      asm volatile("ds_read_b64_tr_b16 %0,%1 offset:%c2":"=&v"(lo[ks]):"v"(vb),"i"(d0*4096+ks*1024):"memory");
      asm volatile("ds_read_b64_tr_b16 %0,%1 offset:%c2":"=&v"(hi[ks]):"v"(vb),"i"(d0*4096+ks*1024+512):"memory");}
    asm volatile("s_waitcnt lgkmcnt(0)":::"memory");SBAR();
    #define PK(k) (bf16x8){lo[k][0],lo[k][1],lo[k][2],lo[k][3],hi[k][0],hi[k][1],hi[k][2],hi[k][3]}
    o[d0]=__builtin_amdgcn_mfma_f32_32x32x16_bf16(pa0,PK(0),o[d0],0,0,0);
    o[d0]=__builtin_amdgcn_mfma_f32_32x32x16_bf16(pa1,PK(1),o[d0],0,0,0);
    o[d0]=__builtin_amdgcn_mfma_f32_32x32x16_bf16(pa2,PK(2),o[d0],0,0,0);
    o[d0]=__builtin_amdgcn_mfma_f32_32x32x16_bf16(pa3,PK(3),o[d0],0,0,0);
    #undef PK
  }
}

#ifndef ATTN_STORE16
#define ATTN_STORE16(p,v) (*(u32x4*)(p)=(v))
#endif
template<int THRL,bool WIN> __device__ __forceinline__ void attn_unit(const bf16*Qu,int QP,const bf16*__restrict__ Kh,const bf16*__restrict__ Vh,int KP,int NT,bf16*Ou,int OP,char*shm,int gap,int qpos0,float sinkl2){
  const int tid=threadIdx.x,lane=tid&63,r32=lane&31,hi=lane>>5; const int wid=__builtin_amdgcn_readfirstlane(tid>>6);
  const bf16*Qw=Qu+(long)(wid*QBLK)*QP;
  const unsigned lds0=(unsigned)(uintptr_t)shm;
  float*wsf=(float*)(shm+LDS_WS)+wid*64;
  const bf16*ksrc=Kh+(long)lane*KP+wid*8;
  const bf16*vsrc=Vh+(long)(16*(wid&3)+(lane>>2))*KP+(wid>>2)*32+(lane&3)*8;
  const unsigned kdst=lds0+LDS_K+wid*1024, vdst=lds0+LDS_V+wid*1024;
  #define KROW(t) ((long)(t)*KVBLK+((WIN&&(t)>=4)?(long)gap:0L))
  #define DMA_K(t,slot) glds16(ksrc+KROW(t)*KP,(unsigned)__builtin_amdgcn_readfirstlane(kdst+(slot)))
  #define DMA_V(t,slot) glds16(vsrc+KROW(t)*KP,(unsigned)__builtin_amdgcn_readfirstlane(vdst+(slot)))
  const int vb0=(int)(lds0+LDS_V)+((lane>>4)&1)*32+(lane&3)*8+(4*hi+((lane&15)>>2))*64;
  const char*Kbase=shm+LDS_K; bf16x8 kf[8];
  const lds_cptr shm3=(lds_cptr)shm; const lds_cptr kp0=shm3+LDS_K+hi*1024+r32*16; const lds_cptr vp0=shm3+LDS_V+((lane>>4)&1)*32+(lane&3)*8+(4*hi+((lane&15)>>2))*64;
  DMA_K(0,0);DMA_V(0,0);DMA_K(1,SLOTB);
  bf16x8 qr[4];
  #pragma unroll
  for(int d0=0;d0<4;++d0)qr[d0]=*reinterpret_cast<const bf16x8*>(&Qw[(long)r32*QP+d0*16+hi*8]);
  if(__builtin_amdgcn_readfirstlane(threadIdx.x)>=256)__builtin_amdgcn_s_setprio(1);
  float mhat=0.f,l_reg=0.f;f32x16 o[2];o[0]=f32x16{};o[1]=f32x16{};f32x16 negm=f32x16{};asm volatile("":"+v"(negm));
  const int qrel=wid*QBLK+r32;
  #define CMASK(P0,P1,t) do{ if(WIN&&(t)>=4){ const int kb_=gap+64*((t)-4)+4*hi-(qpos0+qrel); _Pragma("unroll") for(int r_=0;r_<16;++r_){ const int df_=kb_+(r_&3)+8*(r_>>2); if(df_>128||df_<-128)P0[r_]=-INFINITY; if(df_+32>128||df_+32<-128)P1[r_]=-INFINITY; } } }while(0)
  bool resc=false;
  #define START(P0,P1) do{ const float rm=rowmax(P0,P1); resc=false; \
    { const float dl=rm; mhat=fadd_s(mhat,dl); \
      _Pragma("unroll") for(int r=0;r<16;++r){P0[r]=fsub_s(P0[r],dl);P1[r]=fsub_s(P1[r],dl);} \
      _Pragma("unroll") for(int r=0;r<16;++r)negm[r]=-mhat; asm volatile("":"+v"(negm)); } \
    _Pragma("unroll") for(int r=0;r<16;++r)P0[r]=__builtin_amdgcn_exp2f(P0[r]); }while(0)
  #define RESC() do{ if(resc){ asm volatile("s_waitcnt lgkmcnt(0)":::"memory"); \
      _Pragma("unroll") for(int d_=0;d_<2;++d_) _Pragma("unroll") for(int r=0;r<16;++r)o[d_][r]*=wsf[crow(r,hi)]; } }while(0)
  f32x16 pA0,pA1,pB0,pB1;
  int sl_prev=0,sl_cur=0,sl_next=SLOTB;
  #define ROT() do{sl_prev=sl_cur;sl_cur=sl_next;sl_next=(sl_next==(NSLOT-1)*SLOTB)?0:sl_next+SLOTB;}while(0)
  DMA_K(2,2*SLOTB);
  WAIT_BAR(3);
  qkt(pA0,pA1,Kbase,qr,negm,r32,hi);asm volatile("s_nop 15\n\ts_nop 7":"+v"(pA0),"+v"(pA1));CMASK(pA0,pA1,0);
  START(pA0,pA1);
  _Pragma("unroll") for(int r=0;r<16;++r)pA1[r]=__builtin_amdgcn_exp2f(pA1[r]);
  WAIT_BAR(0);
  DMA_K(3,0);DMA_V(1,SLOTB);
  ROT();
  kload8(kf,kp0+sl_cur);
  WAIT_BAR(2);
  s16x4 vlo[8],vhi[8]; u32x4 pw0,pw1,pw2,pw3;
  #define PKW(P,B) cvtpk_s(P[B],P[B+1])
  #define PAF(k) __builtin_bit_cast(bf16x8,pw##k)
  #define VFR(i) (bf16x8){vlo[i][0],vlo[i][1],vlo[i][2],vlo[i][3],vhi[i][0],vhi[i][1],vhi[i][2],vhi[i][3]}
  #define PIN(x) asm volatile("":"+v"(x))
  #define MX3(a,b,c) __builtin_fmaxf(__builtin_fmaxf((a),(b)),(c))
  #define GAPA(MF,A0,A1,A2,A3,W0,W1,PW) do{ MF; sacc+=A0; sacc+=A1; sacc+=A2; sacc+=A3; PIN(sacc); W0; W1; PIN(PW); SBAR(); }while(0)
  #define EX(v) __builtin_amdgcn_exp2f(v)
  #define GAPB(MF,X,B) do{ MF; X[B]=EX(X[B]); X[B+1]=EX(X[B+1]); X[B+2]=EX(X[B+2]); X[B+3]=EX(X[B+3]); PIN(X); SBAR(); }while(0)
  #define VRD(i) do{ vlo[i]=vtr(vp_+(((i)>>2)*4096+((i)&3)*1024)); vhi[i]=vtr(vp_+(((i)>>2)*4096+((i)&3)*1024+512)); }while(0)
  #define KRD(G,j) do{ if(G){ kload2(kf,kp0+sl_next,j); SBAR(); } }while(0)
  #define STEP(C0,C1,P0,P1,t,GK,GV,GL) do{ SBAR(); \
    const lds_cptr vp_=vp0+sl_prev; \
    VRD(0); SBAR(); float sacc=(P0[0]+P0[1]); \
    GAPA(C0=__builtin_amdgcn_mfma_f32_32x32x16_bf16(kf[0],qr[0],negm,0,0,0), P0[2],P0[3],P0[4],P0[5],     pw0[0]=PKW(P0,0), pw0[1]=PKW(P0,2), pw0); \
    VRD(4); SBAR(); GAPA(C1=__builtin_amdgcn_mfma_f32_32x32x16_bf16(kf[1],qr[0],negm,0,0,0), P0[6],P0[7],P0[8],P0[9],     pw0[2]=PKW(P0,4), pw0[3]=PKW(P0,6), pw0); \
    VRD(1); SBAR(); GAPA(C0=__builtin_amdgcn_mfma_f32_32x32x16_bf16(kf[2],qr[1],C0,0,0,0),   P0[10],P0[11],P0[12],P0[13], pw1[0]=PKW(P0,8), pw1[1]=PKW(P0,10), pw1); \
    VRD(5); SBAR(); GAPA(C1=__builtin_amdgcn_mfma_f32_32x32x16_bf16(kf[3],qr[1],C1,0,0,0),   P0[14],P0[15],P1[0],P1[1],   pw1[2]=PKW(P0,12),pw1[3]=PKW(P0,14), pw1); \
    VRD(2); SBAR(); GAPA(C0=__builtin_amdgcn_mfma_f32_32x32x16_bf16(kf[4],qr[2],C0,0,0,0),   P1[2],P1[3],P1[4],P1[5],     pw2[0]=PKW(P1,0), pw2[1]=PKW(P1,2), pw2); \
    VRD(6); SBAR(); GAPA(C1=__builtin_amdgcn_mfma_f32_32x32x16_bf16(kf[5],qr[2],C1,0,0,0),   P1[6],P1[7],P1[8],P1[9],     pw2[2]=PKW(P1,4), pw2[3]=PKW(P1,6), pw2); \
    VRD(3); SBAR(); GAPA(C0=__builtin_amdgcn_mfma_f32_32x32x16_bf16(kf[6],qr[3],C0,0,0,0),   P1[10],P1[11],P1[12],P1[13], pw3[0]=PKW(P1,8), pw3[1]=PKW(P1,10), pw3); \
    VRD(7); SBAR(); GAPA(C1=__builtin_amdgcn_mfma_f32_32x32x16_bf16(kf[7],qr[3],C1,0,0,0),   P1[14],P1[15],0.f,0.f,       pw3[2]=PKW(P1,12),pw3[3]=PKW(P1,14), pw3); \
    l_reg+=sacc; \
    if(GK){DMA_K((t)+3,sl_cur);} if(GV){DMA_V((t)+1,sl_next);} \
    CMASK(C0,C1,t); \
    { float a=MX3(C0[0],C0[1],C1[0]),b=MX3(C0[2],C0[3],C1[1]); a=MX3(a,C1[2],C1[3]); \
      _Pragma("unroll") for(int r=4;r<16;r+=4){a=MX3(a,C0[r],C0[r+1]);b=MX3(b,C0[r+2],C0[r+3]);a=MX3(a,C1[r],C1[r+1]);b=MX3(b,C1[r+2],C1[r+3]);} \
      float rm=__builtin_fmaxf(a,b); { auto rr=__builtin_amdgcn_permlane32_swap(__float_as_uint(rm),__float_as_uint(rm),false,false); rm=__builtin_fmaxf(__uint_as_float(rr[0]),__uint_as_float(rr[1])); } \
      resc=false; \
      if(__builtin_expect(__any(rm>(float)THRL),0)){ const float dl=__builtin_fmaxf(rm,0.f); mhat+=dl; \
        _Pragma("unroll") for(int r=0;r<16;++r){C0[r]-=dl;C1[r]-=dl;} \
        _Pragma("unroll") for(int r=0;r<16;++r)negm[r]=-mhat; asm volatile("":"+v"(negm)); \
        const float f=__builtin_amdgcn_exp2f(-dl); l_reg*=f; if(hi==0)wsf[r32]=f; resc=true; } } \
    SBAR(); \
    GAPB(o[0]=__builtin_amdgcn_mfma_f32_32x32x16_bf16(PAF(0),VFR(0),o[0],0,0,0), C0,0); \
    GAPB(o[1]=__builtin_amdgcn_mfma_f32_32x32x16_bf16(PAF(0),VFR(4),o[1],0,0,0), C0,4); \
    KRD(GL,0); GAPB(o[0]=__builtin_amdgcn_mfma_f32_32x32x16_bf16(PAF(1),VFR(1),o[0],0,0,0), C0,8); \
    KRD(GL,1); GAPB(o[1]=__builtin_amdgcn_mfma_f32_32x32x16_bf16(PAF(1),VFR(5),o[1],0,0,0), C0,12); \
    KRD(GL,2); GAPB(o[0]=__builtin_amdgcn_mfma_f32_32x32x16_bf16(PAF(2),VFR(2),o[0],0,0,0), C1,0); \
    KRD(GL,3); GAPB(o[1]=__builtin_amdgcn_mfma_f32_32x32x16_bf16(PAF(2),VFR(6),o[1],0,0,0), C1,4); \
    GAPB(o[0]=__builtin_amdgcn_mfma_f32_32x32x16_bf16(PAF(3),VFR(3),o[0],0,0,0), C1,8); \
    GAPB(o[1]=__builtin_amdgcn_mfma_f32_32x32x16_bf16(PAF(3),VFR(7),o[1],0,0,0), C1,12); \
    }while(0)
  int t=1;
  #undef CMASK
  #define CMASK(P0,P1,t) do{ if(WIN&&(t)>=4){ const int kb_=gap+64*((t)-4)+4*hi-(qpos0+qrel); _Pragma("unroll") for(int r_=0;r_<16;++r_){ const int df_=kb_+(r_&3)+8*(r_>>2); if(df_>128||df_<-128)P0[r_]=-INFINITY; if(df_+32>128||df_+32<-128)P1[r_]=-INFINITY; } } }while(0)
  for(;t+5<NT;t+=2){
    STEP(pB0,pB1,pA0,pA1,t,true,true,true);     WAIT_BAR(2); RESC(); ROT();
    STEP(pA0,pA1,pB0,pB1,t+1,true,true,true);   WAIT_BAR(2); RESC(); ROT();
  }
  #undef CMASK
  #define CMASK(P0,P1,t) do{ if(WIN&&(t)>=4){ const int kb_=gap+64*((t)-4)+4*hi-(qpos0+qrel); _Pragma("unroll") for(int r_=0;r_<16;++r_){ const int df_=kb_+(r_&3)+8*(r_>>2); if(df_>128||df_<-128)P0[r_]=-INFINITY; if(df_+32>128||df_+32<-128)P1[r_]=-INFINITY; } } }while(0)
  #define ENDW(tt) do{ if((tt)+3<NT){WAIT_BAR(2);} else if((tt)+2<NT){WAIT_BAR(1);} else {WAIT_BAR(0);} }while(0)
  for(;t+1<NT;t+=2){
    STEP(pB0,pB1,pA0,pA1,t,(t+3<NT),(t+1<NT),(t+1<NT));       ENDW(t);   RESC(); ROT();
    STEP(pA0,pA1,pB0,pB1,t+1,(t+4<NT),(t+2<NT),(t+2<NT));     ENDW(t+1); RESC(); ROT();
  }
  STEP(pB0,pB1,pA0,pA1,NT-1,false,false,false); RESC();
  { float sacc=pB0[0]+pB0[1]; _Pragma("unroll") for(int r=2;r<16;++r)sacc+=pB0[r]; _Pragma("unroll") for(int r=0;r<16;++r)sacc+=pB1[r]; l_reg+=sacc;
    pw0=(u32x4){PKW(pB0,0),PKW(pB0,2),PKW(pB0,4),PKW(pB0,6)};pw1=(u32x4){PKW(pB0,8),PKW(pB0,10),PKW(pB0,12),PKW(pB0,14)};pw2=(u32x4){PKW(pB1,0),PKW(pB1,2),PKW(pB1,4),PKW(pB1,6)};pw3=(u32x4){PKW(pB1,8),PKW(pB1,10),PKW(pB1,12),PKW(pB1,14)};
    SBAR(); pv(o,vb0+sl_cur,PAF(0),PAF(1),PAF(2),PAF(3)); }
  #undef PKW
  #undef PAF
  #undef VFR
  #undef PIN
  #undef MX3
  #undef GAPA
  #undef GAPB
  #undef EX
  #undef VRD
  #undef KRD
  #undef STEP
  #undef ENDW
  {auto rr=__builtin_amdgcn_permlane32_swap(__float_as_uint(l_reg),__float_as_uint(l_reg),false,false);l_reg=__uint_as_float(rr[0])+__uint_as_float(rr[1]);}
  if(WIN)l_reg+=__builtin_amdgcn_exp2f(sinkl2-mhat);
  if(hi==0)wsf[32+r32]=l_reg;asm volatile("s_waitcnt lgkmcnt(0)":::"memory");
  float rli[16];
  #pragma unroll
  for(int r=0;r<16;++r)rli[r]=__builtin_amdgcn_rcpf(wsf[32+crow(r,hi)]);
  bf16*Ow=Ou+(long)(wid*QBLK)*OP;
  { bf16*stg=(bf16*)(shm+LDS_OST)+wid*2048;
    #pragma unroll
    for(int r=0;r<16;++r){const int orow=crow(r,hi);
      #pragma unroll
      for(int d0=0;d0<2;++d0)stg[orow*64+d0*32+r32]=__float2bfloat16(o[d0][r]*rli[r]);}
    asm volatile("s_waitcnt lgkmcnt(0)":::"memory");
    #pragma unroll
    for(int i=0;i<4;++i){const int row=i*8+(lane>>3),ch=lane&7; const u32x4 v=*(const u32x4*)(stg+row*64+ch*8); ATTN_STORE16(Ow+(long)row*OP+ch*8,v);} }
  asm volatile("s_waitcnt lgkmcnt(0)\n\ts_barrier":::"memory");
  __builtin_amdgcn_s_setprio(0);
  #undef DMA_K
  #undef KROW
  #undef DMA_V
  #undef CMASK
  #undef START
  #undef RESC
  #undef ROT
}
constexpr int ATTN_LDS_BYTES=LDS_BYTES;
#undef SBAR
#undef WAIT_BAR
}

#define DI __device__ __forceinline__
#define LAS __attribute__((address_space(3)))
typedef unsigned short bf16;
typedef unsigned v4u __attribute__((ext_vector_type(4)));
typedef unsigned v2u __attribute__((ext_vector_type(2)));
typedef float f32x4 __attribute__((ext_vector_type(4)));
typedef float f32x2 __attribute__((ext_vector_type(2)));
typedef float f32x16 __attribute__((ext_vector_type(16)));
typedef short bf16x8 __attribute__((ext_vector_type(8)));
typedef __bf16 bf16x2_t __attribute__((ext_vector_type(2)));

constexpr int NWAVES = 8, NTHR = 512;
constexpr int BATCH = 2, SEQ = 8192, DM = 1024, LC = 256;
constexpr int NLAT = BATCH * SEQ;
constexpr int NROW = NLAT + BATCH * LC;
constexpr int KT = LC + SEQ;
constexpr int NEXP = 16;
constexpr float LOG2E = 1.4426950408889634f;
constexpr float QSCALE = 0.125f * LOG2E;
constexpr bool MOE_FP8 = true;
constexpr float WSCALE = 32.0f, WINV = 1.0f / 32.0f;

constexpr size_t MiB = 1u << 20;
constexpr size_t WS_CTL = 0, CTL_BYTES = 64 * 1024;
constexpr size_t WS_MOD = 1 * MiB;
constexpr size_t WS_COS = 2 * MiB, WS_SIN = 3 * MiB;
constexpr size_t WS_AFFT = 4 * MiB;
constexpr size_t WS_SLOT = 6 * MiB;
constexpr size_t WS_IDX = 8 * MiB;
constexpr size_t WS_GATEV = 9 * MiB;
constexpr size_t WS_SCH = 10 * MiB;
constexpr size_t WS_RST = 46 * MiB;
constexpr size_t WS_WABIN = 80 * MiB;
constexpr size_t WS_WABOUT = 83 * MiB;
constexpr size_t WS_WCDIN = 86 * MiB;
constexpr size_t WS_WCDOUT = 91 * MiB;
constexpr size_t WS_WGU = 96 * MiB;
constexpr size_t WS_WD = 352 * MiB;
constexpr size_t WS_XN = 480 * MiB;
constexpr size_t WS_X1 = 514 * MiB;
constexpr size_t WS_X2 = 580 * MiB;
constexpr size_t WS_XS = 646 * MiB;
constexpr size_t WS_ACT = 718 * MiB;
constexpr size_t WS_P = 718 * MiB;
constexpr size_t WS_CAT = 793 * MiB;
constexpr size_t WS_QA = 826 * MiB;
constexpr size_t WS_KA = 843 * MiB;
constexpr size_t WS_VTA = 848 * MiB;
constexpr size_t WS_END = 862 * MiB;

constexpr int LDS_BYTES = 147456;
constexpr int LDS_MISC = LDS_BYTES - 256;

struct Params { const float* in[25]; float* out; unsigned char* ws; unsigned long long pad; };

DI float bf2f(unsigned short b) { return __uint_as_float(((unsigned)b) << 16); }
DI unsigned cvtpk(float lo, float hi) { f32x2 v = {lo, hi}; bf16x2_t b = __builtin_convertvector(v, bf16x2_t); return __builtin_bit_cast(unsigned, b); }
DI unsigned short f2bf(float f) { return (unsigned short)(cvtpk(f, 0.f) & 0xffffu); }
DI float shx(float v, int o, int lane) { return __builtin_bit_cast(float, __builtin_amdgcn_ds_bpermute(((lane ^ o) & 63) << 2, __builtin_bit_cast(int, v))); }
DI int shxi(int v, int o, int lane) { return __builtin_amdgcn_ds_bpermute(((lane ^ o) & 63) << 2, v); }
DI float wave_sum(float v, int lane) {
#pragma unroll
    for (int o = 1; o < 64; o <<= 1) v += shx(v, o, lane);
    return v;
}
DI int crow(int i, int hi) { return (i & 3) + 8 * (i >> 2) + 4 * hi; }
#define MFMA32(a, b, c) __builtin_amdgcn_mfma_f32_32x32x16_bf16((a), (b), (c), 0, 0, 0)
#define LDS_WAIT() asm volatile("s_waitcnt lgkmcnt(0)" ::: "memory")

struct Ctx {
    int tid, lane, wave, vcu, G, gw, NGW;
    LAS unsigned char* lds;
};
typedef const __attribute__((address_space(4))) Params* KP;
DI void env(Params& p, Ctx& C, unsigned char* lds_raw) {
    KP kp = (KP)__builtin_amdgcn_kernarg_segment_ptr(); asm volatile("" : "+s"(kp) :: "memory");
#pragma unroll
    for (int i = 0; i < 25; ++i) p.in[i] = kp->in[i];
    p.out = kp->out; p.ws = kp->ws; p.pad = 0ull;
    int tid = threadIdx.x; asm volatile("" : "+v"(tid) :: "memory");
    C.lds = (LAS unsigned char*)lds_raw;
    C.tid = tid; C.lane = tid & 63; C.wave = __builtin_amdgcn_readfirstlane(tid >> 6);
    C.G = gridDim.x; { const int bx = blockIdx.x; C.vcu = (C.G % 8 == 0) ? (bx % 8) * (C.G / 8) + bx / 8 : bx; }
    C.gw = C.vcu * NWAVES + C.wave; C.NGW = C.G * NWAVES;
}

DI void transpose_item(const float* W, int N, int k0, int n0, bf16* dst, int dpitch, LAS float* scr  , int lane) {
    f32x4 t[16];
    const float* wp = W + (size_t)(k0 + (lane >> 4)) * N + n0 + (lane & 15) * 4;
#pragma unroll
    for (int i = 0; i < 16; ++i) t[i] = __builtin_nontemporal_load((const f32x4*)(wp + (size_t)(4 * i) * N));
#pragma unroll
    for (int i = 0; i < 16; ++i) { LAS float* sp = scr + ((lane >> 4) + 4 * i) * 65 + (lane & 15) * 4; sp[0] = t[i].x; sp[1] = t[i].y; sp[2] = t[i].z; sp[3] = t[i].w; }
    LDS_WAIT(); asm volatile("" ::: "memory");
    const int c = lane & 7;
#pragma unroll
    for (int j = 0; j < 8; ++j) { const int n = (lane >> 3) + 8 * j; const LAS float* s = scr + (8 * c) * 65 + n;
        v4u o; o.x = cvtpk(s[0 * 65], s[1 * 65]); o.y = cvtpk(s[2 * 65], s[3 * 65]); o.z = cvtpk(s[4 * 65], s[5 * 65]); o.w = cvtpk(s[6 * 65], s[7 * 65]);
        __builtin_nontemporal_store(o, (v4u*)(dst + (size_t)n * dpitch + 8 * c)); }
    LDS_WAIT(); asm volatile("" ::: "memory");
}

DI unsigned pk4f8(float a, float b, float c, float d) { unsigned w = 0u; w = __builtin_amdgcn_cvt_pk_fp8_f32(a, b, w, false); w = __builtin_amdgcn_cvt_pk_fp8_f32(c, d, w, true); return w; }
DI void transpose_item_f8(const float* W, int N, int k0, int n0, unsigned char* dst, int dpitch, LAS float* scr  , int lane) {
    f32x4 t[16];
    const float* wp = W + (size_t)(k0 + (lane >> 4)) * N + n0 + (lane & 15) * 4;
#pragma unroll
    for (int i = 0; i < 16; ++i) t[i] = __builtin_nontemporal_load((const f32x4*)(wp + (size_t)(4 * i) * N));
#pragma unroll
    for (int i = 0; i < 16; ++i) { LAS float* sp = scr + ((lane >> 4) + 4 * i) * 65 + (lane & 15) * 4; sp[0] = t[i].x * WSCALE; sp[1] = t[i].y * WSCALE; sp[2] = t[i].z * WSCALE; sp[3] = t[i].w * WSCALE; }
    LDS_WAIT(); asm volatile("" ::: "memory");
    const int c = lane & 3;
#pragma unroll
    for (int j = 0; j < 4; ++j) { const int n = (lane >> 2) + 16 * j; const LAS float* s = scr + (16 * c) * 65 + n;
        v4u o; o.x = pk4f8(s[0 * 65], s[1 * 65], s[2 * 65], s[3 * 65]); o.y = pk4f8(s[4 * 65], s[5 * 65], s[6 * 65], s[7 * 65]);
        o.z = pk4f8(s[8 * 65], s[9 * 65], s[10 * 65], s[11 * 65]); o.w = pk4f8(s[12 * 65], s[13 * 65], s[14 * 65], s[15 * 65]);
        __builtin_nontemporal_store(o, (v4u*)(dst + (size_t)n * dpitch + 16 * c)); }
    LDS_WAIT(); asm volatile("" ::: "memory");
}

constexpr int MOE_ITEMS = 3 * 16 * 512;
DI void convert_moe_item(const Params& p, int l, int it, LAS float* scr, int lane) {
    const int kind = it >> 13, r = it & 8191, mat = l * 16 + (r >> 9), rr = r & 511;
    if (kind < 2) { const int kb = rr >> 5, nb = rr & 31, n0 = 64 * nb; const float* src = (kind ? p.in[23] : p.in[22]) + (size_t)mat * 1024 * 2048;
        const int drow = mat * 4096 + (n0 >> 7) * 256 + (n0 & 127) + (kind ? 128 : 0);
        if (MOE_FP8) transpose_item_f8(src, 2048, 64 * kb, n0, (unsigned char*)(p.ws + WS_WGU) + (size_t)drow * 1024 + 64 * kb, 1024, scr, lane);
        else transpose_item(src, 2048, 64 * kb, n0, (bf16*)(p.ws + WS_WGU) + (size_t)drow * 1024 + 64 * kb, 1024, scr, lane); }
    else { const int kb = rr >> 4, nb = rr & 15; const float* src = p.in[24] + (size_t)mat * 2048 * 1024;
        if (MOE_FP8) transpose_item_f8(src, 1024, 64 * kb, 64 * nb, (unsigned char*)(p.ws + WS_WD) + (size_t)(mat * 1024 + 64 * nb) * 2048 + 64 * kb, 2048, scr, lane);
        else transpose_item(src, 1024, 64 * kb, 64 * nb, (bf16*)(p.ws + WS_WD) + (size_t)(mat * 1024 + 64 * nb) * 2048 + 64 * kb, 2048, scr, lane); }
}
struct SlotPlan { int base[6], nidle[6], q[6], covered[2]; };
DI SlotPlan make_slot_plan(int G) {
    SlotPlan sp; const int nunits[6] = {330, 264, 64, 576, 594, 32}; const int qq[6] = {40, 40, 40, 32, 32, 32};
#pragma unroll
    for (int st = 0; st < 2; ++st) { int acc = 0;
#pragma unroll
        for (int k = 3 * st; k < 3 * st + 3; ++k) { const int rounds = (nunits[k] + G - 1) / G; const int busy = nunits[k] - (rounds - 1) * G; const int ni = G - busy; sp.nidle[k] = ni; sp.base[k] = acc;
            sp.q[k] = qq[k]; acc += (ni > 0 ? ni : 0) * qq[k]; if (acc > MOE_ITEMS) acc = MOE_ITEMS; }
        sp.covered[st] = acc; }
    return sp;
}
DI void convert_slot(const Ctx& C, const Params& p, int k, int c) {
    const SlotPlan sp = make_slot_plan(C.G);
    const int ii = c - (C.G - sp.nidle[k]); if (ii < 0) return;
    const int first = sp.base[k] + ii * sp.q[k]; int last = first + sp.q[k]; if (last > MOE_ITEMS) last = MOE_ITEMS;
    LAS float* scr = (LAS float*)(C.lds + C.wave * 16640);
    for (int it = first + C.wave; it < last; it += NWAVES) convert_moe_item(p, k < 3 ? 0 : 1, it, scr, C.lane);
}

DI void ph0_prologue(const Ctx& C, const Params& p) {
    unsigned char* ws = p.ws;
    float* MOD = (float*)(ws + WS_MOD);
    {
        LAS float* sv = (LAS float*)(C.lds);
        LAS float* red = (LAS float*)(C.lds + 12288);
        for (int i = C.tid; i < 3 * 1024; i += NTHR) { const int r = i >> 10, k = i & 1023; const float cv = (r < 2) ? p.in[1][r * 1024 + k] : p.in[3][k]; sv[i] = cv / (1.f + __expf(-cv)); }
        __syncthreads();
        for (int item = C.vcu; item < 192; item += C.G) {
            const int l = item / 96, n0 = (item % 96) * 64;
            const float* W = p.in[4] + (size_t)l * 1024 * 6144 + n0 + C.lane;
            float a0 = 0.f, a1 = 0.f, a2 = 0.f;
            const int kb = C.wave * 128;
#pragma unroll 32
            for (int k = 0; k < 128; ++k) { const float w = __builtin_nontemporal_load(W + (size_t)(kb + k) * 6144); a0 += sv[kb + k] * w; a1 += sv[1024 + kb + k] * w; a2 += sv[2048 + kb + k] * w; }
            red[(C.wave * 3 + 0) * 64 + C.lane] = a0; red[(C.wave * 3 + 1) * 64 + C.lane] = a1; red[(C.wave * 3 + 2) * 64 + C.lane] = a2;
            __syncthreads();
            if (C.tid < 192) { const int r = C.tid >> 6, ln = C.tid & 63; float s = 0.f;
#pragma unroll
                for (int w = 0; w < 8; ++w) s += red[(w * 3 + r) * 64 + ln];
                MOD[(size_t)(l * 3 + r) * 6144 + n0 + ln] = s + p.in[5][l * 6144 + n0 + ln]; }
            __syncthreads();
        }
        __syncthreads();
    }
    {
        float* COS = (float*)(ws + WS_COS); float* SIN = (float*)(ws + WS_SIN);
        for (int i = C.vcu * NTHR + C.tid; i < SEQ * 32; i += C.G * NTHR) {
            const int t = i >> 5, j = i & 31; const int pos = (j < 16) ? (t >> 6) : (t & 63); const int fi = j & 15;
            const float freq = powf(10000.0f, -(float)fi / 16.0f); const float ang = (float)pos * freq;
            COS[i] = cosf(ang); SIN[i] = sinf(ang);
        }
    }
    {
        LAS float* scr = (LAS float*)(C.lds + C.wave * 16640);
        bf16* WABIN = (bf16*)(ws + WS_WABIN); bf16* WABOUT = (bf16*)(ws + WS_WABOUT);
        bf16* WCDIN = (bf16*)(ws + WS_WCDIN); bf16* WCDOUT = (bf16*)(ws + WS_WCDOUT); bf16* WGU = (bf16*)(ws + WS_WGU); bf16* WD = (bf16*)(ws + WS_WD);
        constexpr int I0 = 16 * 20, I1 = 8 * 16, I2 = 16 * 36, I3 = 16 * 16, I4 = 1024, I5 = 0, I6 = 16 * 512, I7 = 16 * 512, I8 = 16 * 512;
        constexpr int NITEMS = I0 + I1 + I2 + I3 + I4 + I5;
        for (int it = C.gw; it < NITEMS; it += C.NGW) {
            int r = it;
            if (r < I0) { const int kb = r / 20, nb = r % 20; transpose_item(p.in[9], 1280, 64 * kb, 64 * nb, WABIN + (size_t)(64 * nb) * 1024 + 64 * kb, 1024, scr, C.lane); continue; } r -= I0;
            if (r < I1) { const int kb = r / 16, nb = r % 16; transpose_item(p.in[10], 1024, 64 * kb, 64 * nb, WABOUT + (size_t)(64 * nb) * 1024 + 64 * kb, 1024, scr, C.lane); continue; } r -= I1;
            if (r < I2) { const int kb = r / 36, nb = r % 36; transpose_item(p.in[15], 2304, 64 * kb, 64 * nb, WCDIN + (size_t)(64 * nb) * 1024 + 64 * kb, 1024, scr, C.lane); continue; } r -= I2;
            if (r < I3) { const int kb = r / 16, nb = r % 16; transpose_item(p.in[16], 1024, 64 * kb, 64 * nb, WCDOUT + (size_t)(64 * nb) * 1024 + 64 * kb, 1024, scr, C.lane); continue; } r -= I3;
            if (r < I4) {
                const int g = r >> 8, cb = (r >> 4) & 15, nb = r & 15, c0 = 8 * cb, n0 = 64 * nb;
                const float* Wg = p.in[13] + (size_t)g * 128 * 128 + (size_t)c0 * 128; const float* bs = p.in[14] + g * 128; const float* Wo = p.in[10] + (size_t)(512 + g * 128) * 1024 + n0 + C.lane;
                float a8[8];
#pragma unroll
                for (int ci = 0; ci < 8; ++ci) a8[ci] = 0.f;
#pragma unroll 8
                for (int d = 0; d < 128; ++d) { const float w = Wo[(size_t)d * 1024] * bs[d];
#pragma unroll
                    for (int ci = 0; ci < 8; ++ci) a8[ci] += Wg[ci * 128 + d] * w; }
                v4u o; o.x = cvtpk(a8[0], a8[1]); o.y = cvtpk(a8[2], a8[3]); o.z = cvtpk(a8[4], a8[5]); o.w = cvtpk(a8[6], a8[7]);
                *(v4u*)(WABOUT + (size_t)(n0 + C.lane) * 1024 + 512 + g * 128 + c0) = o; continue; } r -= I4;
        }
        { const SlotPlan sp = make_slot_plan(C.G);
          const int n0 = MOE_ITEMS - sp.covered[0], n1 = MOE_ITEMS - sp.covered[1];
          for (int it = C.gw; it < n0 + n1; it += C.NGW) { if (it < n0) convert_moe_item(p, 0, sp.covered[0] + it, scr, C.lane); else convert_moe_item(p, 1, sp.covered[1] + (it - n0), scr, C.lane); } }
    }
}

DI void load_row(const float* src, int lane, f32x4 (&v)[4]) {
#pragma unroll
    for (int j = 0; j < 4; ++j) v[j] = __builtin_nontemporal_load((const f32x4*)src + lane + 64 * j);
}
DI void load_row_h(const bf16* src, int lane, f32x4 (&v)[4]) {
#pragma unroll
    for (int j = 0; j < 4; ++j) { const v2u w = __builtin_nontemporal_load((const v2u*)src + lane + 64 * j); v[j] = (f32x4){__uint_as_float(w.x << 16), __uint_as_float(w.x & 0xffff0000u), __uint_as_float(w.y << 16), __uint_as_float(w.y & 0xffff0000u)}; }
}
DI float row_rstd(const f32x4 (&v)[4], float eps, int lane) {
    float s = 0.f;
#pragma unroll
    for (int j = 0; j < 4; ++j) s += (v[j].x * v[j].x + v[j].y * v[j].y) + (v[j].z * v[j].z + v[j].w * v[j].w);
    s = wave_sum(s, lane);
    return rsqrtf(s * (1.0f / 1024.0f) + eps);
}
template <bool OUT_FP8 = false>
DI void modulate_row(f32x4 (&v)[4], const float* g, const float* shift, const float* scale, bf16* dst, int lane) {
    const float rstd = row_rstd(v, 1e-6f, lane);
#pragma unroll
    for (int j = 0; j < 4; ++j) {
        const f32x4 gg = ((const f32x4*)g)[lane + 64 * j], sh = ((const f32x4*)shift)[lane + 64 * j], sc = ((const f32x4*)scale)[lane + 64 * j];
        v[j] = v[j] * rstd * gg * (sc + 1.0f) + sh;
        if (OUT_FP8) ((unsigned*)dst)[lane + 64 * j] = pk4f8(v[j].x, v[j].y, v[j].z, v[j].w);
        else { v2u w; w.x = cvtpk(v[j].x, v[j].y); w.y = cvtpk(v[j].z, v[j].w); ((v2u*)dst)[lane + 64 * j] = w; }
    }
}

DI void ph_modulate0(const Ctx& C, const Params& p) {
    const float* MOD = (const float*)(p.ws + WS_MOD); bf16* XN = (bf16*)(p.ws + WS_XN);
    for (int r0 = C.gw; r0 < NROW; r0 += 2 * C.NGW) {
        int rr[2] = {r0, r0 + C.NGW}; if (rr[1] >= NROW) rr[1] = r0;
        f32x4 v[2][4];
#pragma unroll
        for (int q = 0; q < 2; ++q) { const int r = rr[q]; const float* src = r < NLAT ? p.in[0] + (size_t)r * DM : p.in[2] + (size_t)(r - NLAT) * DM; load_row(src, C.lane, v[q]); }
#pragma unroll
        for (int q = 0; q < 2; ++q) { const int r = rr[q]; const int mi = r < NLAT ? (r >> 13) : 2; const float* mp = MOD + (size_t)(0 * 3 + mi) * 6144;
            modulate_row(v[q], p.in[6], mp, mp + 1024, XN + (size_t)r * DM, C.lane); }
    }
}

struct HeadRegs { v2u a, b; };
DI HeadRegs heads8_load(const bf16* src, int nheads, int lane) {
    const int hd = lane >> 3, hdc = hd < nheads ? hd : nheads - 1, j0 = (lane & 7) * 4;
    HeadRegs h; h.a = __builtin_nontemporal_load((const v2u*)(src + hdc * 64 + j0)); h.b = __builtin_nontemporal_load((const v2u*)(src + hdc * 64 + 32 + j0)); return h;
}
DI void heads8_finish(const HeadRegs h, int nheads, bool donorm, const f32x4 g1, const f32x4 g2, bool dorope, const f32x4 c, const f32x4 sv, float scale, bf16* dst, int lane) {
    const int hd = lane >> 3, j0 = (lane & 7) * 4;
    float x1[4] = {__uint_as_float(h.a.x << 16), __uint_as_float(h.a.x & 0xffff0000u), __uint_as_float(h.a.y << 16), __uint_as_float(h.a.y & 0xffff0000u)};
    float x2[4] = {__uint_as_float(h.b.x << 16), __uint_as_float(h.b.x & 0xffff0000u), __uint_as_float(h.b.y << 16), __uint_as_float(h.b.y & 0xffff0000u)};
    if (donorm) { float ss = 0.f;
#pragma unroll
        for (int i = 0; i < 4; ++i) ss += x1[i] * x1[i] + x2[i] * x2[i];
        ss += shx(ss, 1, lane); ss += shx(ss, 2, lane); ss += shx(ss, 4, lane);
        const float rs = rsqrtf(ss * (1.0f / 64.0f) + 1e-6f);
#pragma unroll
        for (int i = 0; i < 4; ++i) { x1[i] *= rs * g1[i]; x2[i] *= rs * g2[i]; } }
    if (dorope) {
#pragma unroll
        for (int i = 0; i < 4; ++i) { const float o1 = x1[i] * c[i] - x2[i] * sv[i], o2 = x1[i] * sv[i] + x2[i] * c[i]; x1[i] = o1; x2[i] = o2; } }
    if (hd < nheads) { v2u o1, o2; o1.x = cvtpk(x1[0] * scale, x1[1] * scale); o1.y = cvtpk(x1[2] * scale, x1[3] * scale); o2.x = cvtpk(x2[0] * scale, x2[1] * scale); o2.y = cvtpk(x2[2] * scale, x2[3] * scale);
        *(v2u*)(dst + hd * 64 + j0) = o1; *(v2u*)(dst + hd * 64 + 32 + j0) = o2; }
}

DI void ph_post0(const Ctx& C, const Params& p) {
    const bf16* P = (const bf16*)(p.ws + WS_P); bf16* QA = (bf16*)(p.ws + WS_QA); bf16* KA = (bf16*)(p.ws + WS_KA); bf16* VA = (bf16*)(p.ws + WS_VTA); bf16* CATB = (bf16*)(p.ws + WS_CAT) + 512;
    const float* COS = (const float*)(p.ws + WS_COS); const float* SIN = (const float*)(p.ws + WS_SIN);
    const int j0 = (C.lane & 7) * 4;
    const f32x4 qg1 = *(const f32x4*)(p.in[11] + j0), qg2 = *(const f32x4*)(p.in[11] + 32 + j0), kg1 = *(const f32x4*)(p.in[12] + j0), kg2 = *(const f32x4*)(p.in[12] + 32 + j0);
    for (int r0 = C.gw; r0 < NROW; r0 += 2 * C.NGW) {
        int rr[2] = {r0, r0 + C.NGW}; if (rr[1] >= NROW) rr[1] = r0;
        bool isctx[2]; int bb[2], pos[2], kk[2]; const bf16* prow[2];
#pragma unroll
        for (int q = 0; q < 2; ++q) { const int r = rr[q]; isctx[q] = r >= NLAT; bb[q] = isctx[q] ? ((r - NLAT) >> 8) : (r >> 13); pos[q] = isctx[q] ? ((r - NLAT) & 255) : (r & 8191);
            kk[q] = isctx[q] ? pos[q] : LC + pos[q]; prow[q] = P + (size_t)r * 1280; }
        HeadRegs hq[2], hk[2]; v4u vc[2], uu[2]; f32x4 c4[2], s4[2];
#pragma unroll
        for (int q = 0; q < 2; ++q) { hq[q] = heads8_load(prow[q], 8, C.lane); hk[q] = heads8_load(prow[q] + 512, 2, C.lane);
            vc[q] = *(const v4u*)(prow[q] + 640 + (C.lane & 15) * 8); uu[q] = *(const v4u*)(prow[q] + 768 + C.lane * 8);
            const size_t tp = (size_t)(isctx[q] ? 0 : pos[q]) * 32 + j0; c4[q] = *(const f32x4*)(COS + tp); s4[q] = *(const f32x4*)(SIN + tp); }
        const int c0 = C.lane * 8, g = C.lane >> 4, w = 2 << g;
        int lo[2], hi[2]; float s[2][8];
#pragma unroll
        for (int q = 0; q < 2; ++q) { const int L = isctx[q] ? LC : SEQ; lo[q] = max(pos[q] - (w >> 1), 0); hi[q] = min(pos[q] - (w >> 1) + w, L);
#pragma unroll
            for (int i = 0; i < 8; ++i) s[q][i] = 0.f; }
#pragma unroll
        for (int bt = 0; bt < 2; ++bt) {
            if (bt == 1 && !__any((lo[0] + 8 < hi[0]) || (lo[1] + 8 < hi[1]))) break;
            v4u vv[2][8];
#pragma unroll
            for (int q = 0; q < 2; ++q) { const size_t rowbase = (size_t)rr[q] - pos[q];
#pragma unroll
                for (int k = 0; k < 8; ++k) { const int rw = min(lo[q] + 8 * bt + k, hi[q] - 1); vv[q][k] = *(const v4u*)(P + (rowbase + rw) * 1280 + 768 + c0); } }
            if (bt == 0) {
#pragma unroll
                for (int q = 0; q < 2; ++q) {
                    heads8_finish(hq[q], 8, true, qg1, qg2, !isctx[q], c4[q], s4[q], QSCALE, QA + (size_t)rr[q] * 512, C.lane);
                    heads8_finish(hk[q], 2, true, kg1, kg2, !isctx[q], c4[q], s4[q], 1.0f, KA + ((size_t)bb[q] * KT + kk[q]) * 128, C.lane);
                    if (C.lane < 16) *(v4u*)(VA + ((size_t)bb[q] * KT + kk[q]) * 128 + C.lane * 8) = vc[q]; }
            }
#pragma unroll
            for (int q = 0; q < 2; ++q)
#pragma unroll
                for (int k = 0; k < 8; ++k) { const float wgt = (lo[q] + 8 * bt + k < hi[q]) ? 1.0f : 0.0f;
#pragma unroll
                    for (int i = 0; i < 4; ++i) { s[q][2 * i] += wgt * __uint_as_float(vv[q][k][i] << 16); s[q][2 * i + 1] += wgt * __uint_as_float(vv[q][k][i] & 0xffff0000u); } }
        }
#pragma unroll
        for (int q = 0; q < 2; ++q) { const float inv = 1.0f / (float)(hi[q] - lo[q]); v4u o;
#pragma unroll
            for (int i = 0; i < 4; ++i) o[i] = cvtpk(s[q][2 * i] * inv - __uint_as_float(uu[q][i] << 16), s[q][2 * i + 1] * inv - __uint_as_float(uu[q][i] & 0xffff0000u));
            *(v4u*)(CATB + (size_t)rr[q] * 1024 + c0) = o; }
    }
}

DI void ph_post1(const Ctx& C, const Params& p) {
    bf16* P = (bf16*)(p.ws + WS_P); bf16* KA = (bf16*)(p.ws + WS_KA); bf16* VTA = (bf16*)(p.ws + WS_VTA);
    const float* COS = (const float*)(p.ws + WS_COS); const float* SIN = (const float*)(p.ws + WS_SIN);
    const int j0 = (C.lane & 7) * 4; const f32x4 one = (f32x4){1.f, 1.f, 1.f, 1.f};
    for (int r0 = C.gw; r0 < NROW; r0 += 2 * C.NGW) {
        int rr[2] = {r0, r0 + C.NGW}; const bool dup = rr[1] >= NROW; if (dup) rr[1] = r0;
        bool isctx[2]; int bb[2], kk[2]; bf16* prow[2];
        HeadRegs hcq[2], hck[2], hdq[2], hdk[2]; v4u vc[2]; f32x4 c4[2], s4[2];
#pragma unroll
        for (int q = 0; q < 2; ++q) { const int r = rr[q]; isctx[q] = r >= NLAT; bb[q] = isctx[q] ? ((r - NLAT) >> 8) : (r >> 13); const int pos = isctx[q] ? ((r - NLAT) & 255) : (r & 8191);
            kk[q] = isctx[q] ? pos : LC + pos; prow[q] = P + (size_t)r * 2304;
            hcq[q] = heads8_load(prow[q], 4, C.lane); hck[q] = heads8_load(prow[q] + 256, 4, C.lane); hdq[q] = heads8_load(prow[q] + 1536, 8, C.lane); hdk[q] = heads8_load(prow[q] + 2048, 2, C.lane);
            vc[q] = *(const v4u*)(prow[q] + 2176 + (C.lane & 15) * 8);
            const size_t tp = (size_t)(isctx[q] ? 0 : pos) * 32 + j0; c4[q] = *(const f32x4*)(COS + tp); s4[q] = *(const f32x4*)(SIN + tp); }
#pragma unroll
        for (int q = 0; q < 2; ++q) { if (q == 1 && dup) break;
            if (!isctx[q]) { heads8_finish(hcq[q], 4, false, one, one, true, c4[q], s4[q], 1.0f, prow[q], C.lane); heads8_finish(hdq[q], 8, false, one, one, true, c4[q], s4[q], QSCALE, prow[q] + 1536, C.lane); }
            heads8_finish(hck[q], 4, false, one, one, !isctx[q], c4[q], s4[q], 0.125f, prow[q] + 256, C.lane);
            heads8_finish(hdk[q], 2, false, one, one, !isctx[q], c4[q], s4[q], 1.0f, KA + ((size_t)bb[q] * KT + kk[q]) * 128, C.lane);
            if (C.lane < 16) *(v4u*)(VTA + ((size_t)bb[q] * KT + kk[q]) * 128 + C.lane * 8) = vc[q]; }
    }
}

DI void ph_attn_dense(const Ctx& C, const Params& p, unsigned char* lds_raw) {
    typedef attn_body::bf16 abf;
    const abf* QA = (const abf*)(p.ws + WS_QA); const abf* KA = (const abf*)(p.ws + WS_KA); const abf* VA = (const abf*)(p.ws + WS_VTA); abf* CAT = (abf*)(p.ws + WS_CAT);
    for (int u = C.vcu; u < 512 + 16; u += C.G) {
        if (u < 512) { const int qb = u & 31, h = (u >> 5) & 7, b = u >> 8; const size_t row0 = (size_t)b * SEQ + 256 * qb; const size_t kv0 = (size_t)b * KT * 128 + (h >> 2) * 64;
            attn_body::attn_unit<8, false>(QA + row0 * 512 + h * 64, 512, KA + kv0, VA + kv0, 128, KT / 64, CAT + row0 * 1024 + h * 64, 1024, (char*)lds_raw, 0, 0, 0.f); }
        else { const int v = u - 512; const int h = v & 7, b = v >> 3; const size_t row0 = (size_t)NLAT + b * LC; const size_t kv0 = (size_t)b * KT * 128 + (h >> 2) * 64;
            attn_body::attn_unit<8, false>(QA + row0 * 512 + h * 64, 512, KA + kv0, VA + kv0, 128, LC / 64, CAT + row0 * 1024 + h * 64, 1024, (char*)lds_raw, 0, 0, 0.f); }
    }
}
DI void ph_attn_window(const Ctx& C, const Params& p, unsigned char* lds_raw) {
    typedef attn_body::bf16 abf;
    const abf* P = (const abf*)(p.ws + WS_P); const abf* KA = (const abf*)(p.ws + WS_KA); const abf* VA = (const abf*)(p.ws + WS_VTA); abf* CAT = (abf*)(p.ws + WS_CAT);
    for (int u = C.vcu; u < 512; u += C.G) {
        const int qb = u & 31, h = (u >> 5) & 7, b = u >> 8; const int q0 = 256 * qb; const size_t row0 = (size_t)b * SEQ + q0; const size_t kv0 = (size_t)b * KT * 128 + (h >> 2) * 64;
        const int lo = max(q0 - 128, 0), hi = min(q0 + 384, SEQ);
        attn_body::attn_unit<8, true>(P + row0 * 2304 + 1536 + h * 64, 2304, KA + kv0, VA + kv0, 128, 4 + (hi - lo) / 64, CAT + row0 * 1024 + 512 + h * 64, 1024, (char*)lds_raw, lo, q0, p.in[20][h] * LOG2E);
    }
}

DI void ph_ffn_norm_router(const Ctx& C, const Params& p, int l, int nrows) {
    const float* MOD = (const float*)(p.ws + WS_MOD); unsigned char* XN8 = p.ws + WS_XN; const bf16* X1 = (const bf16*)(p.ws + WS_X1); float* AFFT = (float*)(p.ws + WS_AFFT);
    LAS bf16* Bh = (LAS bf16*)C.lds;
    LAS bf16* Bl = Bh + 16384;
    LAS float* GS = (LAS float*)(C.lds + 65536);
    LAS float* SH = GS + 1024;
    LAS float* cb = SH + 1024;
    const int G = C.G, w = C.vcu;
    int mi, t0, t1, rbase;
    { const int gc = nrows == NROW ? (G >= 32 ? G / 32 : 1) : 0, gl = (G - gc) / 2;
      if (w < gl) { mi = 0; rbase = 0; t0 = (w * 512) / gl; t1 = ((w + 1) * 512) / gl; }
      else if (nrows != NROW || w < 2 * gl) { const int n = nrows == NROW ? gl : G - gl, i = w - gl; mi = 1; rbase = SEQ; t0 = (i * 512) / n; t1 = ((i + 1) * 512) / n; }
      else { const int n = G - 2 * gl, i = w - 2 * gl; mi = 2; rbase = NLAT; t0 = (i * 32) / n; t1 = ((i + 1) * 32) / n; } }
    const float* mp = MOD + (size_t)(l * 3 + mi) * 6144; const float* gw = p.in[7] + l * 1024; const float* shp = mp + 3 * 1024; const float* scp = mp + 4 * 1024;
    const float* RW = p.in[21] + (size_t)l * 1024 * 16;
    const int wv = __builtin_amdgcn_readfirstlane(C.wave);
    const int row = C.lane & 15, kg = C.lane >> 4;
    unsigned xo = (unsigned)(row * 1024 + 32 * kg); asm volatile("" : "+v"(xo));
    v4u xq[8][4];
    int t = t0 + wv;
    if (t < t1) { const bf16* xt = X1 + (size_t)(rbase + 16 * t) * DM;
#pragma unroll
        for (int q = 0; q < 8; ++q)
#pragma unroll
            for (int c = 0; c < 4; ++c) xq[q][c] = __builtin_nontemporal_load((const v4u*)(xt + xo + 128 * q + 8 * c)); }
    { float wr[32];
#pragma unroll
      for (int it = 0; it < 32; ++it) wr[it] = RW[C.tid + NTHR * it];
#pragma unroll
      for (int h = 0; h < 2; ++h) { const int k = C.tid + NTHR * h; GS[k] = gw[k] * (scp[k] + 1.0f); SH[k] = shp[k]; }
      __syncthreads();
      float cacc = 0.f;
      unsigned tq = (unsigned)C.tid; asm volatile("" : "+v"(tq));
      const unsigned e = tq & 15u, kb = tq >> 4;
      unsigned ob = ((((kb >> 3) * 4u) * 16u + e) * 8u + (kb & 7u)); asm volatile("" : "+v"(ob));
#pragma unroll
      for (int it = 0; it < 32; ++it) {
          const float gk = GS[kb + 32 * it], shk = SH[kb + 32 * it];
          const float bf = gk * wr[it]; const unsigned short hi = f2bf(bf); const unsigned short lo = f2bf(bf - bf2f(hi));
          const int o = ((4 * (it >> 2)) * 4 + (it & 3)) * 16 * 8;
          Bh[ob + o] = hi; Bl[ob + o] = lo; cacc += shk * wr[it]; }
      cacc += shx(cacc, 16, C.lane); cacc += shx(cacc, 32, C.lane);
      if (C.lane < 16) cb[wv * 16 + C.lane] = cacc; }
    __syncthreads();
    float cbias = 0.f;
#pragma unroll
    for (int ww = 0; ww < 8; ++ww) cbias += cb[ww * 16 + row];
    while (t < t1) {
        const int r0 = rbase + 16 * t;
        f32x4 acc = (f32x4){0.f, 0.f, 0.f, 0.f}; float ssq = 0.f;
        int ln = C.lane; asm volatile("" : "+v"(ln));
        unsigned lb = (unsigned)ln * 8u;
#pragma unroll
        for (int q = 0; q < 8; ++q)
#pragma unroll
            for (int c = 0; c < 4; ++c) {
                const bf16x8 bh = *(const LAS bf16x8*)(Bh + lb + (4 * q + c) * 512), bl = *(const LAS bf16x8*)(Bl + lb + (4 * q + c) * 512);
                const bf16x8 a = __builtin_bit_cast(bf16x8, xq[q][c]);
                acc = __builtin_amdgcn_mfma_f32_16x16x32_bf16(a, bh, acc, 0, 0, 0);
                acc = __builtin_amdgcn_mfma_f32_16x16x32_bf16(a, bl, acc, 0, 0, 0);
#pragma unroll
                for (int d = 0; d < 4; ++d) { const float x0 = __uint_as_float(xq[q][c][d] << 16), x1 = __uint_as_float(xq[q][c][d] & 0xffff0000u); ssq += x0 * x0 + x1 * x1; }
            }
        ssq += shx(ssq, 16, ln); ssq += shx(ssq, 32, ln);
        const float rstd = rsqrtf(ssq * (1.0f / 1024.0f) + 1e-6f);
        f32x4 af;
#pragma unroll
        for (int i = 0; i < 4; ++i) {
            const float rs = __builtin_bit_cast(float, __builtin_amdgcn_ds_bpermute((((ln >> 4) * 4 + i) << 2), __builtin_bit_cast(int, rstd)));
            const float lgt = acc[i] * rs + cbias;
            float mx = lgt; mx = fmaxf(mx, shx(mx, 1, ln)); mx = fmaxf(mx, shx(mx, 2, ln)); mx = fmaxf(mx, shx(mx, 4, ln)); mx = fmaxf(mx, shx(mx, 8, ln));
            const float ex = __expf(lgt - mx);
            float den = ex; den += shx(den, 1, ln); den += shx(den, 2, ln); den += shx(den, 4, ln); den += shx(den, 8, ln);
            af[i] = ex / den;
        }
        *(f32x4*)(AFFT + (size_t)row * NROW + r0 + 4 * kg) = af;
        unsigned char* ho = XN8 + (size_t)r0 * DM;
#pragma unroll
        for (int q = 0; q < 8; ++q)
#pragma unroll
            for (int c = 0; c < 4; ++c) asm volatile("" : "+v"(xq[q][c]));
        unsigned go = (unsigned)(32 * (ln >> 4));
#pragma unroll
        for (int q = 0; q < 8; ++q) {
            v4u o0, o1;
#pragma unroll
            for (int c = 0; c < 4; ++c) {
                const f32x4 g0 = *(const LAS f32x4*)(GS + go + 128 * q + 8 * c), g1 = *(const LAS f32x4*)(GS + go + 128 * q + 8 * c + 4);
                const f32x4 s0 = *(const LAS f32x4*)(SH + go + 128 * q + 8 * c), s1 = *(const LAS f32x4*)(SH + go + 128 * q + 8 * c + 4);
                const v4u xx = xq[q][c];
                const float h0 = __uint_as_float(xx.x << 16) * rstd * g0.x + s0.x, h1 = __uint_as_float(xx.x & 0xffff0000u) * rstd * g0.y + s0.y;
                const float h2 = __uint_as_float(xx.y << 16) * rstd * g0.z + s0.z, h3 = __uint_as_float(xx.y & 0xffff0000u) * rstd * g0.w + s0.w;
                const float h4 = __uint_as_float(xx.z << 16) * rstd * g1.x + s1.x, h5 = __uint_as_float(xx.z & 0xffff0000u) * rstd * g1.y + s1.y;
                const float h6 = __uint_as_float(xx.w << 16) * rstd * g1.z + s1.z, h7 = __uint_as_float(xx.w & 0xffff0000u) * rstd * g1.w + s1.w;
                const unsigned p0 = pk4f8(h0, h1, h2, h3), p1 = pk4f8(h4, h5, h6, h7);
                if (c == 0) { o0.x = p0; o0.y = p1; } else if (c == 1) { o0.z = p0; o0.w = p1; } else if (c == 2) { o1.x = p0; o1.y = p1; } else { o1.z = p0; o1.w = p1; }
            }
            *(v4u*)(ho + xo + 128 * q) = o0; *(v4u*)(ho + xo + 128 * q + 16) = o1;
        }
        t += 8;
        if (t < t1) { const bf16* xt = X1 + (size_t)(rbase + 16 * t) * DM;
#pragma unroll
            for (int q = 0; q < 8; ++q)
#pragma unroll
                for (int c = 0; c < 4; ++c) xq[q][c] = __builtin_nontemporal_load((const v4u*)(xt + xo + 128 * q + 8 * c)); }
    }
    __syncthreads();
}

DI int block_exscan_i(int v, LAS int* wt  , int wave, int lane, int& tot) {
    int x = v;
#pragma unroll
    for (int o = 1; o < 64; o <<= 1) { const int y = __builtin_amdgcn_ds_bpermute(((lane - o) & 63) << 2, x); if (lane >= o) x += y; }
    __syncthreads();
    if (lane == 63) wt[wave] = x;
    __syncthreads();
    int base = 0; tot = 0;
#pragma unroll
    for (int w = 0; w < 8; ++w) { const int t = wt[w]; tot += t; if (w < wave) base += t; }
    return base + x - v;
}

DI void ph_select(const Ctx& C, const Params& p, int nsets, int RPE) {
    const float* AFFT = (const float*)(p.ws + WS_AFFT); int* SLOT = (int*)(p.ws + WS_SLOT); int* IDX = (int*)(p.ws + WS_IDX); float* GATEV = (float*)(p.ws + WS_GATEV);
    LAS int* red = (LAS int*)C.lds; LAS int* wt = (LAS int*)(C.lds + 256);
    { const int nvalid = nsets == 4 ? 2112 : 2048, npad = RPE - nvalid;
      for (int i = C.vcu * NTHR + C.tid; i < NEXP * npad; i += C.G * NTHR) { const int e = i / npad, j = i % npad; IDX[e * RPE + nvalid + j] = 0; GATEV[e * RPE + nvalid + j] = 0.f; } }
    for (int task = C.vcu; task < nsets * NEXP; task += C.G) {
        const int set = task >> 4, e = task & 15;
        const int n = set < 2 ? SEQ : LC, cap = set < 2 ? 1024 : 32;
        const int rowbase = set < 2 ? set * SEQ : NLAT + (set - 2) * LC;
        const int slotbase = set < 2 ? set * 1024 : 2048 + (set - 2) * 32;
        unsigned key[16];
        const int tok0 = C.tid * 16;
#pragma unroll
        for (int q = 0; q < 4; ++q) { v4u kv = (v4u){0u, 0u, 0u, 0u}; if (tok0 + 4 * q < n) kv = *(const v4u*)(AFFT + (size_t)e * NROW + rowbase + tok0 + 4 * q); key[4 * q] = kv.x; key[4 * q + 1] = kv.y; key[4 * q + 2] = kv.z; key[4 * q + 3] = kv.w; }
        unsigned prefix = 0u;
        __syncthreads();
        for (int bit = 30; bit >= 0; --bit) {
            const unsigned cand = prefix | (1u << bit); int cnt = 0;
#pragma unroll
            for (int i = 0; i < 16; ++i) cnt += __popcll(__ballot(key[i] >= cand));
            if (C.lane == 0) red[(bit & 1) * 8 + C.wave] = cnt;
            __syncthreads();
            int total = 0;
#pragma unroll
            for (int w = 0; w < 8; ++w) total += red[(bit & 1) * 8 + w];
            if (total >= cap) prefix = cand;
        }
        const unsigned T = prefix;
        int gtc = 0, eqc = 0;
#pragma unroll
        for (int i = 0; i < 16; ++i) { gtc += (key[i] > T) ? 1 : 0; eqc += (key[i] == T) ? 1 : 0; }
        int totgt, toteq;
        (void)block_exscan_i(gtc, wt, C.wave, C.lane, totgt);
        int eqrank = block_exscan_i(eqc, wt, C.wave, C.lane, toteq);
        const int need_eq = cap - totgt;
        unsigned selmask = 0u; int selc = 0;
#pragma unroll
        for (int i = 0; i < 16; ++i) { bool s = key[i] > T; if (key[i] == T) { s = eqrank < need_eq; ++eqrank; } if (s) { selmask |= 1u << i; ++selc; } }
        int totsel;
        int slot = block_exscan_i(selc, wt, C.wave, C.lane, totsel);
#pragma unroll
        for (int i = 0; i < 16; ++i) { const int tok = tok0 + i;
            if (tok < n) { const int row = rowbase + tok;
                if (selmask & (1u << i)) { const int sp = slotbase + slot; SLOT[(size_t)row * 16 + e] = sp; IDX[e * RPE + sp] = row; GATEV[e * RPE + sp] = __uint_as_float(key[i]); ++slot; }
                else SLOT[(size_t)row * 16 + e] = -1; } }
        __syncthreads();
    }
}

DI void ph_combine(const Ctx& C, const Params& p, int l, int nrows, int RPE) {
    const float* MOD = (const float*)(p.ws + WS_MOD); const bf16* X1 = (const bf16*)(p.ws + WS_X1); const int* SLOT = (const int*)(p.ws + WS_SLOT); const bf16* Y = (const bf16*)(p.ws + WS_XS);
    bf16* X2 = (bf16*)(p.ws + WS_X2); bf16* XN = (bf16*)(p.ws + WS_XN);
    int svn[2]; f32x4 vn[2][4];
    if (C.gw < nrows) {
#pragma unroll
        for (int q = 0; q < 2; ++q) { int r = C.gw + q * C.NGW; if (r >= nrows) r = C.gw; svn[q] = (C.lane < 16) ? SLOT[(size_t)r * 16 + C.lane] : -1; load_row_h(X1 + (size_t)r * DM, C.lane, vn[q]); } }
    for (int r0 = C.gw; r0 < nrows; r0 += 2 * C.NGW) {
        int rr[2] = {r0, r0 + C.NGW}; if (rr[1] >= nrows) rr[1] = r0;
        int sv[2]; f32x4 v[2][4], acc[2][4];
#pragma unroll
        for (int q = 0; q < 2; ++q) { sv[q] = svn[q];
#pragma unroll
            for (int j = 0; j < 4; ++j) v[q][j] = vn[q][j]; }
        { const int rn0 = r0 + 2 * C.NGW;
          if (rn0 < nrows) {
#pragma unroll
            for (int q = 0; q < 2; ++q) { int r = rn0 + q * C.NGW; if (r >= nrows) r = rn0; svn[q] = (C.lane < 16) ? SLOT[(size_t)r * 16 + C.lane] : -1; load_row_h(X1 + (size_t)r * DM, C.lane, vn[q]); } } }
        unsigned msk[2]; const v2u* yp[2][4]; float fw[2][4];
#pragma unroll
        for (int q = 0; q < 2; ++q) { msk[q] = (unsigned)__ballot(sv[q] >= 0);
#pragma unroll
            for (int k = 0; k < 4; ++k) { const bool has = msk[q] != 0u; const int e = has ? __builtin_amdgcn_readfirstlane(__builtin_ctz(msk[q])) : 0; const int sl = __builtin_amdgcn_readlane(sv[q], e);
                yp[q][k] = has ? (const v2u*)(Y + ((size_t)e * RPE + sl) * DM) : (const v2u*)Y; fw[q][k] = has ? 1.0f : 0.0f; if (has) msk[q] &= msk[q] - 1; } }
        v2u w[2][4][4];
#pragma unroll
        for (int q = 0; q < 2; ++q)
#pragma unroll
            for (int k = 0; k < 4; ++k)
#pragma unroll
                for (int j = 0; j < 4; ++j) w[q][k][j] = __builtin_nontemporal_load(yp[q][k] + C.lane + 64 * j);
#pragma unroll
        for (int q = 0; q < 2; ++q)
#pragma unroll
            for (int j = 0; j < 4; ++j) { f32x4 a = (f32x4){0.f, 0.f, 0.f, 0.f};
#pragma unroll
                for (int k = 0; k < 4; ++k) { const float f = fw[q][k]; const v2u ww = w[q][k][j];
                    a.x += f * __uint_as_float(ww.x << 16); a.y += f * __uint_as_float(ww.x & 0xffff0000u); a.z += f * __uint_as_float(ww.y << 16); a.w += f * __uint_as_float(ww.y & 0xffff0000u); }
                acc[q][j] = a; }
#pragma unroll
        for (int q = 0; q < 2; ++q)
            while (msk[q]) { const int e = __builtin_amdgcn_readfirstlane(__builtin_ctz(msk[q])); msk[q] &= msk[q] - 1; const int sl = __builtin_amdgcn_readlane(sv[q], e);
                const v2u* y0 = (const v2u*)(Y + ((size_t)e * RPE + sl) * DM);
#pragma unroll
                for (int j = 0; j < 4; ++j) { const v2u ww = __builtin_nontemporal_load(y0 + C.lane + 64 * j);
                    acc[q][j].x += __uint_as_float(ww.x << 16); acc[q][j].y += __uint_as_float(ww.x & 0xffff0000u); acc[q][j].z += __uint_as_float(ww.y << 16); acc[q][j].w += __uint_as_float(ww.y & 0xffff0000u); } }
#pragma unroll
        for (int q = 0; q < 2; ++q) { const int r = rr[q]; const int mi = r < NLAT ? (r >> 13) : 2;
            const float* g2 = MOD + (size_t)(l * 3 + mi) * 6144 + 5 * 1024;
#pragma unroll
            for (int j = 0; j < 4; ++j) v[q][j] = v[q][j] + ((const f32x4*)g2)[C.lane + 64 * j] * acc[q][j];
            if (l == 0) {
#pragma unroll
                for (int j = 0; j < 4; ++j) { v2u w; w.x = cvtpk(v[q][j].x, v[q][j].y); w.y = cvtpk(v[q][j].z, v[q][j].w); __builtin_nontemporal_store(w, (v2u*)(X2 + (size_t)r * DM) + C.lane + 64 * j); }
                const float* mp = MOD + (size_t)(1 * 3 + mi) * 6144;
                modulate_row(v[q], p.in[6] + 1024, mp, mp + 1024, XN + (size_t)r * DM, C.lane);
            } else {
                const float rstd = row_rstd(v[q], 1e-6f, C.lane);
#pragma unroll
                for (int j = 0; j < 4; ++j) __builtin_nontemporal_store(v[q][j] * rstd * ((const f32x4*)p.in[8])[C.lane + 64 * j], (f32x4*)(p.out + (size_t)r * DM) + C.lane + 64 * j);
            }
        }
    }
}

constexpr int RT = 128;
constexpr int TP = 136;
DI float ret_lg2(const float* e, int hh) { return log1pf(-exp2f(-e[hh])) * LOG2E; }

DI void ph_ret_chunk_states(const Ctx& C, const Params& p) {
    const bf16* P = (const bf16*)(p.ws + WS_P); float* SCH = (float*)(p.ws + WS_SCH);
    LAS bf16* Ktf = (LAS bf16*)C.lds; LAS bf16* Ktb = Ktf + 64 * TP; LAS bf16* Vt = Ktb + 64 * TP;
    const int r32 = C.lane & 31, hi = C.lane >> 5;
    for (int u = C.vcu; u < 2 * 4 * 66; u += C.G) {
        const int cc = u % 66, hh = (u / 66) & 3, b = u / 264;
        const size_t row0 = cc < 64 ? (size_t)b * SEQ + cc * RT : (size_t)NLAT + b * LC + (cc - 64) * RT;
        const float lgf = ret_lg2(p.in[17], hh), lgb = ret_lg2(p.in[18], hh);
        v4u kv2[2], vv4[4];
#pragma unroll
        for (int k = 0; k < 2; ++k) { const int q = C.tid + k * NTHR; const int pp = q & 127, d0 = (q >> 7) * 8; kv2[k] = *(const v4u*)(P + (row0 + pp) * 2304 + 256 + hh * 64 + d0); }
#pragma unroll
        for (int k = 0; k < 4; ++k) { const int q = C.tid + k * NTHR; const int pp = q & 127, v0 = (q >> 7) * 8; vv4[k] = *(const v4u*)(P + (row0 + pp) * 2304 + 512 + hh * 128 + v0); }
#pragma unroll
        for (int k = 0; k < 2; ++k) { const int q = C.tid + k * NTHR; const int pp = q & 127, d0 = (q >> 7) * 8; const v4u kv = kv2[k];
            const float wf = exp2f(lgf * (float)(127 - pp)), wb = exp2f(lgb * (float)pp);
#pragma unroll
            for (int i = 0; i < 4; ++i) { const float k0 = __uint_as_float(kv[i] << 16), k1 = __uint_as_float(kv[i] & 0xffff0000u);
                Ktf[(d0 + 2 * i) * TP + pp] = f2bf(k0 * wf); Ktf[(d0 + 2 * i + 1) * TP + pp] = f2bf(k1 * wf); Ktb[(d0 + 2 * i) * TP + pp] = f2bf(k0 * wb); Ktb[(d0 + 2 * i + 1) * TP + pp] = f2bf(k1 * wb); } }
#pragma unroll
        for (int k = 0; k < 4; ++k) { const int q = C.tid + k * NTHR; const int pp = q & 127, v0 = (q >> 7) * 8; const v4u vv = vv4[k];
#pragma unroll
            for (int i = 0; i < 4; ++i) { Vt[(v0 + 2 * i) * TP + pp] = (bf16)(vv[i] & 0xffffu); Vt[(v0 + 2 * i + 1) * TP + pp] = (bf16)(vv[i] >> 16); } }
        __syncthreads();
        const int db = C.wave & 1, vb = C.wave >> 1;
        f32x16 sf, sb;
#pragma unroll
        for (int i = 0; i < 16; ++i) { sf[i] = 0.f; sb[i] = 0.f; }
#pragma unroll
        for (int ks = 0; ks < 8; ++ks) {
            const bf16x8 af = *(const LAS bf16x8*)(Ktf + (32 * db + r32) * TP + 16 * ks + 8 * hi);
            const bf16x8 ab = *(const LAS bf16x8*)(Ktb + (32 * db + r32) * TP + 16 * ks + 8 * hi);
            const bf16x8 bv = *(const LAS bf16x8*)(Vt + (32 * vb + r32) * TP + 16 * ks + 8 * hi);
            sf = MFMA32(af, bv, sf); sb = MFMA32(ab, bv, sb);
        }
        float* of = SCH + ((((size_t)0 * 2 + b) * 4 + hh) * 66 + cc) * 8192; float* ob = SCH + ((((size_t)1 * 2 + b) * 4 + hh) * 66 + cc) * 8192;
#pragma unroll
        for (int i = 0; i < 16; ++i) { const int d = 32 * db + crow(i, hi); of[d * 128 + 32 * vb + r32] = sf[i]; ob[d * 128 + 32 * vb + r32] = sb[i]; }
        __syncthreads();
    }
}

DI void ph_ret_scan(const Ctx& C, const Params& p) {
    const float* SCH = (const float*)(p.ws + WS_SCH); float* RST = (float*)(p.ws + WS_RST);
    for (int i = C.vcu * NTHR + C.tid; i < 2 * 2 * 4 * 8192; i += C.G * NTHR) {
        const int el = i & 8191, hh = (i >> 13) & 3, b = (i >> 15) & 1, dir = i >> 16;
        const float g128 = exp2f(ret_lg2(dir == 0 ? p.in[17] : p.in[18], hh) * 128.0f);
        const float* S = SCH + (((size_t)dir * 2 + b) * 4 + hh) * 66 * 8192 + el;
        float* R = RST + (((size_t)dir * 2 + b) * 4 + hh) * 64 * 8192 + el;
        float st;
        if (dir == 0) { st = S[64 * 8192]; st = st * g128 + S[65 * 8192]; }
        else { st = S[65 * 8192]; st = st * g128 + S[64 * 8192]; }
        const long step = dir == 0 ? 8192 : -8192;
        const float* Sp = S + (dir == 0 ? 0 : (size_t)63 * 8192); float* Rp = R + (dir == 0 ? 0 : (size_t)63 * 8192);
#pragma unroll 1
        for (int c0 = 0; c0 < 64; c0 += 8) {
            float sv[8];
#pragma unroll
            for (int j = 0; j < 8; ++j) sv[j] = __builtin_nontemporal_load(Sp + j * step);
#pragma unroll
            for (int j = 0; j < 8; ++j) { Rp[j * step] = st; st = st * g128 + sv[j]; }
            Sp += 8 * step; Rp += 8 * step;
        }
    }
}

DI void ph_ret_output(const Ctx& C, const Params& p) {
    const bf16* P = (const bf16*)(p.ws + WS_P); const float* RST = (const float*)(p.ws + WS_RST); bf16* CAT = (bf16*)(p.ws + WS_CAT);
    constexpr int T2 = 256, KP = 72, VP = 260;
    LAS bf16* Ks = (LAS bf16*)C.lds;
    LAS bf16* Vt = Ks + T2 * KP;
    LAS bf16* Rtf = Vt + 128 * VP;
    LAS bf16* Rtb = Rtf + 128 * 72;
    const int r32 = C.lane & 31, hi = C.lane >> 5;
    const float* gn = p.in[19];
    for (int u = C.vcu; u < 2 * 4 * 32; u += C.G) {
        const int c2 = u & 31, hh = (u >> 5) & 3, b = u >> 7;
        const size_t row0 = (size_t)b * SEQ + c2 * T2;
        const float lgf = ret_lg2(p.in[17], hh), lgb = ret_lg2(p.in[18], hh);
        const float* Rf = RST + ((((size_t)0 * 2 + b) * 4 + hh) * 64 + 2 * c2) * 8192; const float* Rb = RST + ((((size_t)1 * 2 + b) * 4 + hh) * 64 + 2 * c2 + 1) * 8192;
        const int pl = 32 * C.wave + r32;
        const bf16* Pu = P + row0 * 2304 + hh * 64;
        unsigned tq = (unsigned)C.tid; asm volatile("" : "+v"(tq));
        unsigned gK = (tq >> 3) * 2304u + 256u + (tq & 7u) * 8u;            asm volatile("" : "+v"(gK));
        unsigned gV = (tq & 255u) * 2304u + 512u + (tq >> 8) * 8u;          asm volatile("" : "+v"(gV));
        unsigned gR = (tq & 63u) * 128u + (tq >> 6) * 4u;                   asm volatile("" : "+v"(gR));
        unsigned gQ = (unsigned)pl * 2304u + 8u * (unsigned)hi;             asm volatile("" : "+v"(gQ));
        unsigned lK = (tq >> 3) * (unsigned)KP + (tq & 7u) * 8u;            asm volatile("" : "+v"(lK));
        unsigned lV = (tq >> 8) * 8u * (unsigned)VP + (tq & 255u);          asm volatile("" : "+v"(lV));
        unsigned lR = (tq >> 6) * 4u * 72u + (tq & 63u);                    asm volatile("" : "+v"(lR));
        v4u kk4[4], vv8[8]; f32x4 ra[4], rb4[4]; bf16x8 qf[4];
#pragma unroll
        for (int k = 0; k < 4; ++k) kk4[k] = *(const v4u*)((Pu + (size_t)k * 64 * 2304) + gK);
        { const bf16* Pv = Pu + hh * 64;
#pragma unroll
          for (int k = 0; k < 8; ++k) vv8[k] = *(const v4u*)(Pv + gV + 16 * k); }
#pragma unroll
        for (int k = 0; k < 4; ++k) { ra[k] = *(const f32x4*)(Rf + gR + 32 * k); rb4[k] = *(const f32x4*)(Rb + gR + 32 * k); }
#pragma unroll
        for (int d0 = 0; d0 < 4; ++d0) qf[d0] = *(const bf16x8*)(Pu + gQ + 16 * d0);
#pragma unroll
        for (int k = 0; k < 4; ++k) *(LAS v4u*)(Ks + lK + 64 * k * KP) = kk4[k];
#pragma unroll
        for (int k = 0; k < 8; ++k) { const v4u vv = vv8[k];
#pragma unroll
            for (int i = 0; i < 4; ++i) { Vt[lV + (16 * k + 2 * i) * VP] = (bf16)(vv[i] & 0xffffu); Vt[lV + (16 * k + 2 * i + 1) * VP] = (bf16)(vv[i] >> 16); } }
#pragma unroll
        for (int k = 0; k < 4; ++k) {
#pragma unroll
            for (int i = 0; i < 4; ++i) { Rtf[lR + (32 * k + i) * 72] = f2bf(ra[k][i]); Rtb[lR + (32 * k + i) * 72] = f2bf(rb4[k][i]); } }
        __syncthreads();
        unsigned lKr = (unsigned)(r32 * KP + 8 * hi);  asm volatile("" : "+v"(lKr));
        unsigned lVr = (unsigned)(r32 * VP + 4 * hi);  asm volatile("" : "+v"(lVr));
        unsigned lRr = (unsigned)(r32 * 72 + 8 * hi);  asm volatile("" : "+v"(lRr));
        f32x16 o[4];
#pragma unroll
        for (int vb = 0; vb < 4; ++vb)
#pragma unroll
            for (int i = 0; i < 16; ++i) o[vb][i] = 0.f;
#pragma unroll 1
        for (int sb = 0; sb < 8; ++sb) {
            bf16x8 kf[4];
#pragma unroll
            for (int d0 = 0; d0 < 4; ++d0) kf[d0] = *(const LAS bf16x8*)(Ks + lKr + 32 * sb * KP + 16 * d0);
            f32x16 st;
#pragma unroll
            for (int i = 0; i < 16; ++i) st[i] = 0.f;
#pragma unroll
            for (int d0 = 0; d0 < 4; ++d0) st = MFMA32(kf[d0], qf[d0], st);
#pragma unroll
            for (int i = 0; i < 16; ++i) { const int sx = 32 * sb + crow(i, hi); const int df = pl - sx; const float w = df >= 0 ? exp2f(lgf * (float)df) : exp2f(lgb * (float)(-df)); st[i] *= w; }
#pragma unroll
            for (int ks = 0; ks < 2; ++ks) {
                v4u pw; pw.x = cvtpk(st[8 * ks + 0], st[8 * ks + 1]); pw.y = cvtpk(st[8 * ks + 2], st[8 * ks + 3]); pw.z = cvtpk(st[8 * ks + 4], st[8 * ks + 5]); pw.w = cvtpk(st[8 * ks + 6], st[8 * ks + 7]);
                const bf16x8 pa = __builtin_bit_cast(bf16x8, pw);
                const int s0 = 32 * sb + 16 * ks;
#pragma unroll
                for (int vb = 0; vb < 4; ++vb) { const LAS bf16* vp = Vt + lVr + s0 + 32 * vb * VP; const v2u lo = *(const LAS v2u*)vp, hh2 = *(const LAS v2u*)(vp + 8);
                    v4u vw; vw.x = lo.x; vw.y = lo.y; vw.z = hh2.x; vw.w = hh2.y; o[vb] = MFMA32(pa, __builtin_bit_cast(bf16x8, vw), o[vb]); }
            }
        }
        {
            const float xf = exp2f(lgf * (float)(pl + 1)), xb = exp2f(lgb * (float)(T2 - pl));
#pragma unroll
            for (int d0 = 0; d0 < 4; ++d0) {
                const v4u qw = __builtin_bit_cast(v4u, qf[d0]); v4u af, ab;
#pragma unroll
                for (int i = 0; i < 4; ++i) { const float q0 = __uint_as_float(qw[i] << 16), q1 = __uint_as_float(qw[i] & 0xffff0000u); af[i] = cvtpk(q0 * xf, q1 * xf); ab[i] = cvtpk(q0 * xb, q1 * xb); }
                const bf16x8 aF = __builtin_bit_cast(bf16x8, af), aB = __builtin_bit_cast(bf16x8, ab);
#pragma unroll
                for (int vb = 0; vb < 4; ++vb) { const bf16x8 rf = *(const LAS bf16x8*)(Rtf + lRr + 32 * vb * 72 + 16 * d0); const bf16x8 rb = *(const LAS bf16x8*)(Rtb + lRr + 32 * vb * 72 + 16 * d0);
                    o[vb] = MFMA32(aF, rf, o[vb]); o[vb] = MFMA32(aB, rb, o[vb]); }
            }
        }
        {
            float gnv[4];
#pragma unroll
            for (int vb = 0; vb < 4; ++vb) gnv[vb] = gn[hh * 128 + 32 * vb + r32];
            unsigned gpk[32];
            { const bf16* gu = P + row0 * 2304 + 1024 + hh * 128; unsigned gl = (unsigned)((32 * C.wave + 4 * hi) * 2304 + r32); asm volatile("" : "+v"(gl));
#pragma unroll
              for (int i = 0; i < 16; ++i) { const bf16* gp = (gu + ((i & 3) + 8 * (i >> 2)) * 2304) + gl; gpk[2 * i] = (unsigned)gp[0] | ((unsigned)gp[32] << 16); gpk[2 * i + 1] = (unsigned)gp[64] | ((unsigned)gp[96] << 16); } }
            float mu[16], var[16];
            unsigned ol = (unsigned)((32 * C.wave + 4 * hi) * 1024 + r32); asm volatile("" : "+v"(ol));
#pragma unroll
            for (int i = 0; i < 16; ++i) mu[i] = (o[0][i] + o[1][i]) + (o[2][i] + o[3][i]);
#pragma unroll
            for (int ofs = 1; ofs < 32; ofs <<= 1) {
#pragma unroll
                for (int i = 0; i < 16; ++i) mu[i] += shx(mu[i], ofs, C.lane); }
#pragma unroll
            for (int i = 0; i < 16; ++i) { mu[i] *= (1.0f / 128.0f); float a = 0.f;
#pragma unroll
                for (int vb = 0; vb < 4; ++vb) { o[vb][i] -= mu[i]; a += o[vb][i] * o[vb][i]; }
                var[i] = a; }
#pragma unroll
            for (int ofs = 1; ofs < 32; ofs <<= 1) {
#pragma unroll
                for (int i = 0; i < 16; ++i) var[i] += shx(var[i], ofs, C.lane); }
#pragma unroll
            for (int i = 0; i < 16; ++i) { const float rs = rsqrtf(var[i] * (1.0f / 128.0f) + 1e-5f);
                bf16* op = (CAT + row0 * 1024 + hh * 128 + ((i & 3) + 8 * (i >> 2)) * 1024) + ol;
#pragma unroll
                for (int vb = 0; vb < 4; ++vb) { const unsigned gw2 = gpk[2 * i + (vb >> 1)]; const float g = (vb & 1) ? __uint_as_float(gw2 & 0xffff0000u) : __uint_as_float(gw2 << 16);
                    op[32 * vb] = f2bf(o[vb][i] * rs * gnv[vb] * (g / (1.f + __expf(-g)))); } }
        }
        __syncthreads();
    }
}

typedef __attribute__((address_space(1))) unsigned gu32;
#define XB_TMO      128
#define XB_XCNT(j)  (256  + 64 * (j))
#define XB_XSUB(j)  (1280 + 64 * (j))
#define XB_XGEN(j)  (2304 + 64 * (j))
#define XB_TOP      3328
#define XB_TOPGEN   3392
#define XCD_BAR_WORDS 3456
#define XB_SPIN_CAP (1u << 18)

__device__ __forceinline__ unsigned xb_ld(unsigned* p)              { return __hip_atomic_load(p, __ATOMIC_RELAXED, __HIP_MEMORY_SCOPE_AGENT); }
__device__ __forceinline__ unsigned xb_add(unsigned* p, unsigned v) { return __hip_atomic_fetch_add(p, v, __ATOMIC_RELAXED, __HIP_MEMORY_SCOPE_AGENT); }
__device__ __forceinline__ unsigned xb_xcc_id() { return (unsigned)__builtin_amdgcn_s_getreg((3 << 11) | 20) & 0xFu; }
#define XB_SPIN(cond, bar) do { unsigned _sp = 0; while (cond) { __builtin_amdgcn_s_sleep(1); \
    if ((++_sp & 255u) == 0u) { if (xb_ld(&(bar)[XB_TMO])) break; if (_sp > XB_SPIN_CAP) { atomicAdd(&(bar)[XB_TMO], 1u); break; } } } } while (0)

struct XcdBarrier {
    unsigned* bar; unsigned x;
    volatile LAS unsigned* st;
};

__device__ __forceinline__ XcdBarrier xcd_barrier_post(unsigned* bar, volatile LAS unsigned* st) {
    XcdBarrier b; b.bar = bar; b.x = xb_xcc_id(); b.st = st;
    if (threadIdx.x == 0) (void)xb_add(&bar[XB_XCNT(b.x)], 1u);
    return b;
}
__device__ __forceinline__ void xcd_barrier_complete(unsigned* bar, unsigned x, unsigned& nloc, unsigned& nx) {
    const unsigned G = gridDim.x * gridDim.y * gridDim.z;
    unsigned sum, cnt, mine, sp = 0u;
    for (;;) {
        sum = 0u; cnt = 0u; mine = 0u;
#pragma unroll
        for (unsigned j = 0; j < 16; ++j) { const unsigned c = xb_ld(&bar[XB_XCNT(j)]); sum += c; cnt += (c > 0u) ? 1u : 0u; mine = (j == x) ? c : mine; }
        if (sum == G) break;
        __builtin_amdgcn_s_sleep(1);
        if ((++sp & 255u) == 0u) { if (xb_ld(&bar[XB_TMO])) break; if (sp > XB_SPIN_CAP) { atomicAdd(&bar[XB_TMO], 1u); break; } }
    }
    nloc = mine > 0u ? mine : 1u; nx = cnt > 0u ? cnt : 1u;
}

__device__ __forceinline__ void xcd_barrier(const XcdBarrier& b) {
    asm volatile("s_waitcnt vmcnt(0)" ::: "memory");
    __syncthreads();
    if (threadIdx.x == 0) {
        unsigned* bar = b.bar;
        __builtin_amdgcn_s_waitcnt(0);
        unsigned nloc = b.st[0], nx = b.st[1];
        if (nloc == 0u) { xcd_barrier_complete(bar, b.x, nloc, nx); b.st[0] = nloc; b.st[1] = nx; }
        const unsigned old = xb_add(&bar[XB_XSUB(b.x)], 1u);
        const unsigned gen = old / nloc;
        if (old + 1u == (gen + 1u) * nloc) {
            __builtin_amdgcn_fence(__ATOMIC_RELEASE, "agent");
            asm volatile("s_waitcnt vmcnt(0)" ::: "memory");
            const unsigned og = xb_add(&bar[XB_TOP], 1u);
            const unsigned target = (og / nx + 1u) * nx;
            if (og + 1u != target) XB_SPIN(xb_ld(&bar[XB_TOP]) < target, bar);
            __builtin_amdgcn_fence(__ATOMIC_ACQUIRE, "agent");
            xb_add(&bar[XB_XGEN(b.x)], 1u);
            asm volatile("s_waitcnt vmcnt(0)" ::: "memory");
        } else {
            XB_SPIN(xb_ld(&bar[XB_XGEN(b.x)]) == gen, bar);
            __builtin_amdgcn_fence(__ATOMIC_ACQUIRE, "agent");
            asm volatile("s_waitcnt vmcnt(0)" ::: "memory");
        }
    }
    __syncthreads();
}

__global__ void __launch_bounds__(NTHR, 2) fwd_megakernel(Params p_unused) {
    extern __shared__ __attribute__((aligned(16))) unsigned char lds_raw[];
    {
        volatile LAS unsigned* st = (volatile LAS unsigned*)((LAS unsigned char*)lds_raw + LDS_MISC);
        if (threadIdx.x < 8) st[threadIdx.x] = 0u;
        __syncthreads();
        KP kp0 = (KP)__builtin_amdgcn_kernarg_segment_ptr();
        (void)xcd_barrier_post((unsigned*)(kp0->ws + WS_CTL), st);
    }
#define GRID_SYNC() do { KP kpb = (KP)__builtin_amdgcn_kernarg_segment_ptr(); asm volatile("" : "+s"(kpb) :: "memory"); XcdBarrier bb; bb.bar = (unsigned*)(kpb->ws + WS_CTL); bb.x = xb_xcc_id(); \
        bb.st = (volatile LAS unsigned*)((LAS unsigned char*)lds_raw + LDS_MISC); xcd_barrier(bb); } while (0)
#define ENV() Params p; Ctx C; env(p, C, lds_raw); unsigned char* ws = p.ws; LAS unsigned char* ring = C.lds; (void)ws; (void)ring

    { ENV(); ph0_prologue(C, p); }
    GRID_SYNC();
    { ENV(); ph_modulate0(C, p); }
    GRID_SYNC();
    {
        ENV();
        pg8::Gemm g{(const pg8::bf16_t*)(ws + WS_XN), (const pg8::bf16_t*)(ws + WS_WABIN), NROW, 1280, 1024}; pg8::StaticOrder S; S.init(NROW, 1280, C.G, (int)blockIdx.x);
        pg8::EpiStoreBf16 E{(pg8::bf16_t*)(ws + WS_P), 1280, 0, nullptr};
        pg8::gemm_phase<pg8::EpiStoreBf16, pg8::StaticOrder, true, true>(ring, g, S, E);
    }
    { ENV(); convert_slot(C, p, 0, (int)blockIdx.x); }
    GRID_SYNC();
    { ENV(); ph_post0(C, p); }
    GRID_SYNC();
    { ENV(); ph_attn_dense(C, p, lds_raw); }
    GRID_SYNC();
    {
        ENV();
        pg8::Gemm g{(const pg8::bf16_t*)(ws + WS_CAT), (const pg8::bf16_t*)(ws + WS_WABOUT), NROW, 1024, 1024}; pg8::StaticOrder S; S.init(NROW, 1024, C.G, (int)blockIdx.x);
        pg8::EpiResid<false> E{p.in[0], p.in[2], (const float*)(ws + WS_MOD), 2, (pg8::bf16_t*)(ws + WS_X1)};
        pg8::gemm_phase<pg8::EpiResid<false>, pg8::StaticOrder, true, true>(ring, g, S, E);
    }
    { ENV(); convert_slot(C, p, 1, (int)blockIdx.x); }
    GRID_SYNC();
    { ENV(); ph_ffn_norm_router(C, p, 0, NROW); }
    GRID_SYNC();
    { ENV(); ph_select(C, p, 4, 2304); }
    { ENV(); convert_slot(C, p, 2, C.vcu); }
    GRID_SYNC();
    {
        ENV();
        pg8::Gemm g{(const pg8::bf16_t*)(ws + WS_XN), (const pg8::bf16_t*)(ws + WS_WGU), NEXP * 2304, NEXP * 4096, 512}; pg8::MoeOrder S; S.init(9, 16, NEXP, C.G, C.vcu);
        LAS unsigned* gtab = (LAS unsigned*)(C.lds + 131072);
        { const int* IDX = (const int*)(ws + WS_IDX); pg8::Unit u; for (int i = 0; S.next(i, u); ++i) if (C.tid < 256) gtab[i * 256 + C.tid] = (unsigned)IDX[u.pm * 256 + C.tid] * 1024u; }
        __syncthreads();
        pg8::EpiSwiGLU8 E{(unsigned char*)(ws + WS_ACT), WINV};
        pg8::gemm_phase<pg8::EpiSwiGLU8, pg8::MoeOrder, true, true, true, true>(ring, g, S, E, gtab);
    }
    GRID_SYNC();
    {
        ENV();
        pg8::Gemm g{(const pg8::bf16_t*)(ws + WS_ACT), (const pg8::bf16_t*)(ws + WS_WD), NEXP * 2304, NEXP * 1024, 1024}; pg8::MoeOrder S; S.init(9, 4, NEXP, C.G, C.vcu);
        pg8::EpiDown E{(pg8::bf16_t*)(ws + WS_XS), (const float*)(ws + WS_GATEV), WINV};
        pg8::gemm_phase<pg8::EpiDown, pg8::MoeOrder, true, true, true>(ring, g, S, E);
    }
    { ENV(); convert_slot(C, p, 3, C.vcu); }
    GRID_SYNC();
    { ENV(); ph_combine(C, p, 0, NROW, 2304); }
    GRID_SYNC();
    {
        ENV();
        pg8::Gemm g{(const pg8::bf16_t*)(ws + WS_XN), (const pg8::bf16_t*)(ws + WS_WCDIN), NROW, 2304, 1024}; pg8::StaticOrder S; S.init(NROW, 2304, C.G, (int)blockIdx.x);
        pg8::EpiStoreBf16 E{(pg8::bf16_t*)(ws + WS_P), 2304, 0, nullptr};
        pg8::gemm_phase<pg8::EpiStoreBf16, pg8::StaticOrder, true, true>(ring, g, S, E);
    }
    { ENV(); convert_slot(C, p, 4, (int)blockIdx.x); }
    GRID_SYNC();
    { ENV(); ph_post1(C, p); }
    GRID_SYNC();
    { ENV(); ph_ret_chunk_states(C, p); }
    GRID_SYNC();
    { ENV(); ph_ret_scan(C, p); }
    GRID_SYNC();
    { ENV(); ph_ret_output(C, p); }
    { ENV(); ph_attn_window(C, p, lds_raw); }
    GRID_SYNC();
    {
        ENV();
        pg8::Gemm g{(const pg8::bf16_t*)(ws + WS_CAT), (const pg8::bf16_t*)(ws + WS_WCDOUT), NLAT, 1024, 1024}; pg8::StaticOrder S; S.init(NLAT, 1024, C.G, (int)blockIdx.x);
        pg8::EpiResid<true> E{(const void*)(ws + WS_X2), (const void*)((const pg8::bf16_t*)(ws + WS_X2) + (size_t)NLAT * DM), (const float*)(ws + WS_MOD) + 3 * 6144, 2, (pg8::bf16_t*)(ws + WS_X1)};
        pg8::gemm_phase<pg8::EpiResid<true>, pg8::StaticOrder, true, true>(ring, g, S, E);
    }
    GRID_SYNC();
    { ENV(); ph_ffn_norm_router(C, p, 1, NLAT); }
    GRID_SYNC();
    { ENV(); ph_select(C, p, 2, 2048); }
    { ENV(); convert_slot(C, p, 5, C.vcu); }
    GRID_SYNC();
    {
        ENV();
        pg8::Gemm g{(const pg8::bf16_t*)(ws + WS_XN), (const pg8::bf16_t*)(ws + WS_WGU + (size_t)NEXP * 4096 * 1024), NEXP * 2048, NEXP * 4096, 512}; pg8::MoeOrder S; S.init(8, 16, NEXP, C.G, C.vcu);
        LAS unsigned* gtab = (LAS unsigned*)(C.lds + 131072);
        { const int* IDX = (const int*)(ws + WS_IDX); pg8::Unit u; for (int i = 0; S.next(i, u); ++i) if (C.tid < 256) gtab[i * 256 + C.tid] = (unsigned)IDX[u.pm * 256 + C.tid] * 1024u; }
        __syncthreads();
        pg8::EpiSwiGLU8 E{(unsigned char*)(ws + WS_ACT), WINV};
        pg8::gemm_phase<pg8::EpiSwiGLU8, pg8::MoeOrder, true, true, true, true>(ring, g, S, E, gtab);
    }
    GRID_SYNC();
    {
        ENV();
        pg8::Gemm g{(const pg8::bf16_t*)(ws + WS_ACT), (const pg8::bf16_t*)(ws + WS_WD + (size_t)NEXP * 1024 * 2048), NEXP * 2048, NEXP * 1024, 1024}; pg8::MoeOrder S; S.init(8, 4, NEXP, C.G, C.vcu);
        pg8::EpiDown E{(pg8::bf16_t*)(ws + WS_XS), (const float*)(ws + WS_GATEV), WINV};
        pg8::gemm_phase<pg8::EpiDown, pg8::MoeOrder, true, true, true>(ring, g, S, E);
    }
    GRID_SYNC();
    { ENV(); ph_combine(C, p, 1, NLAT, 2048); }
}

extern "C" void kernel_launch(void* const* d_in, const int* in_sizes, int n_in, void* d_out, int out_size, void* d_ws, size_t ws_size, hipStream_t stream) {
    static int grid = 0;
    if (grid == 0) {
        if (n_in != 25 || ws_size < WS_END) { fprintf(stderr, "kernel_launch: unexpected inputs (n_in %d, ws %zu)\n", n_in, ws_size); grid = -1; return; }
        int dev = 0, cus = 0, per_cu = 0;
        if (hipGetDevice(&dev) != hipSuccess || hipDeviceGetAttribute(&cus, hipDeviceAttributeMultiprocessorCount, dev) != hipSuccess) { grid = -1; return; }
        if (hipFuncSetAttribute((const void*)fwd_megakernel, hipFuncAttributeMaxDynamicSharedMemorySize, LDS_BYTES) != hipSuccess) { fprintf(stderr, "kernel_launch: hipFuncSetAttribute failed\n"); grid = -1; return; }
        if (hipOccupancyMaxActiveBlocksPerMultiprocessor(&per_cu, (const void*)fwd_megakernel, NTHR, LDS_BYTES) != hipSuccess || per_cu < 1) { fprintf(stderr, "kernel_launch: occupancy query says %d\n", per_cu); (void)hipGetLastError(); grid = -1; return; }
        grid = cus;
    }
    if (grid < 0) return;
    if (hipMemsetAsync((char*)d_ws + WS_CTL, 0, CTL_BYTES, stream) != hipSuccess) { fprintf(stderr, "kernel_launch: hipMemsetAsync failed\n"); return; }
    Params prm{};
    for (int i = 0; i < 25; ++i) prm.in[i] = (const float*)d_in[i];
    prm.out = (float*)d_out; prm.ws = (unsigned char*)d_ws; prm.pad = 0ull;
    void* args[] = {&prm};
    hipError_t e = hipLaunchCooperativeKernel((const void*)fwd_megakernel, dim3(grid), dim3(NTHR), args, LDS_BYTES, stream);
    if (e != hipSuccess) fprintf(stderr, "kernel_launch: cooperative launch failed: %s (grid %d)\n", hipGetErrorString(e), grid);
}
```

```cpp
#include <hip/hip_runtime.h>
#include <hip/hip_bf16.h>
#include <cmath>
#include <cstdio>
#include <cstdint>
namespace pg8 {
#define PG8_LAS __attribute__((address_space(3)))
typedef unsigned short bf16_t;
typedef short bf16x8 __attribute__((ext_vector_type(8)));
typedef float f32x4 __attribute__((ext_vector_type(4)));
typedef unsigned u32x4 __attribute__((ext_vector_type(4)));
constexpr int BM = 256, BK = 64, HALF = 128, HTB = HALF * BK * 2  , STAGE_BYTES = 8 * HTB, NXCD = 8, WGM = 8;

__host__ __device__ __forceinline__ int lds_byte(int r, int c) { const int st = (r >> 4) * 2 + (c >> 5), rr = r & 15, cc = c & 31, ob = rr * 64 + cc * 2; return st * 1024 + (ob ^ (((ob >> 9) & 1) << 5)); }
__host__ __device__ __forceinline__ void stage_rc(int b, int& R, int& C) { const int st = b / 1024, sb = b % 1024, swz = sb ^ (((sb >> 9) & 1) << 5); R = (st >> 1) * 16 + swz / 64; C = (st & 1) * 32 + (swz % 64) / 2; }
__host__ __device__ __forceinline__ int perm32(int rho) { const int n = rho >> 4, i = rho & 15; return 8 * (i >> 2) + 4 * n + (i & 3); }

struct Unit { int pm, pn; };
struct Gemm { const bf16_t* A; const bf16_t* Bt; int M, N, K; };

struct StaticOrder {
    int nM, nN, nwg, G, c;
    __host__ __device__ void init(int M, int N, int G_, int c_) { nM = M / BM; nN = N / BM; nwg = nM * nN; G = G_; c = c_; }
    __host__ __device__ bool next(int i, Unit& u) const {
        const long L = (long)i * G + c; if (L >= nwg) return false;
        int wgid = (int)L; { const int q = nwg / NXCD, r = nwg % NXCD, xcd = wgid % NXCD, off = wgid / NXCD; wgid = (xcd < r ? xcd * (q + 1) : r * (q + 1) + (xcd - r) * q) + off; }
        const int nig = WGM * nN, gid = wgid / nig, fm = gid * WGM, gsz = (nM - fm) < WGM ? (nM - fm) : WGM;
        u.pm = fm + ((wgid % nig) % gsz); u.pn = (wgid % nig) / gsz; return true;
    }
    __device__ __forceinline__ void a_ready(const Unit&) const {}
    __device__ __forceinline__ void done(const Unit&) const {}
    __device__ __forceinline__ bool half(const Unit&) const { return false; }
};

__device__ __forceinline__ unsigned cvt_pk_bf16(float lo, float hi) { unsigned r; asm volatile("v_cvt_pk_bf16_f32 %0, %1, %2" : "=v"(r) : "v"(lo), "v"(hi)); return r; }
typedef float f32x2e __attribute__((ext_vector_type(2)));
typedef __bf16 bf16x2e __attribute__((ext_vector_type(2)));
__device__ __forceinline__ unsigned cvtpk_e(float lo, float hi) { f32x2e v = {lo, hi}; bf16x2e b = __builtin_convertvector(v, bf16x2e); return __builtin_bit_cast(unsigned, b); }
__device__ __forceinline__ u32x4 pack8(const f32x4 a, const f32x4 b) { u32x4 w; w.x = cvtpk_e(a[0], a[1]); w.y = cvtpk_e(a[2], a[3]); w.z = cvtpk_e(b[0], b[1]); w.w = cvtpk_e(b[2], b[3]); return w; }

struct EpiStoreBf16 {
    static constexpr bool PERM = true, AFTER_DRAIN = false;
    bf16_t* O; int ldc; int ocol0; const float* colscale;
    __device__ __forceinline__ void operator()(const f32x4 (&acc)[2][2][4][2], const Unit& u, int wr, int wc, int fr, int fq) const {
        const int row0 = u.pm * BM + wr * 64 + fr, col0 = u.pn * BM + wc * 32 + 8 * fq;
        f32x4 cs[2][2];
#pragma unroll
        for (int bj = 0; bj < 2; ++bj)
#pragma unroll
            for (int n = 0; n < 2; ++n) cs[bj][n] = colscale ? *(const f32x4*)(colscale + col0 + bj * HALF + 4 * n) : (f32x4){1.f, 1.f, 1.f, 1.f};
#pragma unroll
        for (int ai = 0; ai < 2; ++ai)
#pragma unroll
            for (int m = 0; m < 4; ++m) { bf16_t* rowp = O + (size_t)(row0 + ai * HALF + m * 16) * ldc + ocol0 + col0;
#pragma unroll
                for (int bj = 0; bj < 2; ++bj) *(u32x4*)(rowp + bj * HALF) = pack8(acc[ai][bj][m][0] * cs[bj][0], acc[ai][bj][m][1] * cs[bj][1]); }
    }
};

template <bool SRC_BF16> struct EpiResid {
    static constexpr bool PERM = true, AFTER_DRAIN = false;
    const void* xlat; const void* xctx; const float* modl; int chunk; bf16_t* out;
    __device__ __forceinline__ void load_group(const float* srcf, const bf16_t* srch, size_t off, f32x4 (&xv)[2][2]) const {
#pragma unroll
        for (int bj = 0; bj < 2; ++bj) {
            if (SRC_BF16) { const u32x4 w = __builtin_nontemporal_load((const u32x4*)(srch + off + bj * HALF));
                xv[bj][0] = (f32x4){__uint_as_float(w.x << 16), __uint_as_float(w.x & 0xffff0000u), __uint_as_float(w.y << 16), __uint_as_float(w.y & 0xffff0000u)};
                xv[bj][1] = (f32x4){__uint_as_float(w.z << 16), __uint_as_float(w.z & 0xffff0000u), __uint_as_float(w.w << 16), __uint_as_float(w.w & 0xffff0000u)}; }
            else { xv[bj][0] = __builtin_nontemporal_load((const f32x4*)(srcf + off + bj * HALF)); xv[bj][1] = __builtin_nontemporal_load((const f32x4*)(srcf + off + bj * HALF + 4)); } }
    }
    __device__ __forceinline__ void operator()(const f32x4 (&acc)[2][2][4][2], const Unit& u, int wr, int wc, int fr, int fq) const {
        const int pm = u.pm; const int mi = pm < 64 ? (pm >> 5) : 2;
        const float* g = modl + mi * 6144 + chunk * 1024;
        const size_t rowoff = pm < 64 ? (size_t)pm * 256 * 1024 : (size_t)(pm - 64) * 256 * 1024;
        const float* srcf = (const float*)(pm < 64 ? xlat : xctx) + (SRC_BF16 ? 0 : rowoff);
        const bf16_t* srch = (const bf16_t*)(pm < 64 ? xlat : xctx) + (SRC_BF16 ? rowoff : 0);
        bf16_t* dst = out + (size_t)pm * 256 * 1024;
        const int rl = wr * 64 + fr, col0 = u.pn * BM + wc * 32 + 8 * fq;
        f32x4 gv[2][2];
#pragma unroll
        for (int bj = 0; bj < 2; ++bj)
#pragma unroll
            for (int n = 0; n < 2; ++n) gv[bj][n] = *(const f32x4*)(g + col0 + bj * HALF + 4 * n);
        f32x4 xa[2][2], xb[2][2];
        load_group(srcf, srch, (size_t)rl * 1024 + col0, xa);
#define EPIRESID_STEP(q, XC, XN) do { const int ai = (q) >> 2, m = (q) & 3; const size_t off = (size_t)(rl + ai * HALF + m * 16) * 1024 + col0; \
            if ((q) < 7) { const int ai2 = ((q) + 1) >> 2, m2 = ((q) + 1) & 3; load_group(srcf, srch, (size_t)(rl + ai2 * HALF + m2 * 16) * 1024 + col0, XN); } \
            _Pragma("unroll") for (int bj = 0; bj < 2; ++bj) { const f32x4 o0 = XC[bj][0] + gv[bj][0] * acc[ai][bj][m][0], o1 = XC[bj][1] + gv[bj][1] * acc[ai][bj][m][1]; \
                *(u32x4*)(dst + off + bj * HALF) = pack8(o0, o1); } } while (0)
        EPIRESID_STEP(0, xa, xb); EPIRESID_STEP(1, xb, xa); EPIRESID_STEP(2, xa, xb); EPIRESID_STEP(3, xb, xa);
        EPIRESID_STEP(4, xa, xb); EPIRESID_STEP(5, xb, xa); EPIRESID_STEP(6, xa, xb); EPIRESID_STEP(7, xb, xa);
#undef EPIRESID_STEP
    }
};

struct EpiSwiGLU {
    static constexpr bool PERM = true, AFTER_DRAIN = false;
    bf16_t* ACT;
    __device__ __forceinline__ void operator()(const f32x4 (&acc)[2][2][4][2], const Unit& u, int wr, int wc, int fr, int fq) const {
        const int row0 = u.pm * BM + wr * 64 + fr, col0 = (u.pn & 15) * 128 + wc * 32 + 8 * fq;
#pragma unroll
        for (int ai = 0; ai < 2; ++ai)
#pragma unroll
            for (int m = 0; m < 4; ++m) { bf16_t* rowp = ACT + (size_t)(row0 + ai * HALF + m * 16) * 2048 + col0;
                f32x4 r[2];
#pragma unroll
                for (int n = 0; n < 2; ++n)
#pragma unroll
                    for (int j = 0; j < 4; ++j) { const float a = acc[ai][0][m][n][j], up = acc[ai][1][m][n][j];
                        const float sg = a * __builtin_amdgcn_rcpf(1.0f + __builtin_amdgcn_exp2f(-1.4426950408889634f * a)); r[n][j] = sg * up; }
                *(u32x4*)rowp = pack8(r[0], r[1]); }
    }
};


__device__ __forceinline__ unsigned pk4_fp8(float a, float b, float c, float d) { unsigned w = 0u; w = __builtin_amdgcn_cvt_pk_fp8_f32(a, b, w, false); w = __builtin_amdgcn_cvt_pk_fp8_f32(c, d, w, true); return w; }
struct EpiSwiGLU8 {
    static constexpr bool PERM = true, AFTER_DRAIN = false;
    unsigned char* ACT; float winv;
    __device__ __forceinline__ void operator()(const f32x4 (&acc)[2][2][4][2], const Unit& u, int wr, int wc, int fr, int fq) const {
        const int row0 = u.pm * BM + wr * 64 + fr, col0 = (u.pn & 15) * 128 + wc * 32 + 8 * fq;
#pragma unroll
        for (int ai = 0; ai < 2; ++ai)
#pragma unroll
            for (int m = 0; m < 4; ++m) { unsigned char* rowp = ACT + (size_t)(row0 + ai * HALF + m * 16) * 2048 + col0;
                float r[8];
#pragma unroll
                for (int n = 0; n < 2; ++n)
#pragma unroll
                    for (int j = 0; j < 4; ++j) { const float a = acc[ai][0][m][n][j] * winv, up = acc[ai][1][m][n][j] * winv;
                        const float sg = a * __builtin_amdgcn_rcpf(1.0f + __builtin_amdgcn_exp2f(-1.4426950408889634f * a)); float v = sg * up; v = fminf(fmaxf(v, -448.f), 448.f); r[4 * n + j] = v; }
                typedef unsigned u32x2 __attribute__((ext_vector_type(2)));
                u32x2 w; w.x = pk4_fp8(r[0], r[1], r[2], r[3]); w.y = pk4_fp8(r[4], r[5], r[6], r[7]);
                *(u32x2*)rowp = w; }
    }
};

struct EpiDown {
    static constexpr bool PERM = true, AFTER_DRAIN = false;
    bf16_t* Y; const float* gatev; float winv;
    __device__ __forceinline__ void operator()(const f32x4 (&acc)[2][2][4][2], const Unit& u, int wr, int wc, int fr, int fq) const {
        const int row0 = u.pm * BM + wr * 64 + fr, col0 = (u.pn & 3) * 256 + wc * 32 + 8 * fq;
#pragma unroll
        for (int ai = 0; ai < 2; ++ai)
#pragma unroll
            for (int m = 0; m < 4; ++m) { const int row = row0 + ai * HALF + m * 16; const float gv = gatev[row] * winv; bf16_t* rowp = Y + (size_t)row * 1024 + col0;
#pragma unroll
                for (int bj = 0; bj < 2; ++bj) *(u32x4*)(rowp + bj * HALF) = pack8(acc[ai][bj][m][0] * gv, acc[ai][bj][m][1] * gv); }
    }
};

struct MoeOrder {
    int nMe, nNe, nwg, G, c;
    __device__ __forceinline__ void init(int nMe_, int nNe_, int nExp, int G_, int c_) { nMe = nMe_; nNe = nNe_; nwg = nMe_ * nNe_ * nExp; G = G_; c = c_; }
    __device__ __forceinline__ bool next(int i, Unit& u) const {
        const int L = i * G + c; if (L >= nwg) return false;
        const int per = nMe * nNe, e = L / per, r = L % per;
        u.pm = e * nMe + (r % nMe); u.pn = e * nNe + (r / nMe); return true;
    }
    __device__ __forceinline__ void a_ready(const Unit&) const {}
    __device__ __forceinline__ void done(const Unit&) const {}
    __device__ __forceinline__ bool half(const Unit& u) const { return nMe == 9 && (u.pm % 9) == 8; }
};
template <class Epi, class Sched, bool ALIGN_EPI = false, bool SP2 = false, bool FP8 = false, bool GATHER = false>
__device__ __forceinline__ void gemm_phase(PG8_LAS unsigned char* lds, const Gemm g, const Sched& S, const Epi& E, const PG8_LAS unsigned* gtab = nullptr) {
    static_assert(!GATHER || SP2, "GATHER is wired into the SP2 loop only");
    int tid_o = threadIdx.x; asm volatile("" : "+v"(tid_o) :: "memory");
    const int tid = tid_o, wid = __builtin_amdgcn_readfirstlane(tid >> 6), lane = tid & 63, wr = wid >> 2, wc = wid & 3, fr = lane & 15, fq = lane >> 4;
    const int K = g.K, nt = K / BK;
    unsigned voffA[2], voffB[2]; int rA[2]; unsigned cofA[2];
    unsigned vofC[2][2] = {{0u, 0u}, {0u, 0u}}, vofN[2][2] = {{0u, 0u}, {0u, 0u}};
#pragma unroll
    for (int i = 0; i < 2; ++i) { int R, C; stage_rc(tid * 16 + i * 8192, R, C); const int Rb = Epi::PERM ? ((R & ~31) + perm32(R & 31)) : R;
        voffA[i] = (unsigned)(R * K + C) * 2u; voffB[i] = (unsigned)(Rb * K + C) * 2u; rA[i] = R; cofA[i] = (unsigned)C * 2u; }
    const size_t kstep = (size_t)(BK * 2);
    const size_t hstep = (size_t)HALF * K * 2;
    const size_t tstep = 2 * hstep;
    const unsigned ldsw = (unsigned)wid * 1024u;
    const int aoff = lds_byte(wr * 64 + fr, fq * 8), boff = lds_byte(wc * 32 + fr, fq * 8);
#define PG8_SA(b, h) (((b) * 2 + (h)) * HTB)
#define PG8_SB(b, h) ((4 + (b) * 2 + (h)) * HTB)
#define PG8_STAGE(bufoff, gbase, voff) do { _Pragma("unroll") for (int _i = 0; _i < 2; ++_i) \
        __builtin_amdgcn_global_load_lds((const unsigned*)((const char*)(gbase) + (voff)[_i]), (PG8_LAS unsigned*)(lds + (bufoff) + ldsw + _i * 8192), 16, 0, 0); } while (0)
#define PG8_STAGE_A(bufoff, gbase, h, usenext) do { if constexpr (GATHER) { const unsigned vg_[2] = {(usenext) ? vofN[h][0] : vofC[h][0], (usenext) ? vofN[h][1] : vofC[h][1]}; PG8_STAGE(bufoff, gbase, vg_); } \
        else { PG8_STAGE(bufoff, (gbase) + (h) * hstep, voffA); } } while (0)
#define PG8_GTAB(dst, u_) do { _Pragma("unroll") for (int h_ = 0; h_ < 2; ++h_) _Pragma("unroll") for (int i_ = 0; i_ < 2; ++i_) dst[h_][i_] = gtab[(u_) * 256 + h_ * 128 + rA[i_]] + cofA[i_]; } while (0)
#define PG8_LDA(dst, b, h) do { if constexpr (FP8) { _Pragma("unroll") for (int m = 0; m < 4; ++m) { const v4i_ lo_ = *(const PG8_LAS v4i_*)(lds + PG8_SA(b, h) + aoff + m * 2048), hi_ = *(const PG8_LAS v4i_*)(lds + PG8_SA(b, h) + aoff + m * 2048 + 1024); dst##8[m] = __builtin_shufflevector(lo_, hi_, 0, 1, 2, 3, 4, 5, 6, 7); } } \
        else { _Pragma("unroll") for (int m = 0; m < 4; ++m) _Pragma("unroll") for (int k = 0; k < 2; ++k) dst[m][k] = *(const PG8_LAS bf16x8*)(lds + PG8_SA(b, h) + aoff + m * 2048 + k * 1024); } } while (0)
#define PG8_LDB(dst, b, h) do { if constexpr (FP8) { _Pragma("unroll") for (int n = 0; n < 2; ++n) { const v4i_ lo_ = *(const PG8_LAS v4i_*)(lds + PG8_SB(b, h) + boff + n * 2048), hi_ = *(const PG8_LAS v4i_*)(lds + PG8_SB(b, h) + boff + n * 2048 + 1024); dst##8[n] = __builtin_shufflevector(lo_, hi_, 0, 1, 2, 3, 4, 5, 6, 7); } } \
        else { _Pragma("unroll") for (int n = 0; n < 2; ++n) _Pragma("unroll") for (int k = 0; k < 2; ++k) dst[n][k] = *(const PG8_LAS bf16x8*)(lds + PG8_SB(b, h) + boff + n * 2048 + k * 1024); } } while (0)
#define PG8_MMA(ai, bj, At, Bt) do { __builtin_amdgcn_s_setprio(1); _Pragma("unroll") for (int m = 0; m < 4; ++m) _Pragma("unroll") for (int n = 0; n < 2; ++n) { \
        if constexpr (FP8) { asm volatile("v_mfma_f32_16x16x128_f8f6f4 %0, %1, %2, %0" : "+v"(acc[ai][bj][m][n]) : "v"(Bt##8[n]), "v"(At##8[m])); } \
        else { _Pragma("unroll") for (int k = 0; k < 2; ++k) acc[ai][bj][m][n] = __builtin_amdgcn_mfma_f32_16x16x32_bf16(Bt[n][k], At[m][k], acc[ai][bj][m][n], 0, 0, 0); } } \
        __builtin_amdgcn_s_setprio(0); } while (0)
#define PG8_WAIT_V(n) asm volatile("s_waitcnt vmcnt(" #n ")" ::: "memory")
#define PG8_WAIT_L(n) asm volatile("s_waitcnt lgkmcnt(" #n ")" ::: "memory")
#define PG8_BAR __builtin_amdgcn_s_barrier()
#define PG8_SCHED __builtin_amdgcn_sched_barrier(0)
    Unit cur, nxt; int ui = 0;
    if (!S.next(0, cur)) return;
    f32x4 acc[2][2][4][2];
#pragma unroll
    for (int a = 0; a < 2; ++a)
#pragma unroll
        for (int b = 0; b < 2; ++b)
#pragma unroll
            for (int m = 0; m < 4; ++m)
#pragma unroll
                for (int n = 0; n < 2; ++n) acc[a][b][m][n] = (f32x4){0.f, 0.f, 0.f, 0.f};
    typedef int v4i_ __attribute__((ext_vector_type(4))); typedef int v8i_ __attribute__((ext_vector_type(8)));
    bf16x8 At[4][2], B0[2][2], B1[2][2];
    v8i_ At8[4], B08[2], B18[2];
    const char* cA = (const char*)g.A + (GATHER ? (size_t)0 : (size_t)cur.pm * tstep); const char* cB = (const char*)g.Bt + (size_t)cur.pn * tstep;
    if constexpr (GATHER) PG8_GTAB(vofC, 0);
    S.a_ready(cur);
    if constexpr (SP2) {
        PG8_STAGE(PG8_SB(0, 0), cB, voffB); PG8_STAGE(PG8_SB(0, 1), cB + hstep, voffB); PG8_STAGE_A(PG8_SA(0, 0), cA, 0, false); PG8_STAGE_A(PG8_SA(0, 1), cA, 1, false);
        if (wr == 1) PG8_BAR;
        PG8_WAIT_V(2); PG8_BAR;
        PG8_STAGE(PG8_SB(1, 0), cB + kstep, voffB); PG8_STAGE_A(PG8_SA(1, 0), cA + kstep, 0, false); PG8_STAGE(PG8_SB(1, 1), cB + hstep + kstep, voffB);
        PG8_WAIT_V(6); PG8_BAR;
    } else {
        PG8_STAGE(PG8_SB(0, 0), cB, voffB); PG8_STAGE(PG8_SA(0, 0), cA, voffA); PG8_STAGE(PG8_SB(0, 1), cB + hstep, voffB); PG8_STAGE(PG8_SA(0, 1), cA + hstep, voffA);
        if (wr == 1) PG8_BAR;
        PG8_WAIT_V(4); PG8_BAR;
        PG8_STAGE(PG8_SB(1, 0), cB + kstep, voffB); PG8_STAGE(PG8_SA(1, 0), cA + kstep, voffA); PG8_STAGE(PG8_SB(1, 1), cB + hstep + kstep, voffB);
        PG8_WAIT_V(6); PG8_BAR;
    }
    bool halfu = S.half(cur);
    for (;;) {
        const bool has_next = S.next(ui + 1, nxt);
        if constexpr (GATHER) { if (has_next) PG8_GTAB(vofN, ui + 1); else { vofN[0][0] = vofC[0][0]; vofN[0][1] = vofC[0][1]; vofN[1][0] = vofC[1][0]; vofN[1][1] = vofC[1][1]; } }
        const char* nA = (has_next && !GATHER) ? (const char*)g.A + (size_t)nxt.pm * tstep : cA; const char* nB = has_next ? (const char*)g.Bt + (size_t)nxt.pn * tstep : cB;
        for (int t = 0; t < nt; t += 2) {
            const bool last = (t == nt - 2);
            const char* a1 = cA + (size_t)(t + 1) * kstep;
            const char* a2 = last ? nA : cA + (size_t)(t + 2) * kstep; const char* b2 = last ? nB : cB + (size_t)(t + 2) * kstep;
            const char* a3 = a2 + kstep; const char* b3 = b2 + kstep;
            if (last && has_next) S.a_ready(nxt);
            if constexpr (SP2) {
            PG8_LDB(B0, 0, 0); PG8_LDB(B1, 0, 1); PG8_SCHED; PG8_LDA(At, 0, 0); PG8_STAGE_A(PG8_SA(1, 1), a1, 1, false);
            PG8_WAIT_V(8); PG8_WAIT_L(0); PG8_BAR; if (!(halfu && wr == 1)) { PG8_MMA(0, 0, At, B0); PG8_MMA(0, 1, At, B1); } PG8_BAR; PG8_SCHED;
            PG8_LDA(At, 0, 1); PG8_STAGE(PG8_SB(0, 0), b2, voffB); PG8_STAGE(PG8_SB(0, 1), b2 + hstep, voffB); PG8_STAGE_A(PG8_SA(0, 0), a2, 0, last);
            PG8_WAIT_V(8); PG8_WAIT_L(0); PG8_BAR; if (!halfu) { PG8_MMA(1, 0, At, B0); PG8_MMA(1, 1, At, B1); } PG8_BAR; PG8_SCHED;
            PG8_LDB(B0, 1, 0); PG8_LDB(B1, 1, 1); PG8_SCHED; PG8_LDA(At, 1, 0); PG8_STAGE_A(PG8_SA(0, 1), a2, 1, last);
            PG8_WAIT_V(8); PG8_WAIT_L(0); PG8_BAR; if (!(halfu && wr == 1)) { PG8_MMA(0, 0, At, B0); PG8_MMA(0, 1, At, B1); } PG8_BAR; PG8_SCHED;
            PG8_LDA(At, 1, 1); PG8_STAGE(PG8_SB(1, 0), b3, voffB); PG8_STAGE(PG8_SB(1, 1), b3 + hstep, voffB); PG8_STAGE_A(PG8_SA(1, 0), a3, 0, last);
            PG8_WAIT_V(8); PG8_WAIT_L(0); PG8_BAR; if (!halfu) { PG8_MMA(1, 0, At, B0); PG8_MMA(1, 1, At, B1); } PG8_BAR; PG8_SCHED;
            } else {
            PG8_LDB(B0, 0, 0); PG8_SCHED; PG8_LDA(At, 0, 0); PG8_STAGE(PG8_SA(1, 1), a1 + hstep, voffA);
            PG8_WAIT_L(8); PG8_BAR; PG8_WAIT_L(0); PG8_MMA(0, 0, At, B0); PG8_BAR; PG8_SCHED;
            PG8_LDB(B1, 0, 1); PG8_STAGE(PG8_SB(0, 0), b2, voffB);
            PG8_BAR; PG8_WAIT_L(0); PG8_MMA(0, 1, At, B1); PG8_BAR;
            PG8_LDA(At, 0, 1); PG8_STAGE(PG8_SA(0, 0), a2, voffA);
            PG8_BAR; PG8_WAIT_L(0); PG8_MMA(1, 0, At, B0); PG8_BAR; PG8_SCHED;
            PG8_STAGE(PG8_SB(0, 1), b2 + hstep, voffB);
            PG8_WAIT_V(6); PG8_BAR; PG8_MMA(1, 1, At, B1); PG8_BAR;
            PG8_LDB(B0, 1, 0); PG8_SCHED; PG8_LDA(At, 1, 0); PG8_STAGE(PG8_SA(0, 1), a2 + hstep, voffA);
            PG8_WAIT_L(8); PG8_BAR; PG8_WAIT_L(0); PG8_MMA(0, 0, At, B0); PG8_BAR; PG8_SCHED;
            PG8_LDB(B1, 1, 1); PG8_STAGE(PG8_SB(1, 0), b3, voffB);
            PG8_BAR; PG8_WAIT_L(0); PG8_MMA(0, 1, At, B1); PG8_BAR;
            PG8_LDA(At, 1, 1); PG8_STAGE(PG8_SA(1, 0), a3, voffA);
            PG8_BAR; PG8_WAIT_L(0); PG8_MMA(1, 0, At, B0); PG8_BAR; PG8_SCHED;
            PG8_STAGE(PG8_SB(1, 1), b3 + hstep, voffB);
            PG8_WAIT_V(6); PG8_BAR; PG8_MMA(1, 1, At, B1); PG8_BAR;
            }
        }
        if constexpr (FP8) {
            asm volatile("s_nop 15\n\ts_nop 15" ::: "memory");
#pragma unroll
            for (int a = 0; a < 2; ++a)
#pragma unroll
                for (int b = 0; b < 2; ++b)
#pragma unroll
                    for (int m = 0; m < 4; ++m)
#pragma unroll
                        for (int n = 0; n < 2; ++n) asm volatile("" : "+v"(acc[a][b][m][n]));
        }
        if constexpr (ALIGN_EPI) { if (wr == 0) PG8_BAR; }
        if constexpr (!Epi::AFTER_DRAIN) { E(acc, cur, wr, wc, fr, fq); S.done(cur); }
        if (!has_next) break;
#pragma unroll
        for (int a = 0; a < 2; ++a)
#pragma unroll
            for (int b = 0; b < 2; ++b)
#pragma unroll
                for (int m = 0; m < 4; ++m)
#pragma unroll
                    for (int n = 0; n < 2; ++n) acc[a][b][m][n] = (f32x4){0.f, 0.f, 0.f, 0.f};
        cur = nxt; cA = nA; cB = nB; ++ui; halfu = S.half(cur);
        if constexpr (GATHER) { vofC[0][0] = vofN[0][0]; vofC[0][1] = vofN[0][1]; vofC[1][0] = vofN[1][0]; vofC[1][1] = vofN[1][1]; }
        if constexpr (ALIGN_EPI) { if (wr == 1) PG8_BAR; }
    }
    PG8_WAIT_V(0);
    if constexpr (!ALIGN_EPI) { if (wr == 0) PG8_BAR; }
    PG8_BAR;
    if constexpr (Epi::AFTER_DRAIN) { E.fused(acc, cur, wr, wc, fr, fq, lds, wid, lane); S.done(cur); }
#undef PG8_SA
#undef PG8_SB
#undef PG8_STAGE
#undef PG8_STAGE_A
#undef PG8_GTAB
#undef PG8_LDA
#undef PG8_LDB
#undef PG8_MMA
#undef PG8_WAIT_V
#undef PG8_WAIT_L
#undef PG8_BAR
#undef PG8_SCHED
}
}
namespace attn_body {
using bf16=__hip_bfloat16;
using bf16x8=__attribute__((ext_vector_type(8)))short;
using s16x4=__attribute__((ext_vector_type(4)))short;
using f32x16=__attribute__((ext_vector_type(16)))float;
using u32x4=__attribute__((ext_vector_type(4)))unsigned;
constexpr int D=64;
constexpr int NW=8,QBLK=32,QB=QBLK*NW,KVBLK=64;
constexpr int ATTN_UNIT_ROWS=QB;
__device__ __forceinline__ int crow(int r,int hi){return (r&3)+8*(r>>2)+4*hi;}
#define SBAR() __builtin_amdgcn_sched_barrier(0)
__device__ __forceinline__ void cmask(f32x16&p0,f32x16&p1,int jb,int qrel,int hi){
  const float NEG=-INFINITY; int kb=64*jb+4*hi;
  #pragma unroll
  for(int r=0;r<16;++r){int kv=kb+(r&3)+8*(r>>2); if(kv>qrel)p0[r]=NEG; if(kv+32>qrel)p1[r]=NEG;}
}

constexpr int NSLOT=3, SLOTB=8192;
constexpr int LDS_K=0, LDS_V=NSLOT*SLOTB, LDS_WS=2*NSLOT*SLOTB, LDS_OST=LDS_WS+NW*64*4, LDS_BYTES=LDS_OST+NW*4096;
constexpr float C2=0.125f*1.4426950408889634f;
__device__ __forceinline__ void glds16(const void*gsrc,unsigned lds_dst){unsigned keep;
  asm volatile("s_mov_b32 %0, m0\n\ts_mov_b32 m0, %2\n\ts_nop 0\n\tglobal_load_lds_dwordx4 %1, off\n\ts_mov_b32 m0, %0":"=&s"(keep):"v"(gsrc),"s"(lds_dst):"memory");}
__device__ __forceinline__ float max3f(float a,float b,float c){float r;asm("v_max3_f32 %0, %1, %2, %3":"=v"(r):"v"(a),"v"(b),"v"(c));return r;}
__device__ __forceinline__ float max2f(float a,float b){float r;asm("v_max_f32_e32 %0, %1, %2":"=v"(r):"v"(a),"v"(b));return r;}
__device__ __forceinline__ float fadd_s(float a,float b){float r;asm("v_add_f32_e32 %0, %1, %2":"=v"(r):"v"(a),"v"(b));return r;}
__device__ __forceinline__ float fsub_s(float a,float b){float r;asm("v_sub_f32_e32 %0, %1, %2":"=v"(r):"v"(a),"v"(b));return r;}
typedef float f32x2_t __attribute__((ext_vector_type(2))); typedef __bf16 bf16x2_t __attribute__((ext_vector_type(2)));
__device__ __forceinline__ unsigned cvtpk_s(float lo,float hi){f32x2_t v={lo,hi};bf16x2_t b=__builtin_convertvector(v,bf16x2_t);return __builtin_bit_cast(unsigned,b);}
#define WAIT_BAR(N) asm volatile("s_waitcnt vmcnt(" #N ") lgkmcnt(0)\n\ts_barrier":::"memory")

__device__ __forceinline__ void qkt(f32x16&p0,f32x16&p1,const char*Kslot,const bf16x8*qr,const f32x16&negm,int r32,int hi){
  const char*kb=Kslot+hi*1024+r32*16;
  #pragma unroll
  for(int d0=0;d0<4;++d0){
    const bf16x8 b0=*reinterpret_cast<const bf16x8*>(kb+d0*2048);
    const bf16x8 b1=*reinterpret_cast<const bf16x8*>(kb+d0*2048+512);
    if(d0==0){p0=__builtin_amdgcn_mfma_f32_32x32x16_bf16(b0,qr[0],negm,0,0,0);p1=__builtin_amdgcn_mfma_f32_32x32x16_bf16(b1,qr[0],negm,0,0,0);}
    else{p0=__builtin_amdgcn_mfma_f32_32x32x16_bf16(b0,qr[d0],p0,0,0,0);p1=__builtin_amdgcn_mfma_f32_32x32x16_bf16(b1,qr[d0],p1,0,0,0);}}
}
typedef __attribute__((address_space(3))) const char* lds_cptr;
typedef short v4i16_t __attribute__((ext_vector_type(4)));
__device__ __forceinline__ void kload8(bf16x8*kf,lds_cptr kp){
  kf[0]=*(const __attribute__((address_space(3))) bf16x8*)(kp);      kf[1]=*(const __attribute__((address_space(3))) bf16x8*)(kp+512);
  kf[2]=*(const __attribute__((address_space(3))) bf16x8*)(kp+2048); kf[3]=*(const __attribute__((address_space(3))) bf16x8*)(kp+2560);
  kf[4]=*(const __attribute__((address_space(3))) bf16x8*)(kp+4096); kf[5]=*(const __attribute__((address_space(3))) bf16x8*)(kp+4608);
  kf[6]=*(const __attribute__((address_space(3))) bf16x8*)(kp+6144); kf[7]=*(const __attribute__((address_space(3))) bf16x8*)(kp+6656);
}
__device__ __forceinline__ void kload2(bf16x8*kf,lds_cptr kp,int j){ kf[2*j]=*(const __attribute__((address_space(3))) bf16x8*)(kp+j*2048); kf[2*j+1]=*(const __attribute__((address_space(3))) bf16x8*)(kp+j*2048+512); }
__device__ __forceinline__ s16x4 vtr(lds_cptr p){ return __builtin_bit_cast(s16x4,__builtin_amdgcn_ds_read_tr16_b64_v4i16((__attribute__((address_space(3))) v4i16_t*)p)); }
__device__ __forceinline__ float rowmax(const f32x16&p0,const f32x16&p1){
  float a=max3f(p0[0],p0[1],p1[0]),b=max3f(p0[2],p0[3],p1[1]);a=max3f(a,p1[2],p1[3]);
  #pragma unroll
  for(int r=4;r<16;r+=4){a=max3f(a,p0[r],p0[r+1]);b=max3f(b,p0[r+2],p0[r+3]);a=max3f(a,p1[r],p1[r+1]);b=max3f(b,p1[r+2],p1[r+3]);}
  const float m=max2f(a,b);
  auto rr=__builtin_amdgcn_permlane32_swap(__float_as_uint(m),__float_as_uint(m),false,false);
  return max2f(__uint_as_float(rr[0]),__uint_as_float(rr[1]));
}
__device__ __forceinline__ void pv(f32x16*o,int vb,bf16x8 pa0,bf16x8 pa1,bf16x8 pa2,bf16x8 pa3){
  #pragma unroll
  for(int d0=0;d0<2;++d0){s16x4 lo[4],hi[4];
    #pragma unroll
    for(int ks=0;ks<4;++ks){
      asm volatile("ds_read_b64_tr_b16 %0,%1 offset:%c2":"=&v"(lo[ks]):"v"(vb),"i"(d0*4096+ks*1024):"memory");
      asm volatile("ds_read_b64_tr_b16 %0,%1 offset:%c2":"=&v"(hi[ks]):"v"(vb),"i"(d0*4096+ks*1024+512):"memory");}
    asm volatile("s_waitcnt lgkmcnt(0)":::"memory");SBAR();
    #define PK(k) (bf16x8){lo[k][0],lo[k][1],lo[k][2],lo[k][3],hi[k][0],hi[k][1],hi[k][2],hi[k][3]}
    o[d0]=__builtin_amdgcn_mfma_f32_32x32x16_bf16(pa0,PK(0),o[d0],0,0,0);
    o[d0]=__builtin_amdgcn_mfma_f32_32x32x16_bf16(pa1,PK(1),o[d0],0,0,0);
    o[d0]=__builtin_amdgcn_mfma_f32_32x32x16_bf16(pa2,PK(2),o[d0],0,0,0);
    o[d0]=__builtin_amdgcn_mfma_f32_32x32x16_bf16(pa3,PK(3),o[d0],0,0,0);
    #undef PK
  }
}

#ifndef ATTN_STORE16
#define ATTN_STORE16(p,v) (*(u32x4*)(p)=(v))
#endif
template<int THRL,bool WIN> __device__ __forceinline__ void attn_unit(const bf16*Qu,int QP,const bf16*__restrict__ Kh,const bf16*__restrict__ Vh,int KP,int NT,bf16*Ou,int OP,char*shm,int gap,int qpos0,float sinkl2){
  const int tid=threadIdx.x,lane=tid&63,r32=lane&31,hi=lane>>5; const int wid=__builtin_amdgcn_readfirstlane(tid>>6);
  const bf16*Qw=Qu+(long)(wid*QBLK)*QP;
  const unsigned lds0=(unsigned)(uintptr_t)shm;
  float*wsf=(float*)(shm+LDS_WS)+wid*64;
  const bf16*ksrc=Kh+(long)lane*KP+wid*8;
  const bf16*vsrc=Vh+(long)(16*(wid&3)+(lane>>2))*KP+(wid>>2)*32+(lane&3)*8;
  const unsigned kdst=lds0+LDS_K+wid*1024, vdst=lds0+LDS_V+wid*1024;
  #define KROW(t) ((long)(t)*KVBLK+((WIN&&(t)>=4)?(long)gap:0L))
  #define DMA_K(t,slot) glds16(ksrc+KROW(t)*KP,(unsigned)__builtin_amdgcn_readfirstlane(kdst+(slot)))
  #define DMA_V(t,slot) glds16(vsrc+KROW(t)*KP,(unsigned)__builtin_amdgcn_readfirstlane(vdst+(slot)))
  const int vb0=(int)(lds0+LDS_V)+((lane>>4)&1)*32+(lane&3)*8+(4*hi+((lane&15)>>2))*64;
  const char*Kbase=shm+LDS_K; bf16x8 kf[8];
  const lds_cptr shm3=(lds_cptr)shm; const lds_cptr kp0=shm3+LDS_K+hi*1024+r32*16; const lds_cptr vp0=shm3+LDS_V+((lane>>4)&1)*32+(lane&3)*8+(4*hi+((lane&15)>>2))*64;
  DMA_K(0,0);DMA_V(0,0);DMA_K(1,SLOTB);
  bf16x8 qr[4];
  #pragma unroll
  for(int d0=0;d0<4;++d0)qr[d0]=*reinterpret_cast<const bf16x8*>(&Qw[(long)r32*QP+d0*16+hi*8]);
  if(__builtin_amdgcn_readfirstlane(threadIdx.x)>=256)__builtin_amdgcn_s_setprio(1);
  float mhat=0.f,l_reg=0.f;f32x16 o[2];o[0]=f32x16{};o[1]=f32x16{};f32x16 negm=f32x16{};asm volatile("":"+v"(negm));
  const int qrel=wid*QBLK+r32;
  #define CMASK(P0,P1,t) do{ if(WIN&&(t)>=4){ const int kb_=gap+64*((t)-4)+4*hi-(qpos0+qrel); _Pragma("unroll") for(int r_=0;r_<16;++r_){ const int df_=kb_+(r_&3)+8*(r_>>2); if(df_>128||df_<-128)P0[r_]=-INFINITY; if(df_+32>128||df_+32<-128)P1[r_]=-INFINITY; } } }while(0)
  bool resc=false;
  #define START(P0,P1) do{ const float rm=rowmax(P0,P1); resc=false; \
    { const float dl=rm; mhat=fadd_s(mhat,dl); \
      _Pragma("unroll") for(int r=0;r<16;++r){P0[r]=fsub_s(P0[r],dl);P1[r]=fsub_s(P1[r],dl);} \
      _Pragma("unroll") for(int r=0;r<16;++r)negm[r]=-mhat; asm volatile("":"+v"(negm)); } \
    _Pragma("unroll") for(int r=0;r<16;++r)P0[r]=__builtin_amdgcn_exp2f(P0[r]); }while(0)
  #define RESC() do{ if(resc){ asm volatile("s_waitcnt lgkmcnt(0)":::"memory"); \
      _Pragma("unroll") for(int d_=0;d_<2;++d_) _Pragma("unroll") for(int r=0;r<16;++r)o[d_][r]*=wsf[crow(r,hi)]; } }while(0)
  f32x16 pA0,pA1,pB0,pB1;
  int sl_prev=0,sl_cur=0,sl_next=SLOTB;
  #define ROT() do{sl_prev=sl_cur;sl_cur=sl_next;sl_next=(sl_next==(NSLOT-1)*SLOTB)?0:sl_next+SLOTB;}while(0)
  DMA_K(2,2*SLOTB);
  WAIT_BAR(3);
  qkt(pA0,pA1,Kbase,qr,negm,r32,hi);asm volatile("s_nop 15\n\ts_nop 7":"+v"(pA0),"+v"(pA1));CMASK(pA0,pA1,0);
  START(pA0,pA1);
  _Pragma("unroll") for(int r=0;r<16;++r)pA1[r]=__builtin_amdgcn_exp2f(pA1[r]);
  WAIT_BAR(0);
  DMA_K(3,0);DMA_V(1,SLOTB);
  ROT();
  kload8(kf,kp0+sl_cur);
  WAIT_BAR(2);
  s16x4 vlo[8],vhi[8]; u32x4 pw0,pw1,pw2,pw3;
  #define PKW(P,B) cvtpk_s(P[B],P[B+1])
  #define PAF(k) __builtin_bit_cast(bf16x8,pw##k)
  #define VFR(i) (bf16x8){vlo[i][0],vlo[i][1],vlo[i][2],vlo[i][3],vhi[i][0],vhi[i][1],vhi[i][2],vhi[i][3]}
  #define PIN(x) asm volatile("":"+v"(x))
  #define MX3(a,b,c) __builtin_fmaxf(__builtin_fmaxf((a),(b)),(c))
  #define GAPA(MF,A0,A1,A2,A3,W0,W1,PW) do{ MF; sacc+=A0; sacc+=A1; sacc+=A2; sacc+=A3; PIN(sacc); W0; W1; PIN(PW); SBAR(); }while(0)
  #define EX(v) __builtin_amdgcn_exp2f(v)
  #define GAPB(MF,X,B) do{ MF; X[B]=EX(X[B]); X[B+1]=EX(X[B+1]); X[B+2]=EX(X[B+2]); X[B+3]=EX(X[B+3]); PIN(X); SBAR(); }while(0)
  #define VRD(i) do{ vlo[i]=vtr(vp_+(((i)>>2)*4096+((i)&3)*1024)); vhi[i]=vtr(vp_+(((i)>>2)*4096+((i)&3)*1024+512)); }while(0)
  #define KRD(G,j) do{ if(G){ kload2(kf,kp0+sl_next,j); SBAR(); } }while(0)
  #define STEP(C0,C1,P0,P1,t,GK,GV,GL) do{ SBAR(); \
    const lds_cptr vp_=vp0+sl_prev; \
    VRD(0); SBAR(); float sacc=(P0[0]+P0[1]); \
    GAPA(C0=__builtin_amdgcn_mfma_f32_32x32x16_bf16(kf[0],qr[0],negm,0,0,0), P0[2],P0[3],P0[4],P0[5],     pw0[0]=PKW(P0,0), pw0[1]=PKW(P0,2), pw0); \
    VRD(4); SBAR(); GAPA(C1=__builtin_amdgcn_mfma_f32_32x32x16_bf16(kf[1],qr[0],negm,0,0,0), P0[6],P0[7],P0[8],P0[9],     pw0[2]=PKW(P0,4), pw0[3]=PKW(P0,6), pw0); \
    VRD(1); SBAR(); GAPA(C0=__builtin_amdgcn_mfma_f32_32x32x16_bf16(kf[2],qr[1],C0,0,0,0),   P0[10],P0[11],P0[12],P0[13], pw1[0]=PKW(P0,8), pw1[1]=PKW(P0,10), pw1); \
    VRD(5); SBAR(); GAPA(C1=__builtin_amdgcn_mfma_f32_32x32x16_bf16(kf[3],qr[1],C1,0,0,0),   P0[14],P0[15],P1[0],P1[1],   pw1[2]=PKW(P0,12),pw1[3]=PKW(P0,14), pw1); \
    VRD(2); SBAR(); GAPA(C0=__builtin_amdgcn_mfma_f32_32x32x16_bf16(kf[4],qr[2],C0,0,0,0),   P1[2],P1[3],P1[4],P1[5],     pw2[0]=PKW(P1,0), pw2[1]=PKW(P1,2), pw2); \
    VRD(6); SBAR(); GAPA(C1=__builtin_amdgcn_mfma_f32_32x32x16_bf16(kf[5],qr[2],C1,0,0,0),   P1[6],P1[7],P1[8],P1[9],     pw2[2]=PKW(P1,4), pw2[3]=PKW(P1,6), pw2); \
    VRD(3); SBAR(); GAPA(C0=__builtin_amdgcn_mfma_f32_32x32x16_bf16(kf[6],qr[3],C0,0,0,0),   P1[10],P1[11],P1[12],P1[13], pw3[0]=PKW(P1,8), pw3[1]=PKW(P1,10), pw3); \
    VRD(7); SBAR(); GAPA(C1=__builtin_amdgcn_mfma_f32_32x32x16_bf16(kf[7],qr[3],C1,0,0,0),   P1[14],P1[15],0.f,0.f,       pw3[2]=PKW(P1,12),pw3[3]=PKW(P1,14), pw3); \
    l_reg+=sacc; \
    if(GK){DMA_K((t)+3,sl_cur);} if(GV){DMA_V((t)+1,sl_next);} \
    CMASK(C0,C1,t); \
    { float a=MX3(C0[0],C0[1],C1[0]),b=MX3(C0[2],C0[3],C1[1]); a=MX3(a,C1[2],C1[3]); \
      _Pragma("unroll") for(int r=4;r<16;r+=4){a=MX3(a,C0[r],C0[r+1]);b=MX3(b,C0[r+2],C0[r+3]);a=MX3(a,C1[r],C1[r+1]);b=MX3(b,C1[r+2],C1[r+3]);} \
      float rm=__builtin_fmaxf(a,b); { auto rr=__builtin_amdgcn_permlane32_swap(__float_as_uint(rm),__float_as_uint(rm),false,false); rm=__builtin_fmaxf(__uint_as_float(rr[0]),__uint_as_float(rr[1])); } \
      resc=false; \
      if(__builtin_expect(__any(rm>(float)THRL),0)){ const float dl=__builtin_fmaxf(rm,0.f); mhat+=dl; \
        _Pragma("unroll") for(int r=0;r<16;++r){C0[r]-=dl;C1[r]-=dl;} \
        _Pragma("unroll") for(int r=0;r<16;++r)negm[r]=-mhat; asm volatile("":"+v"(negm)); \
        const float f=__builtin_amdgcn_exp2f(-dl); l_reg*=f; if(hi==0)wsf[r32]=f; resc=true; } } \
    SBAR(); \
    GAPB(o[0]=__builtin_amdgcn_mfma_f32_32x32x16_bf16(PAF(0),VFR(0),o[0],0,0,0), C0,0); \
    GAPB(o[1]=__builtin_amdgcn_mfma_f32_32x32x16_bf16(PAF(0),VFR(4),o[1],0,0,0), C0,4); \
    KRD(GL,0); GAPB(o[0]=__builtin_amdgcn_mfma_f32_32x32x16_bf16(PAF(1),VFR(1),o[0],0,0,0), C0,8); \
    KRD(GL,1); GAPB(o[1]=__builtin_amdgcn_mfma_f32_32x32x16_bf16(PAF(1),VFR(5),o[1],0,0,0), C0,12); \
    KRD(GL,2); GAPB(o[0]=__builtin_amdgcn_mfma_f32_32x32x16_bf16(PAF(2),VFR(2),o[0],0,0,0), C1,0); \
    KRD(GL,3); GAPB(o[1]=__builtin_amdgcn_mfma_f32_32x32x16_bf16(PAF(2),VFR(6),o[1],0,0,0), C1,4); \
    GAPB(o[0]=__builtin_amdgcn_mfma_f32_32x32x16_bf16(PAF(3),VFR(3),o[0],0,0,0), C1,8); \
    GAPB(o[1]=__builtin_amdgcn_mfma_f32_32x32x16_bf16(PAF(3),VFR(7),o[1],0,0,0), C1,12); \
    }while(0)
  int t=1;
  #undef CMASK
  #define CMASK(P0,P1,t) do{ if(WIN&&(t)>=4){ const int kb_=gap+64*((t)-4)+4*hi-(qpos0+qrel); _Pragma("unroll") for(int r_=0;r_<16;++r_){ const int df_=kb_+(r_&3)+8*(r_>>2); if(df_>128||df_<-128)P0[r_]=-INFINITY; if(df_+32>128||df_+32<-128)P1[r_]=-INFINITY; } } }while(0)
  for(;t+5<NT;t+=2){
    STEP(pB0,pB1,pA0,pA1,t,true,true,true);     WAIT_BAR(2); RESC(); ROT();
    STEP(pA0,pA1,pB0,pB1,t+1,true,true,true);   WAIT_BAR(2); RESC(); ROT();
  }
  #undef CMASK
  #define CMASK(P0,P1,t) do{ if(WIN&&(t)>=4){ const int kb_=gap+64*((t)-4)+4*hi-(qpos0+qrel); _Pragma("unroll") for(int r_=0;r_<16;++r_){ const int df_=kb_+(r_&3)+8*(r_>>2); if(df_>128||df_<-128)P0[r_]=-INFINITY; if(df_+32>128||df_+32<-128)P1[r_]=-INFINITY; } } }while(0)
  #define ENDW(tt) do{ if((tt)+3<NT){WAIT_BAR(2);} else if((tt)+2<NT){WAIT_BAR(1);} else {WAIT_BAR(0);} }while(0)
  for(;t+1<NT;t+=2){
    STEP(pB0,pB1,pA0,pA1,t,(t+3<NT),(t+1<NT),(t+1<NT));       ENDW(t);   RESC(); ROT();
    STEP(pA0,pA1,pB0,pB1,t+1,(t+4<NT),(t+2<NT),(t+2<NT));     ENDW(t+1); RESC(); ROT();
  }
  STEP(pB0,pB1,pA0,pA1,NT-1,false,false,false); RESC();
  { float sacc=pB0[0]+pB0[1]; _Pragma("unroll") for(int r=2;r<16;++r)sacc+=pB0[r]; _Pragma("unroll") for(int r=0;r<16;++r)sacc+=pB1[r]; l_reg+=sacc;
    pw0=(u32x4){PKW(pB0,0),PKW(pB0,2),PKW(pB0,4),PKW(pB0,6)};pw1=(u32x4){PKW(pB0,8),PKW(pB0,10),PKW(pB0,12),PKW(pB0,14)};pw2=(u32x4){PKW(pB1,0),PKW(pB1,2),PKW(pB1,4),PKW(pB1,6)};pw3=(u32x4){PKW(pB1,8),PKW(pB1,10),PKW(pB1,12),PKW(pB1,14)};
    SBAR(); pv(o,vb0+sl_cur,PAF(0),PAF(1),PAF(2),PAF(3)); }
  #undef PKW
  #undef PAF
  #undef VFR
  #undef PIN
  #undef MX3
  #undef GAPA
  #undef GAPB
  #undef EX
  #undef VRD
  #undef KRD
  #undef STEP
  #undef ENDW
  {auto rr=__builtin_amdgcn_permlane32_swap(__float_as_uint(l_reg),__float_as_uint(l_reg),false,false);l_reg=__uint_as_float(rr[0])+__uint_as_float(rr[1]);}
  if(WIN)l_reg+=__builtin_amdgcn_exp2f(sinkl2-mhat);
  if(hi==0)wsf[32+r32]=l_reg;asm volatile("s_waitcnt lgkmcnt(0)":::"memory");
  float rli[16];
  #pragma unroll
  for(int r=0;r<16;++r)rli[r]=__builtin_amdgcn_rcpf(wsf[32+crow(r,hi)]);
  bf16*Ow=Ou+(long)(wid*QBLK)*OP;
  { bf16*stg=(bf16*)(shm+LDS_OST)+wid*2048;
    #pragma unroll
    for(int r=0;r<16;++r){const int orow=crow(r,hi);
      #pragma unroll
      for(int d0=0;d0<2;++d0)stg[orow*64+d0*32+r32]=__float2bfloat16(o[d0][r]*rli[r]);}
    asm volatile("s_waitcnt lgkmcnt(0)":::"memory");
    #pragma unroll
    for(int i=0;i<4;++i){const int row=i*8+(lane>>3),ch=lane&7; const u32x4 v=*(const u32x4*)(stg+row*64+ch*8); ATTN_STORE16(Ow+(long)row*OP+ch*8,v);} }
  asm volatile("s_waitcnt lgkmcnt(0)\n\ts_barrier":::"memory");
  __builtin_amdgcn_s_setprio(0);
  #undef DMA_K
  #undef KROW
  #undef DMA_V
  #undef CMASK
  #undef START
  #undef RESC
  #undef ROT
}
constexpr int ATTN_LDS_BYTES=LDS_BYTES;
#undef SBAR
#undef WAIT_BAR
}

#define DI __device__ __forceinline__
#define LAS __attribute__((address_space(3)))
typedef unsigned short bf16;
typedef unsigned v4u __attribute__((ext_vector_type(4)));
typedef unsigned v2u __attribute__((ext_vector_type(2)));
typedef float f32x4 __attribute__((ext_vector_type(4)));
typedef float f32x2 __attribute__((ext_vector_type(2)));
typedef float f32x16 __attribute__((ext_vector_type(16)));
typedef short bf16x8 __attribute__((ext_vector_type(8)));
typedef __bf16 bf16x2_t __attribute__((ext_vector_type(2)));

constexpr int NWAVES = 8, NTHR = 512;
constexpr int BATCH = 2, SEQ = 8192, DM = 1024, LC = 256;
constexpr int NLAT = BATCH * SEQ;
constexpr int NROW = NLAT + BATCH * LC;
constexpr int KT = LC + SEQ;
constexpr int NEXP = 16;
constexpr float LOG2E = 1.4426950408889634f;
constexpr float QSCALE = 0.125f * LOG2E;
constexpr bool MOE_FP8 = true;
constexpr float WSCALE = 32.0f, WINV = 1.0f / 32.0f;

constexpr size_t MiB = 1u << 20;
constexpr size_t WS_CTL = 0, CTL_BYTES = 64 * 1024;
constexpr size_t WS_MOD = 1 * MiB;
constexpr size_t WS_COS = 2 * MiB, WS_SIN = 3 * MiB;
constexpr size_t WS_AFFT = 4 * MiB;
constexpr size_t WS_SLOT = 6 * MiB;
constexpr size_t WS_IDX = 8 * MiB;
constexpr size_t WS_GATEV = 9 * MiB;
constexpr size_t WS_SCH = 10 * MiB;
constexpr size_t WS_RST = 46 * MiB;
constexpr size_t WS_WABIN = 80 * MiB;
constexpr size_t WS_WABOUT = 83 * MiB;
constexpr size_t WS_WCDIN = 86 * MiB;
constexpr size_t WS_WCDOUT = 91 * MiB;
constexpr size_t WS_WGU = 96 * MiB;
constexpr size_t WS_WD = 352 * MiB;
constexpr size_t WS_XN = 480 * MiB;
constexpr size_t WS_X1 = 514 * MiB;
constexpr size_t WS_X2 = 580 * MiB;
constexpr size_t WS_XS = 646 * MiB;
constexpr size_t WS_ACT = 718 * MiB;
constexpr size_t WS_P = 718 * MiB;
constexpr size_t WS_CAT = 793 * MiB;
constexpr size_t WS_QA = 826 * MiB;
constexpr size_t WS_KA = 843 * MiB;
constexpr size_t WS_VTA = 848 * MiB;
constexpr size_t WS_END = 862 * MiB;

constexpr int LDS_BYTES = 147456;
constexpr int LDS_MISC = LDS_BYTES - 256;

struct Params { const float* in[25]; float* out; unsigned char* ws; unsigned long long pad; };

DI float bf2f(unsigned short b) { return __uint_as_float(((unsigned)b) << 16); }
DI unsigned cvtpk(float lo, float hi) { f32x2 v = {lo, hi}; bf16x2_t b = __builtin_convertvector(v, bf16x2_t); return __builtin_bit_cast(unsigned, b); }
DI unsigned short f2bf(float f) { return (unsigned short)(cvtpk(f, 0.f) & 0xffffu); }
DI float shx(float v, int o, int lane) { return __builtin_bit_cast(float, __builtin_amdgcn_ds_bpermute(((lane ^ o) & 63) << 2, __builtin_bit_cast(int, v))); }
DI int shxi(int v, int o, int lane) { return __builtin_amdgcn_ds_bpermute(((lane ^ o) & 63) << 2, v); }
DI float wave_sum(float v, int lane) {
#pragma unroll
    for (int o = 1; o < 64; o <<= 1) v += shx(v, o, lane);
    return v;
}
DI int crow(int i, int hi) { return (i & 3) + 8 * (i >> 2) + 4 * hi; }
#define MFMA32(a, b, c) __builtin_amdgcn_mfma_f32_32x32x16_bf16((a), (b), (c), 0, 0, 0)
#define LDS_WAIT() asm volatile("s_waitcnt lgkmcnt(0)" ::: "memory")

struct Ctx {
    int tid, lane, wave, vcu, G, gw, NGW;
    LAS unsigned char* lds;
};
typedef const __attribute__((address_space(4))) Params* KP;
DI void env(Params& p, Ctx& C, unsigned char* lds_raw) {
    KP kp = (KP)__builtin_amdgcn_kernarg_segment_ptr(); asm volatile("" : "+s"(kp) :: "memory");
#pragma unroll
    for (int i = 0; i < 25; ++i) p.in[i] = kp->in[i];
    p.out = kp->out; p.ws = kp->ws; p.pad = 0ull;
    int tid = threadIdx.x; asm volatile("" : "+v"(tid) :: "memory");
    C.lds = (LAS unsigned char*)lds_raw;
    C.tid = tid; C.lane = tid & 63; C.wave = __builtin_amdgcn_readfirstlane(tid >> 6);
    C.G = gridDim.x; { const int bx = blockIdx.x; C.vcu = (C.G % 8 == 0) ? (bx % 8) * (C.G / 8) + bx / 8 : bx; }
    C.gw = C.vcu * NWAVES + C.wave; C.NGW = C.G * NWAVES;
}

DI void transpose_item(const float* W, int N, int k0, int n0, bf16* dst, int dpitch, LAS float* scr  , int lane) {
    f32x4 t[16];
    const float* wp = W + (size_t)(k0 + (lane >> 4)) * N + n0 + (lane & 15) * 4;
#pragma unroll
    for (int i = 0; i < 16; ++i) t[i] = __builtin_nontemporal_load((const f32x4*)(wp + (size_t)(4 * i) * N));
#pragma unroll
    for (int i = 0; i < 16; ++i) { LAS float* sp = scr + ((lane >> 4) + 4 * i) * 65 + (lane & 15) * 4; sp[0] = t[i].x; sp[1] = t[i].y; sp[2] = t[i].z; sp[3] = t[i].w; }
    LDS_WAIT(); asm volatile("" ::: "memory");
    const int c = lane & 7;
#pragma unroll
    for (int j = 0; j < 8; ++j) { const int n = (lane >> 3) + 8 * j; const LAS float* s = scr + (8 * c) * 65 + n;
        v4u o; o.x = cvtpk(s[0 * 65], s[1 * 65]); o.y = cvtpk(s[2 * 65], s[3 * 65]); o.z = cvtpk(s[4 * 65], s[5 * 65]); o.w = cvtpk(s[6 * 65], s[7 * 65]);
        __builtin_nontemporal_store(o, (v4u*)(dst + (size_t)n * dpitch + 8 * c)); }
    LDS_WAIT(); asm volatile("" ::: "memory");
}

DI unsigned pk4f8(float a, float b, float c, float d) { unsigned w = 0u; w = __builtin_amdgcn_cvt_pk_fp8_f32(a, b, w, false); w = __builtin_amdgcn_cvt_pk_fp8_f32(c, d, w, true); return w; }
DI void transpose_item_f8(const float* W, int N, int k0, int n0, unsigned char* dst, int dpitch, LAS float* scr  , int lane) {
    f32x4 t[16];
    const float* wp = W + (size_t)(k0 + (lane >> 4)) * N + n0 + (lane & 15) * 4;
#pragma unroll
    for (int i = 0; i < 16; ++i) t[i] = __builtin_nontemporal_load((const f32x4*)(wp + (size_t)(4 * i) * N));
#pragma unroll
    for (int i = 0; i < 16; ++i) { LAS float* sp = scr + ((lane >> 4) + 4 * i) * 65 + (lane & 15) * 4; sp[0] = t[i].x * WSCALE; sp[1] = t[i].y * WSCALE; sp[2] = t[i].z * WSCALE; sp[3] = t[i].w * WSCALE; }
    LDS_WAIT(); asm volatile("" ::: "memory");
    const int c = lane & 3;
#pragma unroll
    for (int j = 0; j < 4; ++j) { const int n = (lane >> 2) + 16 * j; const LAS float* s = scr + (16 * c) * 65 + n;
        v4u o; o.x = pk4f8(s[0 * 65], s[1 * 65], s[2 * 65], s[3 * 65]); o.y = pk4f8(s[4 * 65], s[5 * 65], s[6 * 65], s[7 * 65]);
        o.z = pk4f8(s[8 * 65], s[9 * 65], s[10 * 65], s[11 * 65]); o.w = pk4f8(s[12 * 65], s[13 * 65], s[14 * 65], s[15 * 65]);
        __builtin_nontemporal_store(o, (v4u*)(dst + (size_t)n * dpitch + 16 * c)); }
    LDS_WAIT(); asm volatile("" ::: "memory");
}

constexpr int MOE_ITEMS = 3 * 16 * 512;
DI void convert_moe_item(const Params& p, int l, int it, LAS float* scr, int lane) {
    const int kind = it >> 13, r = it & 8191, mat = l * 16 + (r >> 9), rr = r & 511;
    if (kind < 2) { const int kb = rr >> 5, nb = rr & 31, n0 = 64 * nb; const float* src = (kind ? p.in[23] : p.in[22]) + (size_t)mat * 1024 * 2048;
        const int drow = mat * 4096 + (n0 >> 7) * 256 + (n0 & 127) + (kind ? 128 : 0);
        if (MOE_FP8) transpose_item_f8(src, 2048, 64 * kb, n0, (unsigned char*)(p.ws + WS_WGU) + (size_t)drow * 1024 + 64 * kb, 1024, scr, lane);
        else transpose_item(src, 2048, 64 * kb, n0, (bf16*)(p.ws + WS_WGU) + (size_t)drow * 1024 + 64 * kb, 1024, scr, lane); }
    else { const int kb = rr >> 4, nb = rr & 15; const float* src = p.in[24] + (size_t)mat * 2048 * 1024;
        if (MOE_FP8) transpose_item_f8(src, 1024, 64 * kb, 64 * nb, (unsigned char*)(p.ws + WS_WD) + (size_t)(mat * 1024 + 64 * nb) * 2048 + 64 * kb, 2048, scr, lane);
        else transpose_item(src, 1024, 64 * kb, 64 * nb, (bf16*)(p.ws + WS_WD) + (size_t)(mat * 1024 + 64 * nb) * 2048 + 64 * kb, 2048, scr, lane); }
}
struct SlotPlan { int base[6], nidle[6], q[6], covered[2]; };
DI SlotPlan make_slot_plan(int G) {
    SlotPlan sp; const int nunits[6] = {330, 264, 64, 576, 594, 32}; const int qq[6] = {40, 40, 40, 32, 32, 32};
#pragma unroll
    for (int st = 0; st < 2; ++st) { int acc = 0;
#pragma unroll
        for (int k = 3 * st; k < 3 * st + 3; ++k) { const int rounds = (nunits[k] + G - 1) / G; const int busy = nunits[k] - (rounds - 1) * G; const int ni = G - busy; sp.nidle[k] = ni; sp.base[k] = acc;
            sp.q[k] = qq[k]; acc += (ni > 0 ? ni : 0) * qq[k]; if (acc > MOE_ITEMS) acc = MOE_ITEMS; }
        sp.covered[st] = acc; }
    return sp;
}
DI void convert_slot(const Ctx& C, const Params& p, int k, int c) {
    const SlotPlan sp = make_slot_plan(C.G);
    const int ii = c - (C.G - sp.nidle[k]); if (ii < 0) return;
    const int first = sp.base[k] + ii * sp.q[k]; int last = first + sp.q[k]; if (last > MOE_ITEMS) last = MOE_ITEMS;
    LAS float* scr = (LAS float*)(C.lds + C.wave * 16640);
    for (int it = first + C.wave; it < last; it += NWAVES) convert_moe_item(p, k < 3 ? 0 : 1, it, scr, C.lane);
}

DI void ph0_prologue(const Ctx& C, const Params& p) {
    unsigned char* ws = p.ws;
    float* MOD = (float*)(ws + WS_MOD);
    {
        LAS float* sv = (LAS float*)(C.lds);
        LAS float* red = (LAS float*)(C.lds + 12288);
        for (int i = C.tid; i < 3 * 1024; i += NTHR) { const int r = i >> 10, k = i & 1023; const float cv = (r < 2) ? p.in[1][r * 1024 + k] : p.in[3][k]; sv[i] = cv / (1.f + __expf(-cv)); }
        __syncthreads();
        for (int item = C.vcu; item < 192; item += C.G) {
            const int l = item / 96, n0 = (item % 96) * 64;
            const float* W = p.in[4] + (size_t)l * 1024 * 6144 + n0 + C.lane;
            float a0 = 0.f, a1 = 0.f, a2 = 0.f;
            const int kb = C.wave * 128;
#pragma unroll 32
            for (int k = 0; k < 128; ++k) { const float w = __builtin_nontemporal_load(W + (size_t)(kb + k) * 6144); a0 += sv[kb + k] * w; a1 += sv[1024 + kb + k] * w; a2 += sv[2048 + kb + k] * w; }
            red[(C.wave * 3 + 0) * 64 + C.lane] = a0; red[(C.wave * 3 + 1) * 64 + C.lane] = a1; red[(C.wave * 3 + 2) * 64 + C.lane] = a2;
            __syncthreads();
            if (C.tid < 192) { const int r = C.tid >> 6, ln = C.tid & 63; float s = 0.f;
#pragma unroll
                for (int w = 0; w < 8; ++w) s += red[(w * 3 + r) * 64 + ln];
                MOD[(size_t)(l * 3 + r) * 6144 + n0 + ln] = s + p.in[5][l * 6144 + n0 + ln]; }
            __syncthreads();
        }
        __syncthreads();
    }
    {
        float* COS = (float*)(ws + WS_COS); float* SIN = (float*)(ws + WS_SIN);
        for (int i = C.vcu * NTHR + C.tid; i < SEQ * 32; i += C.G * NTHR) {
            const int t = i >> 5, j = i & 31; const int pos = (j < 16) ? (t >> 6) : (t & 63); const int fi = j & 15;
            const float freq = powf(10000.0f, -(float)fi / 16.0f); const float ang = (float)pos * freq;
            COS[i] = cosf(ang); SIN[i] = sinf(ang);
        }
    }
    {
        LAS float* scr = (LAS float*)(C.lds + C.wave * 16640);
        bf16* WABIN = (bf16*)(ws + WS_WABIN); bf16* WABOUT = (bf16*)(ws + WS_WABOUT);
        bf16* WCDIN = (bf16*)(ws + WS_WCDIN); bf16* WCDOUT = (bf16*)(ws + WS_WCDOUT); bf16* WGU = (bf16*)(ws + WS_WGU); bf16* WD = (bf16*)(ws + WS_WD);
        constexpr int I0 = 16 * 20, I1 = 8 * 16, I2 = 16 * 36, I3 = 16 * 16, I4 = 1024, I5 = 0, I6 = 16 * 512, I7 = 16 * 512, I8 = 16 * 512;
        constexpr int NITEMS = I0 + I1 + I2 + I3 + I4 + I5;
        for (int it = C.gw; it < NITEMS; it += C.NGW) {
            int r = it;
            if (r < I0) { const int kb = r / 20, nb = r % 20; transpose_item(p.in[9], 1280, 64 * kb, 64 * nb, WABIN + (size_t)(64 * nb) * 1024 + 64 * kb, 1024, scr, C.lane); continue; } r -= I0;
            if (r < I1) { const int kb = r / 16, nb = r % 16; transpose_item(p.in[10], 1024, 64 * kb, 64 * nb, WABOUT + (size_t)(64 * nb) * 1024 + 64 * kb, 1024, scr, C.lane); continue; } r -= I1;
            if (r < I2) { const int kb = r / 36, nb = r % 36; transpose_item(p.in[15], 2304, 64 * kb, 64 * nb, WCDIN + (size_t)(64 * nb) * 1024 + 64 * kb, 1024, scr, C.lane); continue; } r -= I2;
            if (r < I3) { const int kb = r / 16, nb = r % 16; transpose_item(p.in[16], 1024, 64 * kb, 64 * nb, WCDOUT + (size_t)(64 * nb) * 1024 + 64 * kb, 1024, scr, C.lane); continue; } r -= I3;
            if (r < I4) {
                const int g = r >> 8, cb = (r >> 4) & 15, nb = r & 15, c0 = 8 * cb, n0 = 64 * nb;
                const float* Wg = p.in[13] + (size_t)g * 128 * 128 + (size_t)c0 * 128; const float* bs = p.in[14] + g * 128; const float* Wo = p.in[10] + (size_t)(512 + g * 128) * 1024 + n0 + C.lane;
                float a8[8];
#pragma unroll
                for (int ci = 0; ci < 8; ++ci) a8[ci] = 0.f;
#pragma unroll 8
                for (int d = 0; d < 128; ++d) { const float w = Wo[(size_t)d * 1024] * bs[d];
#pragma unroll
                    for (int ci = 0; ci < 8; ++ci) a8[ci] += Wg[ci * 128 + d] * w; }
                v4u o; o.x = cvtpk(a8[0], a8[1]); o.y = cvtpk(a8[2], a8[3]); o.z = cvtpk(a8[4], a8[5]); o.w = cvtpk(a8[6], a8[7]);
                *(v4u*)(WABOUT + (size_t)(n0 + C.lane) * 1024 + 512 + g * 128 + c0) = o; continue; } r -= I4;
        }
        { const SlotPlan sp = make_slot_plan(C.G);
          const int n0 = MOE_ITEMS - sp.covered[0], n1 = MOE_ITEMS - sp.covered[1];
          for (int it = C.gw; it < n0 + n1; it += C.NGW) { if (it < n0) convert_moe_item(p, 0, sp.covered[0] + it, scr, C.lane); else convert_moe_item(p, 1, sp.covered[1] + (it - n0), scr, C.lane); } }
    }
}

DI void load_row(const float* src, int lane, f32x4 (&v)[4]) {
#pragma unroll
    for (int j = 0; j < 4; ++j) v[j] = __builtin_nontemporal_load((const f32x4*)src + lane + 64 * j);
}
DI void load_row_h(const bf16* src, int lane, f32x4 (&v)[4]) {
#pragma unroll
    for (int j = 0; j < 4; ++j) { const v2u w = __builtin_nontemporal_load((const v2u*)src + lane + 64 * j); v[j] = (f32x4){__uint_as_float(w.x << 16), __uint_as_float(w.x & 0xffff0000u), __uint_as_float(w.y << 16), __uint_as_float(w.y & 0xffff0000u)}; }
}
DI float row_rstd(const f32x4 (&v)[4], float eps, int lane) {
    float s = 0.f;
#pragma unroll
    for (int j = 0; j < 4; ++j) s += (v[j].x * v[j].x + v[j].y * v[j].y) + (v[j].z * v[j].z + v[j].w * v[j].w);
    s = wave_sum(s, lane);
    return rsqrtf(s * (1.0f / 1024.0f) + eps);
}
template <bool OUT_FP8 = false>
DI void modulate_row(f32x4 (&v)[4], const float* g, const float* shift, const float* scale, bf16* dst, int lane) {
    const float rstd = row_rstd(v, 1e-6f, lane);
#pragma unroll
    for (int j = 0; j < 4; ++j) {
        const f32x4 gg = ((const f32x4*)g)[lane + 64 * j], sh = ((const f32x4*)shift)[lane + 64 * j], sc = ((const f32x4*)scale)[lane + 64 * j];
        v[j] = v[j] * rstd * gg * (sc + 1.0f) + sh;
        if (OUT_FP8) ((unsigned*)dst)[lane + 64 * j] = pk4f8(v[j].x, v[j].y, v[j].z, v[j].w);
        else { v2u w; w.x = cvtpk(v[j].x, v[j].y); w.y = cvtpk(v[j].z, v[j].w); ((v2u*)dst)[lane + 64 * j] = w; }
    }
}

DI void ph_modulate0(const Ctx& C, const Params& p) {
    const float* MOD = (const float*)(p.ws + WS_MOD); bf16* XN = (bf16*)(p.ws + WS_XN);
    for (int r0 = C.gw; r0 < NROW; r0 += 2 * C.NGW) {
        int rr[2] = {r0, r0 + C.NGW}; if (rr[1] >= NROW) rr[1] = r0;
        f32x4 v[2][4];
#pragma unroll
        for (int q = 0; q < 2; ++q) { const int r = rr[q]; const float* src = r < NLAT ? p.in[0] + (size_t)r * DM : p.in[2] + (size_t)(r - NLAT) * DM; load_row(src, C.lane, v[q]); }
#pragma unroll
        for (int q = 0; q < 2; ++q) { const int r = rr[q]; const int mi = r < NLAT ? (r >> 13) : 2; const float* mp = MOD + (size_t)(0 * 3 + mi) * 6144;
            modulate_row(v[q], p.in[6], mp, mp + 1024, XN + (size_t)r * DM, C.lane); }
    }
}

struct HeadRegs { v2u a, b; };
DI HeadRegs heads8_load(const bf16* src, int nheads, int lane) {
    const int hd = lane >> 3, hdc = hd < nheads ? hd : nheads - 1, j0 = (lane & 7) * 4;
    HeadRegs h; h.a = __builtin_nontemporal_load((const v2u*)(src + hdc * 64 + j0)); h.b = __builtin_nontemporal_load((const v2u*)(src + hdc * 64 + 32 + j0)); return h;
}
DI void heads8_finish(const HeadRegs h, int nheads, bool donorm, const f32x4 g1, const f32x4 g2, bool dorope, const f32x4 c, const f32x4 sv, float scale, bf16* dst, int lane) {
    const int hd = lane >> 3, j0 = (lane & 7) * 4;
    float x1[4] = {__uint_as_float(h.a.x << 16), __uint_as_float(h.a.x & 0xffff0000u), __uint_as_float(h.a.y << 16), __uint_as_float(h.a.y & 0xffff0000u)};
    float x2[4] = {__uint_as_float(h.b.x << 16), __uint_as_float(h.b.x & 0xffff0000u), __uint_as_float(h.b.y << 16), __uint_as_float(h.b.y & 0xffff0000u)};
    if (donorm) { float ss = 0.f;
#pragma unroll
        for (int i = 0; i < 4; ++i) ss += x1[i] * x1[i] + x2[i] * x2[i];
        ss += shx(ss, 1, lane); ss += shx(ss, 2, lane); ss += shx(ss, 4, lane);
        const float rs = rsqrtf(ss * (1.0f / 64.0f) + 1e-6f);
#pragma unroll
        for (int i = 0; i < 4; ++i) { x1[i] *= rs * g1[i]; x2[i] *= rs * g2[i]; } }
    if (dorope) {
#pragma unroll
        for (int i = 0; i < 4; ++i) { const float o1 = x1[i] * c[i] - x2[i] * sv[i], o2 = x1[i] * sv[i] + x2[i] * c[i]; x1[i] = o1; x2[i] = o2; } }
    if (hd < nheads) { v2u o1, o2; o1.x = cvtpk(x1[0] * scale, x1[1] * scale); o1.y = cvtpk(x1[2] * scale, x1[3] * scale); o2.x = cvtpk(x2[0] * scale, x2[1] * scale); o2.y = cvtpk(x2[2] * scale, x2[3] * scale);
        *(v2u*)(dst + hd * 64 + j0) = o1; *(v2u*)(dst + hd * 64 + 32 + j0) = o2; }
}

DI void ph_post0(const Ctx& C, const Params& p) {
    const bf16* P = (const bf16*)(p.ws + WS_P); bf16* QA = (bf16*)(p.ws + WS_QA); bf16* KA = (bf16*)(p.ws + WS_KA); bf16* VA = (bf16*)(p.ws + WS_VTA); bf16* CATB = (bf16*)(p.ws + WS_CAT) + 512;
    const float* COS = (const float*)(p.ws + WS_COS); const float* SIN = (const float*)(p.ws + WS_SIN);
    const int j0 = (C.lane & 7) * 4;
    const f32x4 qg1 = *(const f32x4*)(p.in[11] + j0), qg2 = *(const f32x4*)(p.in[11] + 32 + j0), kg1 = *(const f32x4*)(p.in[12] + j0), kg2 = *(const f32x4*)(p.in[12] + 32 + j0);
    for (int r0 = C.gw; r0 < NROW; r0 += 2 * C.NGW) {
        int rr[2] = {r0, r0 + C.NGW}; if (rr[1] >= NROW) rr[1] = r0;
        bool isctx[2]; int bb[2], pos[2], kk[2]; const bf16* prow[2];
#pragma unroll
        for (int q = 0; q < 2; ++q) { const int r = rr[q]; isctx[q] = r >= NLAT; bb[q] = isctx[q] ? ((r - NLAT) >> 8) : (r >> 13); pos[q] = isctx[q] ? ((r - NLAT) & 255) : (r & 8191);
            kk[q] = isctx[q] ? pos[q] : LC + pos[q]; prow[q] = P + (size_t)r * 1280; }
        HeadRegs hq[2], hk[2]; v4u vc[2], uu[2]; f32x4 c4[2], s4[2];
#pragma unroll
        for (int q = 0; q < 2; ++q) { hq[q] = heads8_load(prow[q], 8, C.lane); hk[q] = heads8_load(prow[q] + 512, 2, C.lane);
            vc[q] = *(const v4u*)(prow[q] + 640 + (C.lane & 15) * 8); uu[q] = *(const v4u*)(prow[q] + 768 + C.lane * 8);
            const size_t tp = (size_t)(isctx[q] ? 0 : pos[q]) * 32 + j0; c4[q] = *(const f32x4*)(COS + tp); s4[q] = *(const f32x4*)(SIN + tp); }
        const int c0 = C.lane * 8, g = C.lane >> 4, w = 2 << g;
        int lo[2], hi[2]; float s[2][8];
#pragma unroll
        for (int q = 0; q < 2; ++q) { const int L = isctx[q] ? LC : SEQ; lo[q] = max(pos[q] - (w >> 1), 0); hi[q] = min(pos[q] - (w >> 1) + w, L);
#pragma unroll
            for (int i = 0; i < 8; ++i) s[q][i] = 0.f; }
#pragma unroll
        for (int bt = 0; bt < 2; ++bt) {
            if (bt == 1 && !__any((lo[0] + 8 < hi[0]) || (lo[1] + 8 < hi[1]))) break;
            v4u vv[2][8];
#pragma unroll
            for (int q = 0; q < 2; ++q) { const size_t rowbase = (size_t)rr[q] - pos[q];
#pragma unroll
                for (int k = 0; k < 8; ++k) { const int rw = min(lo[q] + 8 * bt + k, hi[q] - 1); vv[q][k] = *(const v4u*)(P + (rowbase + rw) * 1280 + 768 + c0); } }
            if (bt == 0) {
#pragma unroll
                for (int q = 0; q < 2; ++q) {
                    heads8_finish(hq[q], 8, true, qg1, qg2, !isctx[q], c4[q], s4[q], QSCALE, QA + (size_t)rr[q] * 512, C.lane);
                    heads8_finish(hk[q], 2, true, kg1, kg2, !isctx[q], c4[q], s4[q], 1.0f, KA + ((size_t)bb[q] * KT + kk[q]) * 128, C.lane);
                    if (C.lane < 16) *(v4u*)(VA + ((size_t)bb[q] * KT + kk[q]) * 128 + C.lane * 8) = vc[q]; }
            }
#pragma unroll
            for (int q = 0; q < 2; ++q)
#pragma unroll
                for (int k = 0; k < 8; ++k) { const float wgt = (lo[q] + 8 * bt + k < hi[q]) ? 1.0f : 0.0f;
#pragma unroll
                    for (int i = 0; i < 4; ++i) { s[q][2 * i] += wgt * __uint_as_float(vv[q][k][i] << 16); s[q][2 * i + 1] += wgt * __uint_as_float(vv[q][k][i] & 0xffff0000u); } }
        }
#pragma unroll
        for (int q = 0; q < 2; ++q) { const float inv = 1.0f / (float)(hi[q] - lo[q]); v4u o;
#pragma unroll
            for (int i = 0; i < 4; ++i) o[i] = cvtpk(s[q][2 * i] * inv - __uint_as_float(uu[q][i] << 16), s[q][2 * i + 1] * inv - __uint_as_float(uu[q][i] & 0xffff0000u));
            *(v4u*)(CATB + (size_t)rr[q] * 1024 + c0) = o; }
    }
}

DI void ph_post1(const Ctx& C, const Params& p) {
    bf16* P = (bf16*)(p.ws + WS_P); bf16* KA = (bf16*)(p.ws + WS_KA); bf16* VTA = (bf16*)(p.ws + WS_VTA);
    const float* COS = (const float*)(p.ws + WS_COS); const float* SIN = (const float*)(p.ws + WS_SIN);
    const int j0 = (C.lane & 7) * 4; const f32x4 one = (f32x4){1.f, 1.f, 1.f, 1.f};
    for (int r0 = C.gw; r0 < NROW; r0 += 2 * C.NGW) {
        int rr[2] = {r0, r0 + C.NGW}; const bool dup = rr[1] >= NROW; if (dup) rr[1] = r0;
        bool isctx[2]; int bb[2], kk[2]; bf16* prow[2];
        HeadRegs hcq[2], hck[2], hdq[2], hdk[2]; v4u vc[2]; f32x4 c4[2], s4[2];
#pragma unroll
        for (int q = 0; q < 2; ++q) { const int r = rr[q]; isctx[q] = r >= NLAT; bb[q] = isctx[q] ? ((r - NLAT) >> 8) : (r >> 13); const int pos = isctx[q] ? ((r - NLAT) & 255) : (r & 8191);
            kk[q] = isctx[q] ? pos : LC + pos; prow[q] = P + (size_t)r * 2304;
            hcq[q] = heads8_load(prow[q], 4, C.lane); hck[q] = heads8_load(prow[q] + 256, 4, C.lane); hdq[q] = heads8_load(prow[q] + 1536, 8, C.lane); hdk[q] = heads8_load(prow[q] + 2048, 2, C.lane);
            vc[q] = *(const v4u*)(prow[q] + 2176 + (C.lane & 15) * 8);
            const size_t tp = (size_t)(isctx[q] ? 0 : pos) * 32 + j0; c4[q] = *(const f32x4*)(COS + tp); s4[q] = *(const f32x4*)(SIN + tp); }
#pragma unroll
        for (int q = 0; q < 2; ++q) { if (q == 1 && dup) break;
            if (!isctx[q]) { heads8_finish(hcq[q], 4, false, one, one, true, c4[q], s4[q], 1.0f, prow[q], C.lane); heads8_finish(hdq[q], 8, false, one, one, true, c4[q], s4[q], QSCALE, prow[q] + 1536, C.lane); }
            heads8_finish(hck[q], 4, false, one, one, !isctx[q], c4[q], s4[q], 0.125f, prow[q] + 256, C.lane);
            heads8_finish(hdk[q], 2, false, one, one, !isctx[q], c4[q], s4[q], 1.0f, KA + ((size_t)bb[q] * KT + kk[q]) * 128, C.lane);
            if (C.lane < 16) *(v4u*)(VTA + ((size_t)bb[q] * KT + kk[q]) * 128 + C.lane * 8) = vc[q]; }
    }
}

DI void ph_attn_dense(const Ctx& C, const Params& p, unsigned char* lds_raw) {
    typedef attn_body::bf16 abf;
    const abf* QA = (const abf*)(p.ws + WS_QA); const abf* KA = (const abf*)(p.ws + WS_KA); const abf* VA = (const abf*)(p.ws + WS_VTA); abf* CAT = (abf*)(p.ws + WS_CAT);
    for (int u = C.vcu; u < 512 + 16; u += C.G) {
        if (u < 512) { const int qb = u & 31, h = (u >> 5) & 7, b = u >> 8; const size_t row0 = (size_t)b * SEQ + 256 * qb; const size_t kv0 = (size_t)b * KT * 128 + (h >> 2) * 64;
            attn_body::attn_unit<8, false>(QA + row0 * 512 + h * 64, 512, KA + kv0, VA + kv0, 128, KT / 64, CAT + row0 * 1024 + h * 64, 1024, (char*)lds_raw, 0, 0, 0.f); }
        else { const int v = u - 512; const int h = v & 7, b = v >> 3; const size_t row0 = (size_t)NLAT + b * LC; const size_t kv0 = (size_t)b * KT * 128 + (h >> 2) * 64;
            attn_body::attn_unit<8, false>(QA + row0 * 512 + h * 64, 512, KA + kv0, VA + kv0, 128, LC / 64, CAT + row0 * 1024 + h * 64, 1024, (char*)lds_raw, 0, 0, 0.f); }
    }
}
DI void ph_attn_window(const Ctx& C, const Params& p, unsigned char* lds_raw) {
    typedef attn_body::bf16 abf;
    const abf* P = (const abf*)(p.ws + WS_P); const abf* KA = (const abf*)(p.ws + WS_KA); const abf* VA = (const abf*)(p.ws + WS_VTA); abf* CAT = (abf*)(p.ws + WS_CAT);
    for (int u = C.vcu; u < 512; u += C.G) {
        const int qb = u & 31, h = (u >> 5) & 7, b = u >> 8; const int q0 = 256 * qb; const size_t row0 = (size_t)b * SEQ + q0; const size_t kv0 = (size_t)b * KT * 128 + (h >> 2) * 64;
        const int lo = max(q0 - 128, 0), hi = min(q0 + 384, SEQ);
        attn_body::attn_unit<8, true>(P + row0 * 2304 + 1536 + h * 64, 2304, KA + kv0, VA + kv0, 128, 4 + (hi - lo) / 64, CAT + row0 * 1024 + 512 + h * 64, 1024, (char*)lds_raw, lo, q0, p.in[20][h] * LOG2E);
    }
}

DI void ph_ffn_norm_router(const Ctx& C, const Params& p, int l, int nrows) {
    const float* MOD = (const float*)(p.ws + WS_MOD); unsigned char* XN8 = p.ws + WS_XN; const bf16* X1 = (const bf16*)(p.ws + WS_X1); float* AFFT = (float*)(p.ws + WS_AFFT);
    LAS bf16* Bh = (LAS bf16*)C.lds;
    LAS bf16* Bl = Bh + 16384;
    LAS float* GS = (LAS float*)(C.lds + 65536);
    LAS float* SH = GS + 1024;
    LAS float* cb = SH + 1024;
    const int G = C.G, w = C.vcu;
    int mi, t0, t1, rbase;
    { const int gc = nrows == NROW ? (G >= 32 ? G / 32 : 1) : 0, gl = (G - gc) / 2;
      if (w < gl) { mi = 0; rbase = 0; t0 = (w * 512) / gl; t1 = ((w + 1) * 512) / gl; }
      else if (nrows != NROW || w < 2 * gl) { const int n = nrows == NROW ? gl : G - gl, i = w - gl; mi = 1; rbase = SEQ; t0 = (i * 512) / n; t1 = ((i + 1) * 512) / n; }
      else { const int n = G - 2 * gl, i = w - 2 * gl; mi = 2; rbase = NLAT; t0 = (i * 32) / n; t1 = ((i + 1) * 32) / n; } }
    const float* mp = MOD + (size_t)(l * 3 + mi) * 6144; const float* gw = p.in[7] + l * 1024; const float* shp = mp + 3 * 1024; const float* scp = mp + 4 * 1024;
    const float* RW = p.in[21] + (size_t)l * 1024 * 16;
    const int wv = __builtin_amdgcn_readfirstlane(C.wave);
    const int row = C.lane & 15, kg = C.lane >> 4;
    unsigned xo = (unsigned)(row * 1024 + 32 * kg); asm volatile("" : "+v"(xo));
    v4u xq[8][4];
    int t = t0 + wv;
    if (t < t1) { const bf16* xt = X1 + (size_t)(rbase + 16 * t) * DM;
#pragma unroll
        for (int q = 0; q < 8; ++q)
#pragma unroll
            for (int c = 0; c < 4; ++c) xq[q][c] = __builtin_nontemporal_load((const v4u*)(xt + xo + 128 * q + 8 * c)); }
    { float wr[32];
#pragma unroll
      for (int it = 0; it < 32; ++it) wr[it] = RW[C.tid + NTHR * it];
#pragma unroll
      for (int h = 0; h < 2; ++h) { const int k = C.tid + NTHR * h; GS[k] = gw[k] * (scp[k] + 1.0f); SH[k] = shp[k]; }
      __syncthreads();
      float cacc = 0.f;
      unsigned tq = (unsigned)C.tid; asm volatile("" : "+v"(tq));
      const unsigned e = tq & 15u, kb = tq >> 4;
      unsigned ob = ((((kb >> 3) * 4u) * 16u + e) * 8u + (kb & 7u)); asm volatile("" : "+v"(ob));
#pragma unroll
      for (int it = 0; it < 32; ++it) {
          const float gk = GS[kb + 32 * it], shk = SH[kb + 32 * it];
          const float bf = gk * wr[it]; const unsigned short hi = f2bf(bf); const unsigned short lo = f2bf(bf - bf2f(hi));
          const int o = ((4 * (it >> 2)) * 4 + (it & 3)) * 16 * 8;
          Bh[ob + o] = hi; Bl[ob + o] = lo; cacc += shk * wr[it]; }
      cacc += shx(cacc, 16, C.lane); cacc += shx(cacc, 32, C.lane);
      if (C.lane < 16) cb[wv * 16 + C.lane] = cacc; }
    __syncthreads();
    float cbias = 0.f;
#pragma unroll
    for (int ww = 0; ww < 8; ++ww) cbias += cb[ww * 16 + row];
    while (t < t1) {
        const int r0 = rbase + 16 * t;
        f32x4 acc = (f32x4){0.f, 0.f, 0.f, 0.f}; float ssq = 0.f;
        int ln = C.lane; asm volatile("" : "+v"(ln));
        unsigned lb = (unsigned)ln * 8u;
#pragma unroll
        for (int q = 0; q < 8; ++q)
#pragma unroll
            for (int c = 0; c < 4; ++c) {
                const bf16x8 bh = *(const LAS bf16x8*)(Bh + lb + (4 * q + c) * 512), bl = *(const LAS bf16x8*)(Bl + lb + (4 * q + c) * 512);
                const bf16x8 a = __builtin_bit_cast(bf16x8, xq[q][c]);
                acc = __builtin_amdgcn_mfma_f32_16x16x32_bf16(a, bh, acc, 0, 0, 0);
                acc = __builtin_amdgcn_mfma_f32_16x16x32_bf16(a, bl, acc, 0, 0, 0);
#pragma unroll
                for (int d = 0; d < 4; ++d) { const float x0 = __uint_as_float(xq[q][c][d] << 16), x1 = __uint_as_float(xq[q][c][d] & 0xffff0000u); ssq += x0 * x0 + x1 * x1; }
            }
        ssq += shx(ssq, 16, ln); ssq += shx(ssq, 32, ln);
        const float rstd = rsqrtf(ssq * (1.0f / 1024.0f) + 1e-6f);
        f32x4 af;
#pragma unroll
        for (int i = 0; i < 4; ++i) {
            const float rs = __builtin_bit_cast(float, __builtin_amdgcn_ds_bpermute((((ln >> 4) * 4 + i) << 2), __builtin_bit_cast(int, rstd)));
            const float lgt = acc[i] * rs + cbias;
            float mx = lgt; mx = fmaxf(mx, shx(mx, 1, ln)); mx = fmaxf(mx, shx(mx, 2, ln)); mx = fmaxf(mx, shx(mx, 4, ln)); mx = fmaxf(mx, shx(mx, 8, ln));
            const float ex = __expf(lgt - mx);
            float den = ex; den += shx(den, 1, ln); den += shx(den, 2, ln); den += shx(den, 4, ln); den += shx(den, 8, ln);
            af[i] = ex / den;
        }
        *(f32x4*)(AFFT + (size_t)row * NROW + r0 + 4 * kg) = af;
        unsigned char* ho = XN8 + (size_t)r0 * DM;
#pragma unroll
        for (int q = 0; q < 8; ++q)
#pragma unroll
            for (int c = 0; c < 4; ++c) asm volatile("" : "+v"(xq[q][c]));
        unsigned go = (unsigned)(32 * (ln >> 4));
#pragma unroll
        for (int q = 0; q < 8; ++q) {
            v4u o0, o1;
#pragma unroll
            for (int c = 0; c < 4; ++c) {
                const f32x4 g0 = *(const LAS f32x4*)(GS + go + 128 * q + 8 * c), g1 = *(const LAS f32x4*)(GS + go + 128 * q + 8 * c + 4);
                const f32x4 s0 = *(const LAS f32x4*)(SH + go + 128 * q + 8 * c), s1 = *(const LAS f32x4*)(SH + go + 128 * q + 8 * c + 4);
                const v4u xx = xq[q][c];
                const float h0 = __uint_as_float(xx.x << 16) * rstd * g0.x + s0.x, h1 = __uint_as_float(xx.x & 0xffff0000u) * rstd * g0.y + s0.y;
                const float h2 = __uint_as_float(xx.y << 16) * rstd * g0.z + s0.z, h3 = __uint_as_float(xx.y & 0xffff0000u) * rstd * g0.w + s0.w;
                const float h4 = __uint_as_float(xx.z << 16) * rstd * g1.x + s1.x, h5 = __uint_as_float(xx.z & 0xffff0000u) * rstd * g1.y + s1.y;
                const float h6 = __uint_as_float(xx.w << 16) * rstd * g1.z + s1.z, h7 = __uint_as_float(xx.w & 0xffff0000u) * rstd * g1.w + s1.w;
                const unsigned p0 = pk4f8(h0, h1, h2, h3), p1 = pk4f8(h4, h5, h6, h7);
                if (c == 0) { o0.x = p0; o0.y = p1; } else if (c == 1) { o0.z = p0; o0.w = p1; } else if (c == 2) { o1.x = p0; o1.y = p1; } else { o1.z = p0; o1.w = p1; }
            }
            *(v4u*)(ho + xo + 128 * q) = o0; *(v4u*)(ho + xo + 128 * q + 16) = o1;
        }
        t += 8;
        if (t < t1) { const bf16* xt = X1 + (size_t)(rbase + 16 * t) * DM;
#pragma unroll
            for (int q = 0; q < 8; ++q)
#pragma unroll
                for (int c = 0; c < 4; ++c) xq[q][c] = __builtin_nontemporal_load((const v4u*)(xt + xo + 128 * q + 8 * c)); }
    }
    __syncthreads();
}

DI int block_exscan_i(int v, LAS int* wt  , int wave, int lane, int& tot) {
    int x = v;
#pragma unroll
    for (int o = 1; o < 64; o <<= 1) { const int y = __builtin_amdgcn_ds_bpermute(((lane - o) & 63) << 2, x); if (lane >= o) x += y; }
    __syncthreads();
    if (lane == 63) wt[wave] = x;
    __syncthreads();
    int base = 0; tot = 0;
#pragma unroll
    for (int w = 0; w < 8; ++w) { const int t = wt[w]; tot += t; if (w < wave) base += t; }
    return base + x - v;
}

DI void ph_select(const Ctx& C, const Params& p, int nsets, int RPE) {
    const float* AFFT = (const float*)(p.ws + WS_AFFT); int* SLOT = (int*)(p.ws + WS_SLOT); int* IDX = (int*)(p.ws + WS_IDX); float* GATEV = (float*)(p.ws + WS_GATEV);
    LAS int* red = (LAS int*)C.lds; LAS int* wt = (LAS int*)(C.lds + 256);
    { const int nvalid = nsets == 4 ? 2112 : 2048, npad = RPE - nvalid;
      for (int i = C.vcu * NTHR + C.tid; i < NEXP * npad; i += C.G * NTHR) { const int e = i / npad, j = i % npad; IDX[e * RPE + nvalid + j] = 0; GATEV[e * RPE + nvalid + j] = 0.f; } }
    for (int task = C.vcu; task < nsets * NEXP; task += C.G) {
        const int set = task >> 4, e = task & 15;
        const int n = set < 2 ? SEQ : LC, cap = set < 2 ? 1024 : 32;
        const int rowbase = set < 2 ? set * SEQ : NLAT + (set - 2) * LC;
        const int slotbase = set < 2 ? set * 1024 : 2048 + (set - 2) * 32;
        unsigned key[16];
        const int tok0 = C.tid * 16;
#pragma unroll
        for (int q = 0; q < 4; ++q) { v4u kv = (v4u){0u, 0u, 0u, 0u}; if (tok0 + 4 * q < n) kv = *(const v4u*)(AFFT + (size_t)e * NROW + rowbase + tok0 + 4 * q); key[4 * q] = kv.x; key[4 * q + 1] = kv.y; key[4 * q + 2] = kv.z; key[4 * q + 3] = kv.w; }
        unsigned prefix = 0u;
        __syncthreads();
        for (int bit = 30; bit >= 0; --bit) {
            const unsigned cand = prefix | (1u << bit); int cnt = 0;
#pragma unroll
            for (int i = 0; i < 16; ++i) cnt += __popcll(__ballot(key[i] >= cand));
            if (C.lane == 0) red[(bit & 1) * 8 + C.wave] = cnt;
            __syncthreads();
            int total = 0;
#pragma unroll
            for (int w = 0; w < 8; ++w) total += red[(bit & 1) * 8 + w];
            if (total >= cap) prefix = cand;
        }
        const unsigned T = prefix;
        int gtc = 0, eqc = 0;
#pragma unroll
        for (int i = 0; i < 16; ++i) { gtc += (key[i] > T) ? 1 : 0; eqc += (key[i] == T) ? 1 : 0; }
        int totgt, toteq;
        (void)block_exscan_i(gtc, wt, C.wave, C.lane, totgt);
        int eqrank = block_exscan_i(eqc, wt, C.wave, C.lane, toteq);
        const int need_eq = cap - totgt;
        unsigned selmask = 0u; int selc = 0;
#pragma unroll
        for (int i = 0; i < 16; ++i) { bool s = key[i] > T; if (key[i] == T) { s = eqrank < need_eq; ++eqrank; } if (s) { selmask |= 1u << i; ++selc; } }
        int totsel;
        int slot = block_exscan_i(selc, wt, C.wave, C.lane, totsel);
#pragma unroll
        for (int i = 0; i < 16; ++i) { const int tok = tok0 + i;
            if (tok < n) { const int row = rowbase + tok;
                if (selmask & (1u << i)) { const int sp = slotbase + slot; SLOT[(size_t)row * 16 + e] = sp; IDX[e * RPE + sp] = row; GATEV[e * RPE + sp] = __uint_as_float(key[i]); ++slot; }
                else SLOT[(size_t)row * 16 + e] = -1; } }
        __syncthreads();
    }
}

DI void ph_combine(const Ctx& C, const Params& p, int l, int nrows, int RPE) {
    const float* MOD = (const float*)(p.ws + WS_MOD); const bf16* X1 = (const bf16*)(p.ws + WS_X1); const int* SLOT = (const int*)(p.ws + WS_SLOT); const bf16* Y = (const bf16*)(p.ws + WS_XS);
    bf16* X2 = (bf16*)(p.ws + WS_X2); bf16* XN = (bf16*)(p.ws + WS_XN);
    int svn[2]; f32x4 vn[2][4];
    if (C.gw < nrows) {
#pragma unroll
        for (int q = 0; q < 2; ++q) { int r = C.gw + q * C.NGW; if (r >= nrows) r = C.gw; svn[q] = (C.lane < 16) ? SLOT[(size_t)r * 16 + C.lane] : -1; load_row_h(X1 + (size_t)r * DM, C.lane, vn[q]); } }
    for (int r0 = C.gw; r0 < nrows; r0 += 2 * C.NGW) {
        int rr[2] = {r0, r0 + C.NGW}; if (rr[1] >= nrows) rr[1] = r0;
        int sv[2]; f32x4 v[2][4], acc[2][4];
#pragma unroll
        for (int q = 0; q < 2; ++q) { sv[q] = svn[q];
#pragma unroll
            for (int j = 0; j < 4; ++j) v[q][j] = vn[q][j]; }
        { const int rn0 = r0 + 2 * C.NGW;
          if (rn0 < nrows) {
#pragma unroll
            for (int q = 0; q < 2; ++q) { int r = rn0 + q * C.NGW; if (r >= nrows) r = rn0; svn[q] = (C.lane < 16) ? SLOT[(size_t)r * 16 + C.lane] : -1; load_row_h(X1 + (size_t)r * DM, C.lane, vn[q]); } } }
        unsigned msk[2]; const v2u* yp[2][4]; float fw[2][4];
#pragma unroll
        for (int q = 0; q < 2; ++q) { msk[q] = (unsigned)__ballot(sv[q] >= 0);
#pragma unroll
            for (int k = 0; k < 4; ++k) { const bool has = msk[q] != 0u; const int e = has ? __builtin_amdgcn_readfirstlane(__builtin_ctz(msk[q])) : 0; const int sl = __builtin_amdgcn_readlane(sv[q], e);
                yp[q][k] = has ? (const v2u*)(Y + ((size_t)e * RPE + sl) * DM) : (const v2u*)Y; fw[q][k] = has ? 1.0f : 0.0f; if (has) msk[q] &= msk[q] - 1; } }
        v2u w[2][4][4];
#pragma unroll
        for (int q = 0; q < 2; ++q)
#pragma unroll
            for (int k = 0; k < 4; ++k)
#pragma unroll
                for (int j = 0; j < 4; ++j) w[q][k][j] = __builtin_nontemporal_load(yp[q][k] + C.lane + 64 * j);
#pragma unroll
        for (int q = 0; q < 2; ++q)
#pragma unroll
            for (int j = 0; j < 4; ++j) { f32x4 a = (f32x4){0.f, 0.f, 0.f, 0.f};
#pragma unroll
                for (int k = 0; k < 4; ++k) { const float f = fw[q][k]; const v2u ww = w[q][k][j];
                    a.x += f * __uint_as_float(ww.x << 16); a.y += f * __uint_as_float(ww.x & 0xffff0000u); a.z += f * __uint_as_float(ww.y << 16); a.w += f * __uint_as_float(ww.y & 0xffff0000u); }
                acc[q][j] = a; }
#pragma unroll
        for (int q = 0; q < 2; ++q)
            while (msk[q]) { const int e = __builtin_amdgcn_readfirstlane(__builtin_ctz(msk[q])); msk[q] &= msk[q] - 1; const int sl = __builtin_amdgcn_readlane(sv[q], e);
                const v2u* y0 = (const v2u*)(Y + ((size_t)e * RPE + sl) * DM);
#pragma unroll
                for (int j = 0; j < 4; ++j) { const v2u ww = __builtin_nontemporal_load(y0 + C.lane + 64 * j);
                    acc[q][j].x += __uint_as_float(ww.x << 16); acc[q][j].y += __uint_as_float(ww.x & 0xffff0000u); acc[q][j].z += __uint_as_float(ww.y << 16); acc[q][j].w += __uint_as_float(ww.y & 0xffff0000u); } }
#pragma unroll
        for (int q = 0; q < 2; ++q) { const int r = rr[q]; const int mi = r < NLAT ? (r >> 13) : 2;
            const float* g2 = MOD + (size_t)(l * 3 + mi) * 6144 + 5 * 1024;
#pragma unroll
            for (int j = 0; j < 4; ++j) v[q][j] = v[q][j] + ((const f32x4*)g2)[C.lane + 64 * j] * acc[q][j];
            if (l == 0) {
#pragma unroll
                for (int j = 0; j < 4; ++j) { v2u w; w.x = cvtpk(v[q][j].x, v[q][j].y); w.y = cvtpk(v[q][j].z, v[q][j].w); __builtin_nontemporal_store(w, (v2u*)(X2 + (size_t)r * DM) + C.lane + 64 * j); }
                const float* mp = MOD + (size_t)(1 * 3 + mi) * 6144;
                modulate_row(v[q], p.in[6] + 1024, mp, mp + 1024, XN + (size_t)r * DM, C.lane);
            } else {
                const float rstd = row_rstd(v[q], 1e-6f, C.lane);
#pragma unroll
                for (int j = 0; j < 4; ++j) __builtin_nontemporal_store(v[q][j] * rstd * ((const f32x4*)p.in[8])[C.lane + 64 * j], (f32x4*)(p.out + (size_t)r * DM) + C.lane + 64 * j);
            }
        }
    }
}

constexpr int RT = 128;
constexpr int TP = 136;
DI float ret_lg2(const float* e, int hh) { return log1pf(-exp2f(-e[hh])) * LOG2E; }

DI void ph_ret_chunk_states(const Ctx& C, const Params& p) {
    const bf16* P = (const bf16*)(p.ws + WS_P); float* SCH = (float*)(p.ws + WS_SCH);
    LAS bf16* Ktf = (LAS bf16*)C.lds; LAS bf16* Ktb = Ktf + 64 * TP; LAS bf16* Vt = Ktb + 64 * TP;
    const int r32 = C.lane & 31, hi = C.lane >> 5;
    for (int u = C.vcu; u < 2 * 4 * 66; u += C.G) {
        const int cc = u % 66, hh = (u / 66) & 3, b = u / 264;
        const size_t row0 = cc < 64 ? (size_t)b * SEQ + cc * RT : (size_t)NLAT + b * LC + (cc - 64) * RT;
        const float lgf = ret_lg2(p.in[17], hh), lgb = ret_lg2(p.in[18], hh);
        v4u kv2[2], vv4[4];
#pragma unroll
        for (int k = 0; k < 2; ++k) { const int q = C.tid + k * NTHR; const int pp = q & 127, d0 = (q >> 7) * 8; kv2[k] = *(const v4u*)(P + (row0 + pp) * 2304 + 256 + hh * 64 + d0); }
#pragma unroll
        for (int k = 0; k < 4; ++k) { const int q = C.tid + k * NTHR; const int pp = q & 127, v0 = (q >> 7) * 8; vv4[k] = *(const v4u*)(P + (row0 + pp) * 2304 + 512 + hh * 128 + v0); }
#pragma unroll
        for (int k = 0; k < 2; ++k) { const int q = C.tid + k * NTHR; const int pp = q & 127, d0 = (q >> 7) * 8; const v4u kv = kv2[k];
            const float wf = exp2f(lgf * (float)(127 - pp)), wb = exp2f(lgb * (float)pp);
#pragma unroll
            for (int i = 0; i < 4; ++i) { const float k0 = __uint_as_float(kv[i] << 16), k1 = __uint_as_float(kv[i] & 0xffff0000u);
                Ktf[(d0 + 2 * i) * TP + pp] = f2bf(k0 * wf); Ktf[(d0 + 2 * i + 1) * TP + pp] = f2bf(k1 * wf); Ktb[(d0 + 2 * i) * TP + pp] = f2bf(k0 * wb); Ktb[(d0 + 2 * i + 1) * TP + pp] = f2bf(k1 * wb); } }
#pragma unroll
        for (int k = 0; k < 4; ++k) { const int q = C.tid + k * NTHR; const int pp = q & 127, v0 = (q >> 7) * 8; const v4u vv = vv4[k];
#pragma unroll
            for (int i = 0; i < 4; ++i) { Vt[(v0 + 2 * i) * TP + pp] = (bf16)(vv[i] & 0xffffu); Vt[(v0 + 2 * i + 1) * TP + pp] = (bf16)(vv[i] >> 16); } }
        __syncthreads();
        const int db = C.wave & 1, vb = C.wave >> 1;
        f32x16 sf, sb;
#pragma unroll
        for (int i = 0; i < 16; ++i) { sf[i] = 0.f; sb[i] = 0.f; }
#pragma unroll
        for (int ks = 0; ks < 8; ++ks) {
            const bf16x8 af = *(const LAS bf16x8*)(Ktf + (32 * db + r32) * TP + 16 * ks + 8 * hi);
            const bf16x8 ab = *(const LAS bf16x8*)(Ktb + (32 * db + r32) * TP + 16 * ks + 8 * hi);
            const bf16x8 bv = *(const LAS bf16x8*)(Vt + (32 * vb + r32) * TP + 16 * ks + 8 * hi);
            sf = MFMA32(af, bv, sf); sb = MFMA32(ab, bv, sb);
        }
        float* of = SCH + ((((size_t)0 * 2 + b) * 4 + hh) * 66 + cc) * 8192; float* ob = SCH + ((((size_t)1 * 2 + b) * 4 + hh) * 66 + cc) * 8192;
#pragma unroll
        for (int i = 0; i < 16; ++i) { const int d = 32 * db + crow(i, hi); of[d * 128 + 32 * vb + r32] = sf[i]; ob[d * 128 + 32 * vb + r32] = sb[i]; }
        __syncthreads();
    }
}

DI void ph_ret_scan(const Ctx& C, const Params& p) {
    const float* SCH = (const float*)(p.ws + WS_SCH); float* RST = (float*)(p.ws + WS_RST);
    for (int i = C.vcu * NTHR + C.tid; i < 2 * 2 * 4 * 8192; i += C.G * NTHR) {
        const int el = i & 8191, hh = (i >> 13) & 3, b = (i >> 15) & 1, dir = i >> 16;
        const float g128 = exp2f(ret_lg2(dir == 0 ? p.in[17] : p.in[18], hh) * 128.0f);
        const float* S = SCH + (((size_t)dir * 2 + b) * 4 + hh) * 66 * 8192 + el;
        float* R = RST + (((size_t)dir * 2 + b) * 4 + hh) * 64 * 8192 + el;
        float st;
        if (dir == 0) { st = S[64 * 8192]; st = st * g128 + S[65 * 8192]; }
        else { st = S[65 * 8192]; st = st * g128 + S[64 * 8192]; }
        const long step = dir == 0 ? 8192 : -8192;
        const float* Sp = S + (dir == 0 ? 0 : (size_t)63 * 8192); float* Rp = R + (dir == 0 ? 0 : (size_t)63 * 8192);
#pragma unroll 1
        for (int c0 = 0; c0 < 64; c0 += 8) {
            float sv[8];
#pragma unroll
            for (int j = 0; j < 8; ++j) sv[j] = __builtin_nontemporal_load(Sp + j * step);
#pragma unroll
            for (int j = 0; j < 8; ++j) { Rp[j * step] = st; st = st * g128 + sv[j]; }
            Sp += 8 * step; Rp += 8 * step;
        }
    }
}

DI void ph_ret_output(const Ctx& C, const Params& p) {
    const bf16* P = (const bf16*)(p.ws + WS_P); const float* RST = (const float*)(p.ws + WS_RST); bf16* CAT = (bf16*)(p.ws + WS_CAT);
    constexpr int T2 = 256, KP = 72, VP = 260;
    LAS bf16* Ks = (LAS bf16*)C.lds;
    LAS bf16* Vt = Ks + T2 * KP;
    LAS bf16* Rtf = Vt + 128 * VP;
    LAS bf16* Rtb = Rtf + 128 * 72;
    const int r32 = C.lane & 31, hi = C.lane >> 5;
    const float* gn = p.in[19];
    for (int u = C.vcu; u < 2 * 4 * 32; u += C.G) {
        const int c2 = u & 31, hh = (u >> 5) & 3, b = u >> 7;
        const size_t row0 = (size_t)b * SEQ + c2 * T2;
        const float lgf = ret_lg2(p.in[17], hh), lgb = ret_lg2(p.in[18], hh);
        const float* Rf = RST + ((((size_t)0 * 2 + b) * 4 + hh) * 64 + 2 * c2) * 8192; const float* Rb = RST + ((((size_t)1 * 2 + b) * 4 + hh) * 64 + 2 * c2 + 1) * 8192;
        const int pl = 32 * C.wave + r32;
        const bf16* Pu = P + row0 * 2304 + hh * 64;
        unsigned tq = (unsigned)C.tid; asm volatile("" : "+v"(tq));
        unsigned gK = (tq >> 3) * 2304u + 256u + (tq & 7u) * 8u;            asm volatile("" : "+v"(gK));
        unsigned gV = (tq & 255u) * 2304u + 512u + (tq >> 8) * 8u;          asm volatile("" : "+v"(gV));
        unsigned gR = (tq & 63u) * 128u + (tq >> 6) * 4u;                   asm volatile("" : "+v"(gR));
        unsigned gQ = (unsigned)pl * 2304u + 8u * (unsigned)hi;             asm volatile("" : "+v"(gQ));
        unsigned lK = (tq >> 3) * (unsigned)KP + (tq & 7u) * 8u;            asm volatile("" : "+v"(lK));
        unsigned lV = (tq >> 8) * 8u * (unsigned)VP + (tq & 255u);          asm volatile("" : "+v"(lV));
        unsigned lR = (tq >> 6) * 4u * 72u + (tq & 63u);                    asm volatile("" : "+v"(lR));
        v4u kk4[4], vv8[8]; f32x4 ra[4], rb4[4]; bf16x8 qf[4];
#pragma unroll
        for (int k = 0; k < 4; ++k) kk4[k] = *(const v4u*)((Pu + (size_t)k * 64 * 2304) + gK);
        { const bf16* Pv = Pu + hh * 64;
#pragma unroll
          for (int k = 0; k < 8; ++k) vv8[k] = *(const v4u*)(Pv + gV + 16 * k); }
#pragma unroll
        for (int k = 0; k < 4; ++k) { ra[k] = *(const f32x4*)(Rf + gR + 32 * k); rb4[k] = *(const f32x4*)(Rb + gR + 32 * k); }
#pragma unroll
        for (int d0 = 0; d0 < 4; ++d0) qf[d0] = *(const bf16x8*)(Pu + gQ + 16 * d0);
#pragma unroll
        for (int k = 0; k < 4; ++k) *(LAS v4u*)(Ks + lK + 64 * k * KP) = kk4[k];
#pragma unroll
        for (int k = 0; k < 8; ++k) { const v4u vv = vv8[k];
#pragma unroll
            for (int i = 0; i < 4; ++i) { Vt[lV + (16 * k + 2 * i) * VP] = (bf16)(vv[i] & 0xffffu); Vt[lV + (16 * k + 2 * i + 1) * VP] = (bf16)(vv[i] >> 16); } }
#pragma unroll
        for (int k = 0; k < 4; ++k) {
#pragma unroll
            for (int i = 0; i < 4; ++i) { Rtf[lR + (32 * k + i) * 72] = f2bf(ra[k][i]); Rtb[lR + (32 * k + i) * 72] = f2bf(rb4[k][i]); } }
        __syncthreads();
        unsigned lKr = (unsigned)(r32 * KP + 8 * hi);  asm volatile("" : "+v"(lKr));
        unsigned lVr = (unsigned)(r32 * VP + 4 * hi);  asm volatile("" : "+v"(lVr));
        unsigned lRr = (unsigned)(r32 * 72 + 8 * hi);  asm volatile("" : "+v"(lRr));
        f32x16 o[4];
#pragma unroll
        for (int vb = 0; vb < 4; ++vb)
#pragma unroll
            for (int i = 0; i < 16; ++i) o[vb][i] = 0.f;
#pragma unroll 1
        for (int sb = 0; sb < 8; ++sb) {
            bf16x8 kf[4];
#pragma unroll
            for (int d0 = 0; d0 < 4; ++d0) kf[d0] = *(const LAS bf16x8*)(Ks + lKr + 32 * sb * KP + 16 * d0);
            f32x16 st;
#pragma unroll
            for (int i = 0; i < 16; ++i) st[i] = 0.f;
#pragma unroll
            for (int d0 = 0; d0 < 4; ++d0) st = MFMA32(kf[d0], qf[d0], st);
#pragma unroll
            for (int i = 0; i < 16; ++i) { const int sx = 32 * sb + crow(i, hi); const int df = pl - sx; const float w = df >= 0 ? exp2f(lgf * (float)df) : exp2f(lgb * (float)(-df)); st[i] *= w; }
#pragma unroll
            for (int ks = 0; ks < 2; ++ks) {
                v4u pw; pw.x = cvtpk(st[8 * ks + 0], st[8 * ks + 1]); pw.y = cvtpk(st[8 * ks + 2], st[8 * ks + 3]); pw.z = cvtpk(st[8 * ks + 4], st[8 * ks + 5]); pw.w = cvtpk(st[8 * ks + 6], st[8 * ks + 7]);
                const bf16x8 pa = __builtin_bit_cast(bf16x8, pw);
                const int s0 = 32 * sb + 16 * ks;
#pragma unroll
                for (int vb = 0; vb < 4; ++vb) { const LAS bf16* vp = Vt + lVr + s0 + 32 * vb * VP; const v2u lo = *(const LAS v2u*)vp, hh2 = *(const LAS v2u*)(vp + 8);
                    v4u vw; vw.x = lo.x; vw.y = lo.y; vw.z = hh2.x; vw.w = hh2.y; o[vb] = MFMA32(pa, __builtin_bit_cast(bf16x8, vw), o[vb]); }
            }
        }
        {
            const float xf = exp2f(lgf * (float)(pl + 1)), xb = exp2f(lgb * (float)(T2 - pl));
#pragma unroll
            for (int d0 = 0; d0 < 4; ++d0) {
                const v4u qw = __builtin_bit_cast(v4u, qf[d0]); v4u af, ab;
#pragma unroll
                for (int i = 0; i < 4; ++i) { const float q0 = __uint_as_float(qw[i] << 16), q1 = __uint_as_float(qw[i] & 0xffff0000u); af[i] = cvtpk(q0 * xf, q1 * xf); ab[i] = cvtpk(q0 * xb, q1 * xb); }
                const bf16x8 aF = __builtin_bit_cast(bf16x8, af), aB = __builtin_bit_cast(bf16x8, ab);
#pragma unroll
                for (int vb = 0; vb < 4; ++vb) { const bf16x8 rf = *(const LAS bf16x8*)(Rtf + lRr + 32 * vb * 72 + 16 * d0); const bf16x8 rb = *(const LAS bf16x8*)(Rtb + lRr + 32 * vb * 72 + 16 * d0);
                    o[vb] = MFMA32(aF, rf, o[vb]); o[vb] = MFMA32(aB, rb, o[vb]); }
            }
        }
        {
            float gnv[4];
#pragma unroll
            for (int vb = 0; vb < 4; ++vb) gnv[vb] = gn[hh * 128 + 32 * vb + r32];
            unsigned gpk[32];
            { const bf16* gu = P + row0 * 2304 + 1024 + hh * 128; unsigned gl = (unsigned)((32 * C.wave + 4 * hi) * 2304 + r32); asm volatile("" : "+v"(gl));
#pragma unroll
              for (int i = 0; i < 16; ++i) { const bf16* gp = (gu + ((i & 3) + 8 * (i >> 2)) * 2304) + gl; gpk[2 * i] = (unsigned)gp[0] | ((unsigned)gp[32] << 16); gpk[2 * i + 1] = (unsigned)gp[64] | ((unsigned)gp[96] << 16); } }
            float mu[16], var[16];
            unsigned ol = (unsigned)((32 * C.wave + 4 * hi) * 1024 + r32); asm volatile("" : "+v"(ol));
#pragma unroll
            for (int i = 0; i < 16; ++i) mu[i] = (o[0][i] + o[1][i]) + (o[2][i] + o[3][i]);
#pragma unroll
            for (int ofs = 1; ofs < 32; ofs <<= 1) {
#pragma unroll
                for (int i = 0; i < 16; ++i) mu[i] += shx(mu[i], ofs, C.lane); }
#pragma unroll
            for (int i = 0; i < 16; ++i) { mu[i] *= (1.0f / 128.0f); float a = 0.f;
#pragma unroll
                for (int vb = 0; vb < 4; ++vb) { o[vb][i] -= mu[i]; a += o[vb][i] * o[vb][i]; }
                var[i] = a; }
#pragma unroll
            for (int ofs = 1; ofs < 32; ofs <<= 1) {
#pragma unroll
                for (int i = 0; i < 16; ++i) var[i] += shx(var[i], ofs, C.lane); }
#pragma unroll
            for (int i = 0; i < 16; ++i) { const float rs = rsqrtf(var[i] * (1.0f / 128.0f) + 1e-5f);
                bf16* op = (CAT + row0 * 1024 + hh * 128 + ((i & 3) + 8 * (i >> 2)) * 1024) + ol;
#pragma unroll
                for (int vb = 0; vb < 4; ++vb) { const unsigned gw2 = gpk[2 * i + (vb >> 1)]; const float g = (vb & 1) ? __uint_as_float(gw2 & 0xffff0000u) : __uint_as_float(gw2 << 16);
                    op[32 * vb] = f2bf(o[vb][i] * rs * gnv[vb] * (g / (1.f + __expf(-g)))); } }
        }
        __syncthreads();
    }
}

typedef __attribute__((address_space(1))) unsigned gu32;
#define XB_TMO      128
#define XB_XCNT(j)  (256  + 64 * (j))
#define XB_XSUB(j)  (1280 + 64 * (j))
#define XB_XGEN(j)  (2304 + 64 * (j))
#define XB_TOP      3328
#define XB_TOPGEN   3392
#define XCD_BAR_WORDS 3456
#define XB_SPIN_CAP (1u << 18)

__device__ __forceinline__ unsigned xb_ld(unsigned* p)              { return __hip_atomic_load(p, __ATOMIC_RELAXED, __HIP_MEMORY_SCOPE_AGENT); }
__device__ __forceinline__ unsigned xb_add(unsigned* p, unsigned v) { return __hip_atomic_fetch_add(p, v, __ATOMIC_RELAXED, __HIP_MEMORY_SCOPE_AGENT); }
__device__ __forceinline__ unsigned xb_xcc_id() { return (unsigned)__builtin_amdgcn_s_getreg((3 << 11) | 20) & 0xFu; }
#define XB_SPIN(cond, bar) do { unsigned _sp = 0; while (cond) { __builtin_amdgcn_s_sleep(1); \
    if ((++_sp & 255u) == 0u) { if (xb_ld(&(bar)[XB_TMO])) break; if (_sp > XB_SPIN_CAP) { atomicAdd(&(bar)[XB_TMO], 1u); break; } } } } while (0)

struct XcdBarrier {
    unsigned* bar; unsigned x;
    volatile LAS unsigned* st;
};

__device__ __forceinline__ XcdBarrier xcd_barrier_post(unsigned* bar, volatile LAS unsigned* st) {
    XcdBarrier b; b.bar = bar; b.x = xb_xcc_id(); b.st = st;
    if (threadIdx.x == 0) (void)xb_add(&bar[XB_XCNT(b.x)], 1u);
    return b;
}
__device__ __forceinline__ void xcd_barrier_complete(unsigned* bar, unsigned x, unsigned& nloc, unsigned& nx) {
    const unsigned G = gridDim.x * gridDim.y * gridDim.z;
    unsigned sum, cnt, mine, sp = 0u;
    for (;;) {
        sum = 0u; cnt = 0u; mine = 0u;
#pragma unroll
        for (unsigned j = 0; j < 16; ++j) { const unsigned c = xb_ld(&bar[XB_XCNT(j)]); sum += c; cnt += (c > 0u) ? 1u : 0u; mine = (j == x) ? c : mine; }
        if (sum == G) break;
        __builtin_amdgcn_s_sleep(1);
        if ((++sp & 255u) == 0u) { if (xb_ld(&bar[XB_TMO])) break; if (sp > XB_SPIN_CAP) { atomicAdd(&bar[XB_TMO], 1u); break; } }
    }
    nloc = mine > 0u ? mine : 1u; nx = cnt > 0u ? cnt : 1u;
}

__device__ __forceinline__ void xcd_barrier(const XcdBarrier& b) {
    asm volatile("s_waitcnt vmcnt(0)" ::: "memory");
    __syncthreads();
    if (threadIdx.x == 0) {
        unsigned* bar = b.bar;
        __builtin_amdgcn_s_waitcnt(0);
        unsigned nloc = b.st[0], nx = b.st[1];
        if (nloc == 0u) { xcd_barrier_complete(bar, b.x, nloc, nx); b.st[0] = nloc; b.st[1] = nx; }
        const unsigned old = xb_add(&bar[XB_XSUB(b.x)], 1u);
        const unsigned gen = old / nloc;
        if (old + 1u == (gen + 1u) * nloc) {
            __builtin_amdgcn_fence(__ATOMIC_RELEASE, "agent");
            asm volatile("s_waitcnt vmcnt(0)" ::: "memory");
            const unsigned og = xb_add(&bar[XB_TOP], 1u);
            const unsigned target = (og / nx + 1u) * nx;
            if (og + 1u != target) XB_SPIN(xb_ld(&bar[XB_TOP]) < target, bar);
            __builtin_amdgcn_fence(__ATOMIC_ACQUIRE, "agent");
            xb_add(&bar[XB_XGEN(b.x)], 1u);
            asm volatile("s_waitcnt vmcnt(0)" ::: "memory");
        } else {
            XB_SPIN(xb_ld(&bar[XB_XGEN(b.x)]) == gen, bar);
            __builtin_amdgcn_fence(__ATOMIC_ACQUIRE, "agent");
            asm volatile("s_waitcnt vmcnt(0)" ::: "memory");
        }
    }
    __syncthreads();
}

__global__ void __launch_bounds__(NTHR, 2) fwd_megakernel(Params p_unused) {
    extern __shared__ __attribute__((aligned(16))) unsigned char lds_raw[];
    {
        volatile LAS unsigned* st = (volatile LAS unsigned*)((LAS unsigned char*)lds_raw + LDS_MISC);
        if (threadIdx.x < 8) st[threadIdx.x] = 0u;
        __syncthreads();
        KP kp0 = (KP)__builtin_amdgcn_kernarg_segment_ptr();
        (void)xcd_barrier_post((unsigned*)(kp0->ws + WS_CTL), st);
    }
#define GRID_SYNC() do { KP kpb = (KP)__builtin_amdgcn_kernarg_segment_ptr(); asm volatile("" : "+s"(kpb) :: "memory"); XcdBarrier bb; bb.bar = (unsigned*)(kpb->ws + WS_CTL); bb.x = xb_xcc_id(); \
        bb.st = (volatile LAS unsigned*)((LAS unsigned char*)lds_raw + LDS_MISC); xcd_barrier(bb); } while (0)
#define ENV() Params p; Ctx C; env(p, C, lds_raw); unsigned char* ws = p.ws; LAS unsigned char* ring = C.lds; (void)ws; (void)ring

    { ENV(); ph0_prologue(C, p); }
    GRID_SYNC();
    { ENV(); ph_modulate0(C, p); }
    GRID_SYNC();
    {
        ENV();
        pg8::Gemm g{(const pg8::bf16_t*)(ws + WS_XN), (const pg8::bf16_t*)(ws + WS_WABIN), NROW, 1280, 1024}; pg8::StaticOrder S; S.init(NROW, 1280, C.G, (int)blockIdx.x);
        pg8::EpiStoreBf16 E{(pg8::bf16_t*)(ws + WS_P), 1280, 0, nullptr};
        pg8::gemm_phase<pg8::EpiStoreBf16, pg8::StaticOrder, true, true>(ring, g, S, E);
    }
    { ENV(); convert_slot(C, p, 0, (int)blockIdx.x); }
    GRID_SYNC();
    { ENV(); ph_post0(C, p); }
    GRID_SYNC();
    { ENV(); ph_attn_dense(C, p, lds_raw); }
    GRID_SYNC();
    {
        ENV();
        pg8::Gemm g{(const pg8::bf16_t*)(ws + WS_CAT), (const pg8::bf16_t*)(ws + WS_WABOUT), NROW, 1024, 1024}; pg8::StaticOrder S; S.init(NROW, 1024, C.G, (int)blockIdx.x);
        pg8::EpiResid<false> E{p.in[0], p.in[2], (const float*)(ws + WS_MOD), 2, (pg8::bf16_t*)(ws + WS_X1)};
        pg8::gemm_phase<pg8::EpiResid<false>, pg8::StaticOrder, true, true>(ring, g, S, E);
    }
    { ENV(); convert_slot(C, p, 1, (int)blockIdx.x); }
    GRID_SYNC();
    { ENV(); ph_ffn_norm_router(C, p, 0, NROW); }
    GRID_SYNC();
    { ENV(); ph_select(C, p, 4, 2304); }
    { ENV(); convert_slot(C, p, 2, C.vcu); }
    GRID_SYNC();
    {
        ENV();
        pg8::Gemm g{(const pg8::bf16_t*)(ws + WS_XN), (const pg8::bf16_t*)(ws + WS_WGU), NEXP * 2304, NEXP * 4096, 512}; pg8::MoeOrder S; S.init(9, 16, NEXP, C.G, C.vcu);
        LAS unsigned* gtab = (LAS unsigned*)(C.lds + 131072);
        { const int* IDX = (const int*)(ws + WS_IDX); pg8::Unit u; for (int i = 0; S.next(i, u); ++i) if (C.tid < 256) gtab[i * 256 + C.tid] = (unsigned)IDX[u.pm * 256 + C.tid] * 1024u; }
        __syncthreads();
        pg8::EpiSwiGLU8 E{(unsigned char*)(ws + WS_ACT), WINV};
        pg8::gemm_phase<pg8::EpiSwiGLU8, pg8::MoeOrder, true, true, true, true>(ring, g, S, E, gtab);
    }
    GRID_SYNC();
    {
        ENV();
        pg8::Gemm g{(const pg8::bf16_t*)(ws + WS_ACT), (const pg8::bf16_t*)(ws + WS_WD), NEXP * 2304, NEXP * 1024, 1024}; pg8::MoeOrder S; S.init(9, 4, NEXP, C.G, C.vcu);
        pg8::EpiDown E{(pg8::bf16_t*)(ws + WS_XS), (const float*)(ws + WS_GATEV), WINV};
        pg8::gemm_phase<pg8::EpiDown, pg8::MoeOrder, true, true, true>(ring, g, S, E);
    }
    { ENV(); convert_slot(C, p, 3, C.vcu); }
    GRID_SYNC();
    { ENV(); ph_combine(C, p, 0, NROW, 2304); }
    GRID_SYNC();
    {
        ENV();
        pg8::Gemm g{(const pg8::bf16_t*)(ws + WS_XN), (const pg8::bf16_t*)(ws + WS_WCDIN), NROW, 2304, 1024}; pg8::StaticOrder S; S.init(NROW, 2304, C.G, (int)blockIdx.x);
        pg8::EpiStoreBf16 E{(pg8::bf16_t*)(ws + WS_P), 2304, 0, nullptr};
        pg8::gemm_phase<pg8::EpiStoreBf16, pg8::StaticOrder, true, true>(ring, g, S, E);
    }
    { ENV(); convert_slot(C, p, 4, (int)blockIdx.x); }
    GRID_SYNC();
    { ENV(); ph_post1(C, p); }
    GRID_SYNC();
    { ENV(); ph_ret_chunk_states(C, p); }
    GRID_SYNC();
    { ENV(); ph_ret_scan(C, p); }
    GRID_SYNC();
    { ENV(); ph_ret_output(C, p); }
    { ENV(); ph_attn_window(C, p, lds_raw); }
    GRID_SYNC();
    {
        ENV();
        pg8::Gemm g{(const pg8::bf16_t*)(ws + WS_CAT), (const pg8::bf16_t*)(ws + WS_WCDOUT), NLAT, 1024, 1024}; pg8::StaticOrder S; S.init(NLAT, 1024, C.G, (int)blockIdx.x);
        pg8::EpiResid<true> E{(const void*)(ws + WS_X2), (const void*)((const pg8::bf16_t*)(ws + WS_X2) + (size_t)NLAT * DM), (const float*)(ws + WS_MOD) + 3 * 6144, 2, (pg8::bf16_t*)(ws + WS_X1)};
        pg8::gemm_phase<pg8::EpiResid<true>, pg8::StaticOrder, true, true>(ring, g, S, E);
    }
    GRID_SYNC();
    { ENV(); ph_ffn_norm_router(C, p, 1, NLAT); }
    GRID_SYNC();
    { ENV(); ph_select(C, p, 2, 2048); }
    { ENV(); convert_slot(C, p, 5, C.vcu); }
    GRID_SYNC();
    {
        ENV();
        pg8::Gemm g{(const pg8::bf16_t*)(ws + WS_XN), (const pg8::bf16_t*)(ws + WS_WGU + (size_t)NEXP * 4096 * 1024), NEXP * 2048, NEXP * 4096, 512}; pg8::MoeOrder S; S.init(8, 16, NEXP, C.G, C.vcu);
        LAS unsigned* gtab = (LAS unsigned*)(C.lds + 131072);
        { const int* IDX = (const int*)(ws + WS_IDX); pg8::Unit u; for (int i = 0; S.next(i, u); ++i) if (C.tid < 256) gtab[i * 256 + C.tid] = (unsigned)IDX[u.pm * 256 + C.tid] * 1024u; }
        __syncthreads();
        pg8::EpiSwiGLU8 E{(unsigned char*)(ws + WS_ACT), WINV};
        pg8::gemm_phase<pg8::EpiSwiGLU8, pg8::MoeOrder, true, true, true, true>(ring, g, S, E, gtab);
    }
    GRID_SYNC();
    {
        ENV();
        pg8::Gemm g{(const pg8::bf16_t*)(ws + WS_ACT), (const pg8::bf16_t*)(ws + WS_WD + (size_t)NEXP * 1024 * 2048), NEXP * 2048, NEXP * 1024, 1024}; pg8::MoeOrder S; S.init(8, 4, NEXP, C.G, C.vcu);
        pg8::EpiDown E{(pg8::bf16_t*)(ws + WS_XS), (const float*)(ws + WS_GATEV), WINV};
        pg8::gemm_phase<pg8::EpiDown, pg8::MoeOrder, true, true, true>(ring, g, S, E);
    }
    GRID_SYNC();
    { ENV(); ph_combine(C, p, 1, NLAT, 2048); }
}

extern "C" void kernel_launch(void* const* d_in, const int* in_sizes, int n_in, void* d_out, int out_size, void* d_ws, size_t ws_size, hipStream_t stream) {
    static int grid = 0;
    if (grid == 0) {
        if (n_in != 25 || ws_size < WS_END) { fprintf(stderr, "kernel_launch: unexpected inputs (n_in %d, ws %zu)\n", n_in, ws_size); grid = -1; return; }
        int dev = 0, cus = 0, per_cu = 0;
        if (hipGetDevice(&dev) != hipSuccess || hipDeviceGetAttribute(&cus, hipDeviceAttributeMultiprocessorCount, dev) != hipSuccess) { grid = -1; return; }
        if (hipFuncSetAttribute((const void*)fwd_megakernel, hipFuncAttributeMaxDynamicSharedMemorySize, LDS_BYTES) != hipSuccess) { fprintf(stderr, "kernel_launch: hipFuncSetAttribute failed\n"); grid = -1; return; }
        if (hipOccupancyMaxActiveBlocksPerMultiprocessor(&per_cu, (const void*)fwd_megakernel, NTHR, LDS_BYTES) != hipSuccess || per_cu < 1) { fprintf(stderr, "kernel_launch: occupancy query says %d\n", per_cu); (void)hipGetLastError(); grid = -1; return; }
        grid = cus;
    }
    if (grid < 0) return;
    if (hipMemsetAsync((char*)d_ws + WS_CTL, 0, CTL_BYTES, stream) != hipSuccess) { fprintf(stderr, "kernel_launch: hipMemsetAsync failed\n"); return; }
    Params prm{};
    for (int i = 0; i < 25; ++i) prm.in[i] = (const float*)d_in[i];
    prm.out = (float*)d_out; prm.ws = (unsigned char*)d_ws; prm.pad = 0ull;
    void* args[] = {&prm};
    hipError_t e = hipLaunchCooperativeKernel((const void*)fwd_megakernel, dim3(grid), dim3(NTHR), args, LDS_BYTES, stream);
    if (e != hipSuccess) fprintf(stderr, "kernel_launch: cooperative launch failed: %s (grid %d)\n", hipGetErrorString(e), grid);
}
```

```cpp
#include <hip/hip_runtime.h>
#include <hip/hip_bf16.h>
#include <cmath>
#include <cstdio>
#include <cstdint>
namespace pg8 {
#define PG8_LAS __attribute__((address_space(3)))
typedef unsigned short bf16_t;
typedef short bf16x8 __attribute__((ext_vector_type(8)));
typedef float f32x4 __attribute__((ext_vector_type(4)));
typedef unsigned u32x4 __attribute__((ext_vector_type(4)));
constexpr int BM = 256, BK = 64, HALF = 128, HTB = HALF * BK * 2  , STAGE_BYTES = 8 * HTB, NXCD = 8, WGM = 8;

__host__ __device__ __forceinline__ int lds_byte(int r, int c) { const int st = (r >> 4) * 2 + (c >> 5), rr = r & 15, cc = c & 31, ob = rr * 64 + cc * 2; return st * 1024 + (ob ^ (((ob >> 9) & 1) << 5)); }
__host__ __device__ __forceinline__ void stage_rc(int b, int& R, int& C) { const int st = b / 1024, sb = b % 1024, swz = sb ^ (((sb >> 9) & 1) << 5); R = (st >> 1) * 16 + swz / 64; C = (st & 1) * 32 + (swz % 64) / 2; }
__host__ __device__ __forceinline__ int perm32(int rho) { const int n = rho >> 4, i = rho & 15; return 8 * (i >> 2) + 4 * n + (i & 3); }

struct Unit { int pm, pn; };
struct Gemm { const bf16_t* A; const bf16_t* Bt; int M, N, K; };

struct StaticOrder {
    int nM, nN, nwg, G, c;
    __host__ __device__ void init(int M, int N, int G_, int c_) { nM = M / BM; nN = N / BM; nwg = nM * nN; G = G_; c = c_; }
    __host__ __device__ bool next(int i, Unit& u) const {
        const long L = (long)i * G + c; if (L >= nwg) return false;
        int wgid = (int)L; { const int q = nwg / NXCD, r = nwg % NXCD, xcd = wgid % NXCD, off = wgid / NXCD; wgid = (xcd < r ? xcd * (q + 1) : r * (q + 1) + (xcd - r) * q) + off; }
        const int nig = WGM * nN, gid = wgid / nig, fm = gid * WGM, gsz = (nM - fm) < WGM ? (nM - fm) : WGM;
        u.pm = fm + ((wgid % nig) % gsz); u.pn = (wgid % nig) / gsz; return true;
    }
    __device__ __forceinline__ void a_ready(const Unit&) const {}
    __device__ __forceinline__ void done(const Unit&) const {}
    __device__ __forceinline__ bool half(const Unit&) const { return false; }
};

__device__ __forceinline__ unsigned cvt_pk_bf16(float lo, float hi) { unsigned r; asm volatile("v_cvt_pk_bf16_f32 %0, %1, %2" : "=v"(r) : "v"(lo), "v"(hi)); return r; }
typedef float f32x2e __attribute__((ext_vector_type(2)));
typedef __bf16 bf16x2e __attribute__((ext_vector_type(2)));
__device__ __forceinline__ unsigned cvtpk_e(float lo, float hi) { f32x2e v = {lo, hi}; bf16x2e b = __builtin_convertvector(v, bf16x2e); return __builtin_bit_cast(unsigned, b); }
__device__ __forceinline__ u32x4 pack8(const f32x4 a, const f32x4 b) { u32x4 w; w.x = cvtpk_e(a[0], a[1]); w.y = cvtpk_e(a[2], a[3]); w.z = cvtpk_e(b[0], b[1]); w.w = cvtpk_e(b[2], b[3]); return w; }

struct EpiStoreBf16 {
    static constexpr bool PERM = true, AFTER_DRAIN = false;
    bf16_t* O; int ldc; int ocol0; const float* colscale; float sc;
    __device__ __forceinline__ void operator()(const f32x4 (&acc)[2][2][4][2], const Unit& u, int wr, int wc, int fr, int fq) const {
        const int row0 = u.pm * BM + wr * 64 + fr, col0 = u.pn * BM + wc * 32 + 8 * fq;
        f32x4 cs[2][2];
#pragma unroll
        for (int bj = 0; bj < 2; ++bj)
#pragma unroll
            for (int n = 0; n < 2; ++n) cs[bj][n] = colscale ? *(const f32x4*)(colscale + col0 + bj * HALF + 4 * n) : (f32x4){sc, sc, sc, sc};
#pragma unroll
        for (int ai = 0; ai < 2; ++ai)
#pragma unroll
            for (int m = 0; m < 4; ++m) { bf16_t* rowp = O + (size_t)(row0 + ai * HALF + m * 16) * ldc + ocol0 + col0;
#pragma unroll
                for (int bj = 0; bj < 2; ++bj) *(u32x4*)(rowp + bj * HALF) = pack8(acc[ai][bj][m][0] * cs[bj][0], acc[ai][bj][m][1] * cs[bj][1]); }
    }
};

template <bool SRC_BF16> struct EpiResid {
    static constexpr bool PERM = true, AFTER_DRAIN = false;
    const void* xlat; const void* xctx; const float* modl; int chunk; bf16_t* out;
    __device__ __forceinline__ void load_group(const float* srcf, const bf16_t* srch, size_t off, f32x4 (&xv)[2][2]) const {
#pragma unroll
        for (int bj = 0; bj < 2; ++bj) {
            if (SRC_BF16) { const u32x4 w = __builtin_nontemporal_load((const u32x4*)(srch + off + bj * HALF));
                xv[bj][0] = (f32x4){__uint_as_float(w.x << 16), __uint_as_float(w.x & 0xffff0000u), __uint_as_float(w.y << 16), __uint_as_float(w.y & 0xffff0000u)};
                xv[bj][1] = (f32x4){__uint_as_float(w.z << 16), __uint_as_float(w.z & 0xffff0000u), __uint_as_float(w.w << 16), __uint_as_float(w.w & 0xffff0000u)}; }
            else { xv[bj][0] = __builtin_nontemporal_load((const f32x4*)(srcf + off + bj * HALF)); xv[bj][1] = __builtin_nontemporal_load((const f32x4*)(srcf + off + bj * HALF + 4)); } }
    }
    __device__ __forceinline__ void operator()(const f32x4 (&acc)[2][2][4][2], const Unit& u, int wr, int wc, int fr, int fq) const {
        const int pm = u.pm; const int mi = pm < 64 ? (pm >> 5) : 2;
        const float* g = modl + mi * 6144 + chunk * 1024;
        const size_t rowoff = pm < 64 ? (size_t)pm * 256 * 1024 : (size_t)(pm - 64) * 256 * 1024;
        const float* srcf = (const float*)(pm < 64 ? xlat : xctx) + (SRC_BF16 ? 0 : rowoff);
        const bf16_t* srch = (const bf16_t*)(pm < 64 ? xlat : xctx) + (SRC_BF16 ? rowoff : 0);
        bf16_t* dst = out + (size_t)pm * 256 * 1024;
        const int rl = wr * 64 + fr, col0 = u.pn * BM + wc * 32 + 8 * fq;
        f32x4 gv[2][2];
#pragma unroll
        for (int bj = 0; bj < 2; ++bj)
#pragma unroll
            for (int n = 0; n < 2; ++n) gv[bj][n] = *(const f32x4*)(g + col0 + bj * HALF + 4 * n);
        f32x4 xa[2][2], xb[2][2];
        load_group(srcf, srch, (size_t)rl * 1024 + col0, xa);
#define EPIRESID_STEP(q, XC, XN) do { const int ai = (q) >> 2, m = (q) & 3; const size_t off = (size_t)(rl + ai * HALF + m * 16) * 1024 + col0; \
            if ((q) < 7) { const int ai2 = ((q) + 1) >> 2, m2 = ((q) + 1) & 3; load_group(srcf, srch, (size_t)(rl + ai2 * HALF + m2 * 16) * 1024 + col0, XN); } \
            _Pragma("unroll") for (int bj = 0; bj < 2; ++bj) { const f32x4 o0 = XC[bj][0] + gv[bj][0] * acc[ai][bj][m][0], o1 = XC[bj][1] + gv[bj][1] * acc[ai][bj][m][1]; \
                *(u32x4*)(dst + off + bj * HALF) = pack8(o0, o1); } } while (0)
        EPIRESID_STEP(0, xa, xb); EPIRESID_STEP(1, xb, xa); EPIRESID_STEP(2, xa, xb); EPIRESID_STEP(3, xb, xa);
        EPIRESID_STEP(4, xa, xb); EPIRESID_STEP(5, xb, xa); EPIRESID_STEP(6, xa, xb); EPIRESID_STEP(7, xb, xa);
#undef EPIRESID_STEP
    }
};

struct EpiSwiGLU {
    static constexpr bool PERM = true, AFTER_DRAIN = false;
    bf16_t* ACT;
    __device__ __forceinline__ void operator()(const f32x4 (&acc)[2][2][4][2], const Unit& u, int wr, int wc, int fr, int fq) const {
        const int row0 = u.pm * BM + wr * 64 + fr, col0 = (u.pn & 15) * 128 + wc * 32 + 8 * fq;
#pragma unroll
        for (int ai = 0; ai < 2; ++ai)
#pragma unroll
            for (int m = 0; m < 4; ++m) { bf16_t* rowp = ACT + (size_t)(row0 + ai * HALF + m * 16) * 2048 + col0;
                f32x4 r[2];
#pragma unroll
                for (int n = 0; n < 2; ++n)
#pragma unroll
                    for (int j = 0; j < 4; ++j) { const float a = acc[ai][0][m][n][j], up = acc[ai][1][m][n][j];
                        const float sg = a * __builtin_amdgcn_rcpf(1.0f + __builtin_amdgcn_exp2f(-1.4426950408889634f * a)); r[n][j] = sg * up; }
                *(u32x4*)rowp = pack8(r[0], r[1]); }
    }
};


__device__ __forceinline__ unsigned pk4_fp8(float a, float b, float c, float d) { unsigned w = 0u; w = __builtin_amdgcn_cvt_pk_fp8_f32(a, b, w, false); w = __builtin_amdgcn_cvt_pk_fp8_f32(c, d, w, true); return w; }
struct EpiSwiGLU8 {
    static constexpr bool PERM = true, AFTER_DRAIN = false;
    unsigned char* ACT; float winv;
    __device__ __forceinline__ void operator()(const f32x4 (&acc)[2][2][4][2], const Unit& u, int wr, int wc, int fr, int fq) const {
        const int row0 = u.pm * BM + wr * 64 + fr, col0 = (u.pn & 15) * 128 + wc * 32 + 8 * fq;
#pragma unroll
        for (int ai = 0; ai < 2; ++ai)
#pragma unroll
            for (int m = 0; m < 4; ++m) { unsigned char* rowp = ACT + (size_t)(row0 + ai * HALF + m * 16) * 2048 + col0;
                float r[8];
#pragma unroll
                for (int n = 0; n < 2; ++n)
#pragma unroll
                    for (int j = 0; j < 4; ++j) { const float a = acc[ai][0][m][n][j] * winv, up = acc[ai][1][m][n][j] * winv;
                        const float sg = a * __builtin_amdgcn_rcpf(1.0f + __builtin_amdgcn_exp2f(-1.4426950408889634f * a)); float v = sg * up; v = fminf(fmaxf(v, -448.f), 448.f); r[4 * n + j] = v; }
                typedef unsigned u32x2 __attribute__((ext_vector_type(2)));
                u32x2 w; w.x = pk4_fp8(r[0], r[1], r[2], r[3]); w.y = pk4_fp8(r[4], r[5], r[6], r[7]);
                *(u32x2*)rowp = w; }
    }
};

struct EpiDown {
    static constexpr bool PERM = true, AFTER_DRAIN = false;
    bf16_t* Y; const float* gatev; float winv;
    __device__ __forceinline__ void operator()(const f32x4 (&acc)[2][2][4][2], const Unit& u, int wr, int wc, int fr, int fq) const {
        const int row0 = u.pm * BM + wr * 64 + fr, col0 = (u.pn & 3) * 256 + wc * 32 + 8 * fq;
#pragma unroll
        for (int ai = 0; ai < 2; ++ai)
#pragma unroll
            for (int m = 0; m < 4; ++m) { const int row = row0 + ai * HALF + m * 16; const float gv = gatev[row] * winv; bf16_t* rowp = Y + (size_t)row * 1024 + col0;
#pragma unroll
                for (int bj = 0; bj < 2; ++bj) *(u32x4*)(rowp + bj * HALF) = pack8(acc[ai][bj][m][0] * gv, acc[ai][bj][m][1] * gv); }
    }
};

struct MoeOrder {
    int nMe, nNe, nwg, G, c;
    __device__ __forceinline__ void init(int nMe_, int nNe_, int nExp, int G_, int c_) { nMe = nMe_; nNe = nNe_; nwg = nMe_ * nNe_ * nExp; G = G_; c = c_; }
    __device__ __forceinline__ bool next(int i, Unit& u) const {
        const int L = i * G + c; if (L >= nwg) return false;
        const int per = nMe * nNe, e = L / per, r = L % per;
        u.pm = e * nMe + (r % nMe); u.pn = e * nNe + (r / nMe); return true;
    }
    __device__ __forceinline__ void a_ready(const Unit&) const {}
    __device__ __forceinline__ void done(const Unit&) const {}
    __device__ __forceinline__ bool half(const Unit& u) const { return nMe == 9 && (u.pm % 9) == 8; }
};
template <class Epi, class Sched, bool ALIGN_EPI = false, bool SP2 = false, bool FP8 = false, bool GATHER = false>
__device__ __forceinline__ void gemm_phase(PG8_LAS unsigned char* lds, const Gemm g, const Sched& S, const Epi& E, const PG8_LAS unsigned* gtab = nullptr) {
    static_assert(!GATHER || SP2, "GATHER is wired into the SP2 loop only");
    int tid_o = threadIdx.x; asm volatile("" : "+v"(tid_o) :: "memory");
    const int tid = tid_o, wid = __builtin_amdgcn_readfirstlane(tid >> 6), lane = tid & 63, wr = wid >> 2, wc = wid & 3, fr = lane & 15, fq = lane >> 4;
    const int K = g.K, nt = K / BK;
    unsigned voffA[2], voffB[2]; int rA[2]; unsigned cofA[2];
    unsigned vofC[2][2] = {{0u, 0u}, {0u, 0u}}, vofN[2][2] = {{0u, 0u}, {0u, 0u}};
#pragma unroll
    for (int i = 0; i < 2; ++i) { int R, C; stage_rc(tid * 16 + i * 8192, R, C); const int Rb = Epi::PERM ? ((R & ~31) + perm32(R & 31)) : R;
        voffA[i] = (unsigned)(R * K + C) * 2u; voffB[i] = (unsigned)(Rb * K + C) * 2u; rA[i] = R; cofA[i] = (unsigned)C * 2u; }
    const size_t kstep = (size_t)(BK * 2);
    const size_t hstep = (size_t)HALF * K * 2;
    const size_t tstep = 2 * hstep;
    const unsigned ldsw = (unsigned)wid * 1024u;
    const int aoff = lds_byte(wr * 64 + fr, fq * 8), boff = lds_byte(wc * 32 + fr, fq * 8);
#define PG8_SA(b, h) (((b) * 2 + (h)) * HTB)
#define PG8_SB(b, h) ((4 + (b) * 2 + (h)) * HTB)
#define PG8_STAGE(bufoff, gbase, voff) do { _Pragma("unroll") for (int _i = 0; _i < 2; ++_i) \
        __builtin_amdgcn_global_load_lds((const unsigned*)((const char*)(gbase) + (voff)[_i]), (PG8_LAS unsigned*)(lds + (bufoff) + ldsw + _i * 8192), 16, 0, 0); } while (0)
#define PG8_STAGE_A(bufoff, gbase, h, usenext) do { if constexpr (GATHER) { const unsigned vg_[2] = {(usenext) ? vofN[h][0] : vofC[h][0], (usenext) ? vofN[h][1] : vofC[h][1]}; PG8_STAGE(bufoff, gbase, vg_); } \
        else { PG8_STAGE(bufoff, (gbase) + (h) * hstep, voffA); } } while (0)
#define PG8_GTAB(dst, u_) do { _Pragma("unroll") for (int h_ = 0; h_ < 2; ++h_) _Pragma("unroll") for (int i_ = 0; i_ < 2; ++i_) dst[h_][i_] = gtab[(u_) * 256 + h_ * 128 + rA[i_]] + cofA[i_]; } while (0)
#define PG8_LDA(dst, b, h) do { if constexpr (FP8) { _Pragma("unroll") for (int m = 0; m < 4; ++m) { const v4i_ lo_ = *(const PG8_LAS v4i_*)(lds + PG8_SA(b, h) + aoff + m * 2048), hi_ = *(const PG8_LAS v4i_*)(lds + PG8_SA(b, h) + aoff + m * 2048 + 1024); dst##8[m] = __builtin_shufflevector(lo_, hi_, 0, 1, 2, 3, 4, 5, 6, 7); } } \
        else { _Pragma("unroll") for (int m = 0; m < 4; ++m) _Pragma("unroll") for (int k = 0; k < 2; ++k) dst[m][k] = *(const PG8_LAS bf16x8*)(lds + PG8_SA(b, h) + aoff + m * 2048 + k * 1024); } } while (0)
#define PG8_LDB(dst, b, h) do { if constexpr (FP8) { _Pragma("unroll") for (int n = 0; n < 2; ++n) { const v4i_ lo_ = *(const PG8_LAS v4i_*)(lds + PG8_SB(b, h) + boff + n * 2048), hi_ = *(const PG8_LAS v4i_*)(lds + PG8_SB(b, h) + boff + n * 2048 + 1024); dst##8[n] = __builtin_shufflevector(lo_, hi_, 0, 1, 2, 3, 4, 5, 6, 7); } } \
        else { _Pragma("unroll") for (int n = 0; n < 2; ++n) _Pragma("unroll") for (int k = 0; k < 2; ++k) dst[n][k] = *(const PG8_LAS bf16x8*)(lds + PG8_SB(b, h) + boff + n * 2048 + k * 1024); } } while (0)
#define PG8_MMA(ai, bj, At, Bt) do { __builtin_amdgcn_s_setprio(1); _Pragma("unroll") for (int m = 0; m < 4; ++m) _Pragma("unroll") for (int n = 0; n < 2; ++n) { \
        if constexpr (FP8) { asm volatile("v_mfma_f32_16x16x128_f8f6f4 %0, %1, %2, %0" : "+v"(acc[ai][bj][m][n]) : "v"(Bt##8[n]), "v"(At##8[m])); } \
        else { _Pragma("unroll") for (int k = 0; k < 2; ++k) acc[ai][bj][m][n] = __builtin_amdgcn_mfma_f32_16x16x32_bf16(Bt[n][k], At[m][k], acc[ai][bj][m][n], 0, 0, 0); } } \
        __builtin_amdgcn_s_setprio(0); } while (0)
#define PG8_WAIT_V(n) asm volatile("s_waitcnt vmcnt(" #n ")" ::: "memory")
#define PG8_WAIT_L(n) asm volatile("s_waitcnt lgkmcnt(" #n ")" ::: "memory")
#define PG8_BAR __builtin_amdgcn_s_barrier()
#define PG8_SCHED __builtin_amdgcn_sched_barrier(0)
    Unit cur, nxt; int ui = 0;
    if (!S.next(0, cur)) return;
    f32x4 acc[2][2][4][2];
#pragma unroll
    for (int a = 0; a < 2; ++a)
#pragma unroll
        for (int b = 0; b < 2; ++b)
#pragma unroll
            for (int m = 0; m < 4; ++m)
#pragma unroll
                for (int n = 0; n < 2; ++n) acc[a][b][m][n] = (f32x4){0.f, 0.f, 0.f, 0.f};
    typedef int v4i_ __attribute__((ext_vector_type(4))); typedef int v8i_ __attribute__((ext_vector_type(8)));
    bf16x8 At[4][2], B0[2][2], B1[2][2];
    v8i_ At8[4], B08[2], B18[2];
    const char* cA = (const char*)g.A + (GATHER ? (size_t)0 : (size_t)cur.pm * tstep); const char* cB = (const char*)g.Bt + (size_t)cur.pn * tstep;
    if constexpr (GATHER) PG8_GTAB(vofC, 0);
    S.a_ready(cur);
    if constexpr (SP2) {
        PG8_STAGE(PG8_SB(0, 0), cB, voffB); PG8_STAGE(PG8_SB(0, 1), cB + hstep, voffB); PG8_STAGE_A(PG8_SA(0, 0), cA, 0, false); PG8_STAGE_A(PG8_SA(0, 1), cA, 1, false);
        if (wr == 1) PG8_BAR;
        PG8_WAIT_V(2); PG8_BAR;
        PG8_STAGE(PG8_SB(1, 0), cB + kstep, voffB); PG8_STAGE_A(PG8_SA(1, 0), cA + kstep, 0, false); PG8_STAGE(PG8_SB(1, 1), cB + hstep + kstep, voffB);
        PG8_WAIT_V(6); PG8_BAR;
    } else {
        PG8_STAGE(PG8_SB(0, 0), cB, voffB); PG8_STAGE(PG8_SA(0, 0), cA, voffA); PG8_STAGE(PG8_SB(0, 1), cB + hstep, voffB); PG8_STAGE(PG8_SA(0, 1), cA + hstep, voffA);
        if (wr == 1) PG8_BAR;
        PG8_WAIT_V(4); PG8_BAR;
        PG8_STAGE(PG8_SB(1, 0), cB + kstep, voffB); PG8_STAGE(PG8_SA(1, 0), cA + kstep, voffA); PG8_STAGE(PG8_SB(1, 1), cB + hstep + kstep, voffB);
        PG8_WAIT_V(6); PG8_BAR;
    }
    bool halfu = S.half(cur);
    for (;;) {
        const bool has_next = S.next(ui + 1, nxt);
        if constexpr (GATHER) { if (has_next) PG8_GTAB(vofN, ui + 1); else { vofN[0][0] = vofC[0][0]; vofN[0][1] = vofC[0][1]; vofN[1][0] = vofC[1][0]; vofN[1][1] = vofC[1][1]; } }
        const char* nA = (has_next && !GATHER) ? (const char*)g.A + (size_t)nxt.pm * tstep : cA; const char* nB = has_next ? (const char*)g.Bt + (size_t)nxt.pn * tstep : cB;
        for (int t = 0; t < nt; t += 2) {
            const bool last = (t == nt - 2);
            const char* a1 = cA + (size_t)(t + 1) * kstep;
            const char* a2 = last ? nA : cA + (size_t)(t + 2) * kstep; const char* b2 = last ? nB : cB + (size_t)(t + 2) * kstep;
            const char* a3 = a2 + kstep; const char* b3 = b2 + kstep;
            if (last && has_next) S.a_ready(nxt);
            if constexpr (SP2) {
            PG8_LDB(B0, 0, 0); PG8_LDB(B1, 0, 1); PG8_SCHED; PG8_LDA(At, 0, 0); PG8_STAGE_A(PG8_SA(1, 1), a1, 1, false);
            PG8_WAIT_V(8); PG8_WAIT_L(0); PG8_BAR; if (!(halfu && wr == 1)) { PG8_MMA(0, 0, At, B0); PG8_MMA(0, 1, At, B1); } PG8_BAR; PG8_SCHED;
            PG8_LDA(At, 0, 1); PG8_STAGE(PG8_SB(0, 0), b2, voffB); PG8_STAGE(PG8_SB(0, 1), b2 + hstep, voffB); PG8_STAGE_A(PG8_SA(0, 0), a2, 0, last);
            PG8_WAIT_V(8); PG8_WAIT_L(0); PG8_BAR; if (!halfu) { PG8_MMA(1, 0, At, B0); PG8_MMA(1, 1, At, B1); } PG8_BAR; PG8_SCHED;
            PG8_LDB(B0, 1, 0); PG8_LDB(B1, 1, 1); PG8_SCHED; PG8_LDA(At, 1, 0); PG8_STAGE_A(PG8_SA(0, 1), a2, 1, last);
            PG8_WAIT_V(8); PG8_WAIT_L(0); PG8_BAR; if (!(halfu && wr == 1)) { PG8_MMA(0, 0, At, B0); PG8_MMA(0, 1, At, B1); } PG8_BAR; PG8_SCHED;
            PG8_LDA(At, 1, 1); PG8_STAGE(PG8_SB(1, 0), b3, voffB); PG8_STAGE(PG8_SB(1, 1), b3 + hstep, voffB); PG8_STAGE_A(PG8_SA(1, 0), a3, 0, last);
            PG8_WAIT_V(8); PG8_WAIT_L(0); PG8_BAR; if (!halfu) { PG8_MMA(1, 0, At, B0); PG8_MMA(1, 1, At, B1); } PG8_BAR; PG8_SCHED;
            } else {
            PG8_LDB(B0, 0, 0); PG8_SCHED; PG8_LDA(At, 0, 0); PG8_STAGE(PG8_SA(1, 1), a1 + hstep, voffA);
            PG8_WAIT_L(8); PG8_BAR; PG8_WAIT_L(0); PG8_MMA(0, 0, At, B0); PG8_BAR; PG8_SCHED;
            PG8_LDB(B1, 0, 1); PG8_STAGE(PG8_SB(0, 0), b2, voffB);
            PG8_BAR; PG8_WAIT_L(0); PG8_MMA(0, 1, At, B1); PG8_BAR;
            PG8_LDA(At, 0, 1); PG8_STAGE(PG8_SA(0, 0), a2, voffA);
            PG8_BAR; PG8_WAIT_L(0); PG8_MMA(1, 0, At, B0); PG8_BAR; PG8_SCHED;
            PG8_STAGE(PG8_SB(0, 1), b2 + hstep, voffB);
            PG8_WAIT_V(6); PG8_BAR; PG8_MMA(1, 1, At, B1); PG8_BAR;
            PG8_LDB(B0, 1, 0); PG8_SCHED; PG8_LDA(At, 1, 0); PG8_STAGE(PG8_SA(0, 1), a2 + hstep, voffA);
            PG8_WAIT_L(8); PG8_BAR; PG8_WAIT_L(0); PG8_MMA(0, 0, At, B0); PG8_BAR; PG8_SCHED;
            PG8_LDB(B1, 1, 1); PG8_STAGE(PG8_SB(1, 0), b3, voffB);
            PG8_BAR; PG8_WAIT_L(0); PG8_MMA(0, 1, At, B1); PG8_BAR;
            PG8_LDA(At, 1, 1); PG8_STAGE(PG8_SA(1, 0), a3, voffA);
            PG8_BAR; PG8_WAIT_L(0); PG8_MMA(1, 0, At, B0); PG8_BAR; PG8_SCHED;
            PG8_STAGE(PG8_SB(1, 1), b3 + hstep, voffB);
            PG8_WAIT_V(6); PG8_BAR; PG8_MMA(1, 1, At, B1); PG8_BAR;
            }
        }
        if constexpr (FP8) {
            asm volatile("s_nop 15\n\ts_nop 15" ::: "memory");
#pragma unroll
            for (int a = 0; a < 2; ++a)
#pragma unroll
                for (int b = 0; b < 2; ++b)
#pragma unroll
                    for (int m = 0; m < 4; ++m)
#pragma unroll
                        for (int n = 0; n < 2; ++n) asm volatile("" : "+v"(acc[a][b][m][n]));
        }
        if constexpr (ALIGN_EPI) { if (wr == 0) PG8_BAR; }
        if constexpr (!Epi::AFTER_DRAIN) { E(acc, cur, wr, wc, fr, fq); S.done(cur); }
        if (!has_next) break;
#pragma unroll
        for (int a = 0; a < 2; ++a)
#pragma unroll
            for (int b = 0; b < 2; ++b)
#pragma unroll
                for (int m = 0; m < 4; ++m)
#pragma unroll
                    for (int n = 0; n < 2; ++n) acc[a][b][m][n] = (f32x4){0.f, 0.f, 0.f, 0.f};
        cur = nxt; cA = nA; cB = nB; ++ui; halfu = S.half(cur);
        if constexpr (GATHER) { vofC[0][0] = vofN[0][0]; vofC[0][1] = vofN[0][1]; vofC[1][0] = vofN[1][0]; vofC[1][1] = vofN[1][1]; }
        if constexpr (ALIGN_EPI) { if (wr == 1) PG8_BAR; }
    }
    PG8_WAIT_V(0);
    if constexpr (!ALIGN_EPI) { if (wr == 0) PG8_BAR; }
    PG8_BAR;
    if constexpr (Epi::AFTER_DRAIN) { E.fused(acc, cur, wr, wc, fr, fq, lds, wid, lane); S.done(cur); }
#undef PG8_SA
#undef PG8_SB
#undef PG8_STAGE
#undef PG8_STAGE_A
#undef PG8_GTAB
#undef PG8_LDA
#undef PG8_LDB
#undef PG8_MMA
#undef PG8_WAIT_V
#undef PG8_WAIT_L
#undef PG8_BAR
#undef PG8_SCHED
}
}
namespace attn_body {
using bf16=__hip_bfloat16;
using bf16x8=__attribute__((ext_vector_type(8)))short;
using s16x4=__attribute__((ext_vector_type(4)))short;
using f32x16=__attribute__((ext_vector_type(16)))float;
using u32x4=__attribute__((ext_vector_type(4)))unsigned;
constexpr int D=64;
constexpr int NW=8,QBLK=32,QB=QBLK*NW,KVBLK=64;
constexpr int ATTN_UNIT_ROWS=QB;
__device__ __forceinline__ int crow(int r,int hi){return (r&3)+8*(r>>2)+4*hi;}
#define SBAR() __builtin_amdgcn_sched_barrier(0)
__device__ __forceinline__ void cmask(f32x16&p0,f32x16&p1,int jb,int qrel,int hi){
  const float NEG=-INFINITY; int kb=64*jb+4*hi;
  #pragma unroll
  for(int r=0;r<16;++r){int kv=kb+(r&3)+8*(r>>2); if(kv>qrel)p0[r]=NEG; if(kv+32>qrel)p1[r]=NEG;}
}

constexpr int NSLOT=3, SLOTB=8192;
constexpr int LDS_K=0, LDS_V=NSLOT*SLOTB, LDS_WS=2*NSLOT*SLOTB, LDS_OST=LDS_WS+NW*64*4, LDS_BYTES=LDS_OST+NW*4096;
constexpr float C2=0.125f*1.4426950408889634f;
__device__ __forceinline__ void glds16(const void*gsrc,unsigned lds_dst){unsigned keep;
  asm volatile("s_mov_b32 %0, m0\n\ts_mov_b32 m0, %2\n\ts_nop 0\n\tglobal_load_lds_dwordx4 %1, off\n\ts_mov_b32 m0, %0":"=&s"(keep):"v"(gsrc),"s"(lds_dst):"memory");}
__device__ __forceinline__ float max3f(float a,float b,float c){float r;asm("v_max3_f32 %0, %1, %2, %3":"=v"(r):"v"(a),"v"(b),"v"(c));return r;}
__device__ __forceinline__ float max2f(float a,float b){float r;asm("v_max_f32_e32 %0, %1, %2":"=v"(r):"v"(a),"v"(b));return r;}
__device__ __forceinline__ float fadd_s(float a,float b){float r;asm("v_add_f32_e32 %0, %1, %2":"=v"(r):"v"(a),"v"(b));return r;}
__device__ __forceinline__ float fsub_s(float a,float b){float r;asm("v_sub_f32_e32 %0, %1, %2":"=v"(r):"v"(a),"v"(b));return r;}
typedef float f32x2_t __attribute__((ext_vector_type(2))); typedef __bf16 bf16x2_t __attribute__((ext_vector_type(2)));
__device__ __forceinline__ unsigned cvtpk_s(float lo,float hi){f32x2_t v={lo,hi};bf16x2_t b=__builtin_convertvector(v,bf16x2_t);return __builtin_bit_cast(unsigned,b);}
#define WAIT_BAR(N) asm volatile("s_waitcnt vmcnt(" #N ") lgkmcnt(0)\n\ts_barrier":::"memory")

__device__ __forceinline__ void qkt(f32x16&p0,f32x16&p1,const char*Kslot,const bf16x8*qr,const f32x16&negm,int r32,int hi){
  const char*kb=Kslot+hi*1024+r32*16;
  #pragma unroll
  for(int d0=0;d0<4;++d0){
    const bf16x8 b0=*reinterpret_cast<const bf16x8*>(kb+d0*2048);
    const bf16x8 b1=*reinterpret_cast<const bf16x8*>(kb+d0*2048+512);
    if(d0==0){p0=__builtin_amdgcn_mfma_f32_32x32x16_bf16(b0,qr[0],negm,0,0,0);p1=__builtin_amdgcn_mfma_f32_32x32x16_bf16(b1,qr[0],negm,0,0,0);}
    else{p0=__builtin_amdgcn_mfma_f32_32x32x16_bf16(b0,qr[d0],p0,0,0,0);p1=__builtin_amdgcn_mfma_f32_32x32x16_bf16(b1,qr[d0],p1,0,0,0);}}
}
typedef __attribute__((address_space(3))) const char* lds_cptr;
typedef short v4i16_t __attribute__((ext_vector_type(4)));
__device__ __forceinline__ void kload8(bf16x8*kf,lds_cptr kp){
  kf[0]=*(const __attribute__((address_space(3))) bf16x8*)(kp);      kf[1]=*(const __attribute__((address_space(3))) bf16x8*)(kp+512);
  kf[2]=*(const __attribute__((address_space(3))) bf16x8*)(kp+2048); kf[3]=*(const __attribute__((address_space(3))) bf16x8*)(kp+2560);
  kf[4]=*(const __attribute__((address_space(3))) bf16x8*)(kp+4096); kf[5]=*(const __attribute__((address_space(3))) bf16x8*)(kp+4608);
  kf[6]=*(const __attribute__((address_space(3))) bf16x8*)(kp+6144); kf[7]=*(const __attribute__((address_space(3))) bf16x8*)(kp+6656);
}
__device__ __forceinline__ void kload2(bf16x8*kf,lds_cptr kp,int j){ kf[2*j]=*(const __attribute__((address_space(3))) bf16x8*)(kp+j*2048); kf[2*j+1]=*(const __attribute__((address_space(3))) bf16x8*)(kp+j*2048+512); }
__device__ __forceinline__ s16x4 vtr(lds_cptr p){ return __builtin_bit_cast(s16x4,__builtin_amdgcn_ds_read_tr16_b64_v4i16((__attribute__((address_space(3))) v4i16_t*)p)); }
__device__ __forceinline__ float rowmax(const f32x16&p0,const f32x16&p1){
  float a=max3f(p0[0],p0[1],p1[0]),b=max3f(p0[2],p0[3],p1[1]);a=max3f(a,p1[2],p1[3]);
  #pragma unroll
  for(int r=4;r<16;r+=4){a=max3f(a,p0[r],p0[r+1]);b=max3f(b,p0[r+2],p0[r+3]);a=max3f(a,p1[r],p1[r+1]);b=max3f(b,p1[r+2],p1[r+3]);}
  const float m=max2f(a,b);
  auto rr=__builtin_amdgcn_permlane32_swap(__float_as_uint(m),__float_as_uint(m),false,false);
  return max2f(__uint_as_float(rr[0]),__uint_as_float(rr[1]));
}
__device__ __forceinline__ void pv(f32x16*o,int vb,bf16x8 pa0,bf16x8 pa1,bf16x8 pa2,bf16x8 pa3){
  #pragma unroll
  for(int d0=0;d0<2;++d0){s16x4 lo[4],hi[4];
    #pragma unroll
    for(int ks=0;ks<4;++ks){
      asm volatile("ds_read_b64_tr_b16 %0,%1 offset:%c2":"=&v"(lo[ks]):"v"(vb),"i"(d0*4096+ks*1024):"memory");
      asm volatile("ds_read_b64_tr_b16 %0,%1 offset:%c2":"=&v"(hi[ks]):"v"(vb),"i"(d0*4096+ks*1024+512):"memory");}
    asm volatile("s_waitcnt lgkmcnt(0)":::"memory");SBAR();
    #define PK(k) (bf16x8){lo[k][0],lo[k][1],lo[k][2],lo[k][3],hi[k][0],hi[k][1],hi[k][2],hi[k][3]}
    o[d0]=__builtin_amdgcn_mfma_f32_32x32x16_bf16(pa0,PK(0),o[d0],0,0,0);
    o[d0]=__builtin_amdgcn_mfma_f32_32x32x16_bf16(pa1,PK(1),o[d0],0,0,0);
    o[d0]=__builtin_amdgcn_mfma_f32_32x32x16_bf16(pa2,PK(2),o[d0],0,0,0);
    o[d0]=__builtin_amdgcn_mfma_f32_32x32x16_bf16(pa3,PK(3),o[d0],0,0,0);
    #undef PK
  }
}

#ifndef ATTN_STORE16
#define ATTN_STORE16(p,v) (*(u32x4*)(p)=(v))
#endif
template<int THRL,bool WIN> __device__ __forceinline__ void attn_unit(const bf16*Qu,int QP,const bf16*__restrict__ Kh,const bf16*__restrict__ Vh,int KP,int NT,bf16*Ou,int OP,char*shm,int gap,int qpos0,float sinkl2){
  const int tid=threadIdx.x,lane=tid&63,r32=lane&31,hi=lane>>5; const int wid=__builtin_amdgcn_readfirstlane(tid>>6);
  const bf16*Qw=Qu+(long)(wid*QBLK)*QP;
  const unsigned lds0=(unsigned)(uintptr_t)shm;
  float*wsf=(float*)(shm+LDS_WS)+wid*64;
  const bf16*ksrc=Kh+(long)lane*KP+wid*8;
  const bf16*vsrc=Vh+(long)(16*(wid&3)+(lane>>2))*KP+(wid>>2)*32+(lane&3)*8;
  const unsigned kdst=lds0+LDS_K+wid*1024, vdst=lds0+LDS_V+wid*1024;
  #define KROW(t) ((long)(t)*KVBLK+((WIN&&(t)>=4)?(long)gap:0L))
  #define DMA_K(t,slot) glds16(ksrc+KROW(t)*KP,(unsigned)__builtin_amdgcn_readfirstlane(kdst+(slot)))
  #define DMA_V(t,slot) glds16(vsrc+KROW(t)*KP,(unsigned)__builtin_amdgcn_readfirstlane(vdst+(slot)))
  const int vb0=(int)(lds0+LDS_V)+((lane>>4)&1)*32+(lane&3)*8+(4*hi+((lane&15)>>2))*64;
  const char*Kbase=shm+LDS_K; bf16x8 kf[8];
  const lds_cptr shm3=(lds_cptr)shm; const lds_cptr kp0=shm3+LDS_K+hi*1024+r32*16; const lds_cptr vp0=shm3+LDS_V+((lane>>4)&1)*32+(lane&3)*8+(4*hi+((lane&15)>>2))*64;
  DMA_K(0,0);DMA_V(0,0);DMA_K(1,SLOTB);
  bf16x8 qr[4];
  #pragma unroll
  for(int d0=0;d0<4;++d0)qr[d0]=*reinterpret_cast<const bf16x8*>(&Qw[(long)r32*QP+d0*16+hi*8]);
  if(__builtin_amdgcn_readfirstlane(threadIdx.x)>=256)__builtin_amdgcn_s_setprio(1);
  float mhat=0.f,l_reg=0.f;f32x16 o[2];o[0]=f32x16{};o[1]=f32x16{};f32x16 negm=f32x16{};asm volatile("":"+v"(negm));
  const int qrel=wid*QBLK+r32;
  #define CMASK(P0,P1,t) do{ if(WIN&&(t)>=4){ const int kb_=gap+64*((t)-4)+4*hi-(qpos0+qrel); _Pragma("unroll") for(int r_=0;r_<16;++r_){ const int df_=kb_+(r_&3)+8*(r_>>2); if(df_>128||df_<-128)P0[r_]=-INFINITY; if(df_+32>128||df_+32<-128)P1[r_]=-INFINITY; } } }while(0)
  bool resc=false;
  #define START(P0,P1) do{ const float rm=rowmax(P0,P1); resc=false; \
    { const float dl=rm; mhat=fadd_s(mhat,dl); \
      _Pragma("unroll") for(int r=0;r<16;++r){P0[r]=fsub_s(P0[r],dl);P1[r]=fsub_s(P1[r],dl);} \
      _Pragma("unroll") for(int r=0;r<16;++r)negm[r]=-mhat; asm volatile("":"+v"(negm)); } \
    _Pragma("unroll") for(int r=0;r<16;++r)P0[r]=__builtin_amdgcn_exp2f(P0[r]); }while(0)
  #define RESC() do{ if(resc){ asm volatile("s_waitcnt lgkmcnt(0)":::"memory"); \
      _Pragma("unroll") for(int d_=0;d_<2;++d_) _Pragma("unroll") for(int r=0;r<16;++r)o[d_][r]*=wsf[crow(r,hi)]; } }while(0)
  f32x16 pA0,pA1,pB0,pB1;
  int sl_prev=0,sl_cur=0,sl_next=SLOTB;
  #define ROT() do{sl_prev=sl_cur;sl_cur=sl_next;sl_next=(sl_next==(NSLOT-1)*SLOTB)?0:sl_next+SLOTB;}while(0)
  DMA_K(2,2*SLOTB);
  WAIT_BAR(3);
  qkt(pA0,pA1,Kbase,qr,negm,r32,hi);asm volatile("s_nop 15\n\ts_nop 7":"+v"(pA0),"+v"(pA1));CMASK(pA0,pA1,0);
  START(pA0,pA1);
  _Pragma("unroll") for(int r=0;r<16;++r)pA1[r]=__builtin_amdgcn_exp2f(pA1[r]);
  WAIT_BAR(0);
  DMA_K(3,0);DMA_V(1,SLOTB);
  ROT();
  kload8(kf,kp0+sl_cur);
  WAIT_BAR(2);
  s16x4 vlo[8],vhi[8]; u32x4 pw0,pw1,pw2,pw3;
  #define PKW(P,B) cvtpk_s(P[B],P[B+1])
  #define PAF(k) __builtin_bit_cast(bf16x8,pw##k)
  #define VFR(i) (bf16x8){vlo[i][0],vlo[i][1],vlo[i][2],vlo[i][3],vhi[i][0],vhi[i][1],vhi[i][2],vhi[i][3]}
  #define PIN(x) asm volatile("":"+v"(x))
  #define MX3(a,b,c) __builtin_fmaxf(__builtin_fmaxf((a),(b)),(c))
  #define GAPA(MF,A0,A1,A2,A3,W0,W1,PW) do{ MF; sacc+=A0; sacc+=A1; sacc+=A2; sacc+=A3; PIN(sacc); W0; W1; PIN(PW); SBAR(); }while(0)
  #define EX(v) __builtin_amdgcn_exp2f(v)
  #define GAPB(MF,X,B) do{ MF; X[B]=EX(X[B]); X[B+1]=EX(X[B+1]); X[B+2]=EX(X[B+2]); X[B+3]=EX(X[B+3]); PIN(X); SBAR(); }while(0)
  #define VRD(i) do{ vlo[i]=vtr(vp_+(((i)>>2)*4096+((i)&3)*1024)); vhi[i]=vtr(vp_+(((i)>>2)*4096+((i)&3)*1024+512)); }while(0)
  #define KRD(G,j) do{ if(G){ kload2(kf,kp0+sl_next,j); SBAR(); } }while(0)
  #define STEP(C0,C1,P0,P1,t,GK,GV,GL) do{ SBAR(); \
    const lds_cptr vp_=vp0+sl_prev; \
    VRD(0); SBAR(); float sacc=(P0[0]+P0[1]); \
    GAPA(C0=__builtin_amdgcn_mfma_f32_32x32x16_bf16(kf[0],qr[0],negm,0,0,0), P0[2],P0[3],P0[4],P0[5],     pw0[0]=PKW(P0,0), pw0[1]=PKW(P0,2), pw0); \
    VRD(4); SBAR(); GAPA(C1=__builtin_amdgcn_mfma_f32_32x32x16_bf16(kf[1],qr[0],negm,0,0,0), P0[6],P0[7],P0[8],P0[9],     pw0[2]=PKW(P0,4), pw0[3]=PKW(P0,6), pw0); \
    VRD(1); SBAR(); GAPA(C0=__builtin_amdgcn_mfma_f32_32x32x16_bf16(kf[2],qr[1],C0,0,0,0),   P0[10],P0[11],P0[12],P0[13], pw1[0]=PKW(P0,8), pw1[1]=PKW(P0,10), pw1); \
    VRD(5); SBAR(); GAPA(C1=__builtin_amdgcn_mfma_f32_32x32x16_bf16(kf[3],qr[1],C1,0,0,0),   P0[14],P0[15],P1[0],P1[1],   pw1[2]=PKW(P0,12),pw1[3]=PKW(P0,14), pw1); \
    VRD(2); SBAR(); GAPA(C0=__builtin_amdgcn_mfma_f32_32x32x16_bf16(kf[4],qr[2],C0,0,0,0),   P1[2],P1[3],P1[4],P1[5],     pw2[0]=PKW(P1,0), pw2[1]=PKW(P1,2), pw2); \
    VRD(6); SBAR(); GAPA(C1=__builtin_amdgcn_mfma_f32_32x32x16_bf16(kf[5],qr[2],C1,0,0,0),   P1[6],P1[7],P1[8],P1[9],     pw2[2]=PKW(P1,4), pw2[3]=PKW(P1,6), pw2); \
    VRD(3); SBAR(); GAPA(C0=__builtin_amdgcn_mfma_f32_32x32x16_bf16(kf[6],qr[3],C0,0,0,0),   P1[10],P1[11],P1[12],P1[13], pw3[0]=PKW(P1,8), pw3[1]=PKW(P1,10), pw3); \
    VRD(7); SBAR(); GAPA(C1=__builtin_amdgcn_mfma_f32_32x32x16_bf16(kf[7],qr[3],C1,0,0,0),   P1[14],P1[15],0.f,0.f,       pw3[2]=PKW(P1,12),pw3[3]=PKW(P1,14), pw3); \
    l_reg+=sacc; \
    if(GK){DMA_K((t)+3,sl_cur);} if(GV){DMA_V((t)+1,sl_next);} \
    CMASK(C0,C1,t); \
    { float a=MX3(C0[0],C0[1],C1[0]),b=MX3(C0[2],C0[3],C1[1]); a=MX3(a,C1[2],C1[3]); \
      _Pragma("unroll") for(int r=4;r<16;r+=4){a=MX3(a,C0[r],C0[r+1]);b=MX3(b,C0[r+2],C0[r+3]);a=MX3(a,C1[r],C1[r+1]);b=MX3(b,C1[r+2],C1[r+3]);} \
      float rm=__builtin_fmaxf(a,b); { auto rr=__builtin_amdgcn_permlane32_swap(__float_as_uint(rm),__float_as_uint(rm),false,false); rm=__builtin_fmaxf(__uint_as_float(rr[0]),__uint_as_float(rr[1])); } \
      resc=false; \
      if(__builtin_expect(__any(rm>(float)THRL),0)){ const float dl=__builtin_fmaxf(rm,0.f); mhat+=dl; \
        _Pragma("unroll") for(int r=0;r<16;++r){C0[r]-=dl;C1[r]-=dl;} \
        _Pragma("unroll") for(int r=0;r<16;++r)negm[r]=-mhat; asm volatile("":"+v"(negm)); \
        const float f=__builtin_amdgcn_exp2f(-dl); l_reg*=f; if(hi==0)wsf[r32]=f; resc=true; } } \
    SBAR(); \
    GAPB(o[0]=__builtin_amdgcn_mfma_f32_32x32x16_bf16(PAF(0),VFR(0),o[0],0,0,0), C0,0); \
    GAPB(o[1]=__builtin_amdgcn_mfma_f32_32x32x16_bf16(PAF(0),VFR(4),o[1],0,0,0), C0,4); \
    KRD(GL,0); GAPB(o[0]=__builtin_amdgcn_mfma_f32_32x32x16_bf16(PAF(1),VFR(1),o[0],0,0,0), C0,8); \
    KRD(GL,1); GAPB(o[1]=__builtin_amdgcn_mfma_f32_32x32x16_bf16(PAF(1),VFR(5),o[1],0,0,0), C0,12); \
    KRD(GL,2); GAPB(o[0]=__builtin_amdgcn_mfma_f32_32x32x16_bf16(PAF(2),VFR(2),o[0],0,0,0), C1,0); \
    KRD(GL,3); GAPB(o[1]=__builtin_amdgcn_mfma_f32_32x32x16_bf16(PAF(2),VFR(6),o[1],0,0,0), C1,4); \
    GAPB(o[0]=__builtin_amdgcn_mfma_f32_32x32x16_bf16(PAF(3),VFR(3),o[0],0,0,0), C1,8); \
    GAPB(o[1]=__builtin_amdgcn_mfma_f32_32x32x16_bf16(PAF(3),VFR(7),o[1],0,0,0), C1,12); \
    }while(0)
  int t=1;
  #undef CMASK
  #define CMASK(P0,P1,t) do{ if(WIN&&(t)>=4){ const int kb_=gap+64*((t)-4)+4*hi-(qpos0+qrel); _Pragma("unroll") for(int r_=0;r_<16;++r_){ const int df_=kb_+(r_&3)+8*(r_>>2); if(df_>128||df_<-128)P0[r_]=-INFINITY; if(df_+32>128||df_+32<-128)P1[r_]=-INFINITY; } } }while(0)
  for(;t+5<NT;t+=2){
    STEP(pB0,pB1,pA0,pA1,t,true,true,true);     WAIT_BAR(2); RESC(); ROT();
    STEP(pA0,pA1,pB0,pB1,t+1,true,true,true);   WAIT_BAR(2); RESC(); ROT();
  }
  #undef CMASK
  #define CMASK(P0,P1,t) do{ if(WIN&&(t)>=4){ const int kb_=gap+64*((t)-4)+4*hi-(qpos0+qrel); _Pragma("unroll") for(int r_=0;r_<16;++r_){ const int df_=kb_+(r_&3)+8*(r_>>2); if(df_>128||df_<-128)P0[r_]=-INFINITY; if(df_+32>128||df_+32<-128)P1[r_]=-INFINITY; } } }while(0)
  #define ENDW(tt) do{ if((tt)+3<NT){WAIT_BAR(2);} else if((tt)+2<NT){WAIT_BAR(1);} else {WAIT_BAR(0);} }while(0)
  for(;t+1<NT;t+=2){
    STEP(pB0,pB1,pA0,pA1,t,(t+3<NT),(t+1<NT),(t+1<NT));       ENDW(t);   RESC(); ROT();
    STEP(pA0,pA1,pB0,pB1,t+1,(t+4<NT),(t+2<NT),(t+2<NT));     ENDW(t+1); RESC(); ROT();
  }
  STEP(pB0,pB1,pA0,pA1,NT-1,false,false,false); RESC();
  { float sacc=pB0[0]+pB0[1]; _Pragma("unroll") for(int r=2;r<16;++r)sacc+=pB0[r]; _Pragma("unroll") for(int r=0;r<16;++r)sacc+=pB1[r]; l_reg+=sacc;
    pw0=(u32x4){PKW(pB0,0),PKW(pB0,2),PKW(pB0,4),PKW(pB0,6)};pw1=(u32x4){PKW(pB0,8),PKW(pB0,10),PKW(pB0,12),PKW(pB0,14)};pw2=(u32x4){PKW(pB1,0),PKW(pB1,2),PKW(pB1,4),PKW(pB1,6)};pw3=(u32x4){PKW(pB1,8),PKW(pB1,10),PKW(pB1,12),PKW(pB1,14)};
    SBAR(); pv(o,vb0+sl_cur,PAF(0),PAF(1),PAF(2),PAF(3)); }
  #undef PKW
  #undef PAF
  #undef VFR
  #undef PIN
  #undef MX3
  #undef GAPA
  #undef GAPB
  #undef EX
  #undef VRD
  #undef KRD
  #undef STEP
  #undef ENDW
  {auto rr=__builtin_amdgcn_permlane32_swap(__float_as_uint(l_reg),__float_as_uint(l_reg),false,false);l_reg=__uint_as_float(rr[0])+__uint_as_float(rr[1]);}
  if(WIN)l_reg+=__builtin_amdgcn_exp2f(sinkl2-mhat);
  if(hi==0)wsf[32+r32]=l_reg;asm volatile("s_waitcnt lgkmcnt(0)":::"memory");
  float rli[16];
  #pragma unroll
  for(int r=0;r<16;++r)rli[r]=__builtin_amdgcn_rcpf(wsf[32+crow(r,hi)]);
  bf16*Ow=Ou+(long)(wid*QBLK)*OP;
  { bf16*stg=(bf16*)(shm+LDS_OST)+wid*2048;
    #pragma unroll
    for(int r=0;r<16;++r){const int orow=crow(r,hi);
      #pragma unroll
      for(int d0=0;d0<2;++d0)stg[orow*64+d0*32+r32]=__float2bfloat16(o[d0][r]*rli[r]);}
    asm volatile("s_waitcnt lgkmcnt(0)":::"memory");
    #pragma unroll
    for(int i=0;i<4;++i){const int row=i*8+(lane>>3),ch=lane&7; const u32x4 v=*(const u32x4*)(stg+row*64+ch*8); ATTN_STORE16(Ow+(long)row*OP+ch*8,v);} }
  asm volatile("s_waitcnt lgkmcnt(0)\n\ts_barrier":::"memory");
  __builtin_amdgcn_s_setprio(0);
  #undef DMA_K
  #undef KROW
  #undef DMA_V
  #undef CMASK
  #undef START
  #undef RESC
  #undef ROT
}
constexpr int ATTN_LDS_BYTES=LDS_BYTES;
#undef SBAR
#undef WAIT_BAR
}

#define DI __device__ __forceinline__
#define LAS __attribute__((address_space(3)))
typedef unsigned short bf16;
typedef unsigned v4u __attribute__((ext_vector_type(4)));
typedef unsigned v2u __attribute__((ext_vector_type(2)));
typedef float f32x4 __attribute__((ext_vector_type(4)));
typedef float f32x2 __attribute__((ext_vector_type(2)));
typedef float f32x16 __attribute__((ext_vector_type(16)));
typedef short bf16x8 __attribute__((ext_vector_type(8)));
typedef __bf16 bf16x2_t __attribute__((ext_vector_type(2)));

constexpr int NWAVES = 8, NTHR = 512;
constexpr int BATCH = 2, SEQ = 8192, DM = 1024, LC = 256;
constexpr int NLAT = BATCH * SEQ;
constexpr int NROW = NLAT + BATCH * LC;
constexpr int KT = LC + SEQ;
constexpr int NEXP = 16;
constexpr float LOG2E = 1.4426950408889634f;
constexpr float QSCALE = 0.125f * LOG2E;
constexpr bool MOE_FP8 = true;
constexpr float WSCALE = 32.0f, WINV = 1.0f / 32.0f;

constexpr size_t MiB = 1u << 20;
constexpr size_t WS_CTL = 0, CTL_BYTES = 64 * 1024;
constexpr size_t WS_MOD = 1 * MiB;
constexpr size_t WS_COS = 2 * MiB, WS_SIN = 3 * MiB;
constexpr size_t WS_AFFT = 4 * MiB;
constexpr size_t WS_SLOT = 6 * MiB;
constexpr size_t WS_IDX = 8 * MiB;
constexpr size_t WS_GATEV = 9 * MiB;
constexpr size_t WS_SCH = 10 * MiB;
constexpr size_t WS_RST = 46 * MiB;
constexpr size_t WS_WABIN = 80 * MiB;
constexpr size_t WS_WABOUT = 83 * MiB;
constexpr size_t WS_WCDIN = 86 * MiB;
constexpr size_t WS_WCDOUT = 91 * MiB;
constexpr size_t WS_WGU = 96 * MiB;
constexpr size_t WS_WD = 352 * MiB;
constexpr size_t WS_XN = 480 * MiB;
constexpr size_t WS_X1 = 514 * MiB;
constexpr size_t WS_X2 = 580 * MiB;
constexpr size_t WS_XS = 646 * MiB;
constexpr size_t WS_ACT = 718 * MiB;
constexpr size_t WS_P = 718 * MiB;
constexpr size_t WS_CAT = 793 * MiB;
constexpr size_t WS_QA = 826 * MiB;
constexpr size_t WS_KA = 843 * MiB;
constexpr size_t WS_VTA = 848 * MiB;
constexpr size_t WS_END = 862 * MiB;

constexpr int LDS_BYTES = 147456;
constexpr int LDS_MISC = LDS_BYTES - 256;

struct Params { const float* in[25]; float* out; unsigned char* ws; unsigned long long pad; };

DI float bf2f(unsigned short b) { return __uint_as_float(((unsigned)b) << 16); }
DI unsigned cvtpk(float lo, float hi) { f32x2 v = {lo, hi}; bf16x2_t b = __builtin_convertvector(v, bf16x2_t); return __builtin_bit_cast(unsigned, b); }
DI unsigned short f2bf(float f) { return (unsigned short)(cvtpk(f, 0.f) & 0xffffu); }
DI float shx(float v, int o, int lane) { return __builtin_bit_cast(float, __builtin_amdgcn_ds_bpermute(((lane ^ o) & 63) << 2, __builtin_bit_cast(int, v))); }
DI int shxi(int v, int o, int lane) { return __builtin_amdgcn_ds_bpermute(((lane ^ o) & 63) << 2, v); }
DI float wave_sum(float v, int lane) {
#pragma unroll
    for (int o = 1; o < 64; o <<= 1) v += shx(v, o, lane);
    return v;
}
DI int crow(int i, int hi) { return (i & 3) + 8 * (i >> 2) + 4 * hi; }
#define MFMA32(a, b, c) __builtin_amdgcn_mfma_f32_32x32x16_bf16((a), (b), (c), 0, 0, 0)
#define LDS_WAIT() asm volatile("s_waitcnt lgkmcnt(0)" ::: "memory")

struct Ctx {
    int tid, lane, wave, vcu, G, gw, NGW;
    LAS unsigned char* lds;
};
typedef const __attribute__((address_space(4))) Params* KP;
DI void env(Params& p, Ctx& C, unsigned char* lds_raw) {
    KP kp = (KP)__builtin_amdgcn_kernarg_segment_ptr(); asm volatile("" : "+s"(kp) :: "memory");
#pragma unroll
    for (int i = 0; i < 25; ++i) p.in[i] = kp->in[i];
    p.out = kp->out; p.ws = kp->ws; p.pad = 0ull;
    int tid = threadIdx.x; asm volatile("" : "+v"(tid) :: "memory");
    C.lds = (LAS unsigned char*)lds_raw;
    C.tid = tid; C.lane = tid & 63; C.wave = __builtin_amdgcn_readfirstlane(tid >> 6);
    C.G = gridDim.x; { const int bx = blockIdx.x; C.vcu = (C.G % 8 == 0) ? (bx % 8) * (C.G / 8) + bx / 8 : bx; }
    C.gw = C.vcu * NWAVES + C.wave; C.NGW = C.G * NWAVES;
}

DI void transpose_item(const float* W, int N, int k0, int n0, bf16* dst, int dpitch, LAS float* scr  , int lane) {
    f32x4 t[16];
    const float* wp = W + (size_t)(k0 + (lane >> 4)) * N + n0 + (lane & 15) * 4;
#pragma unroll
    for (int i = 0; i < 16; ++i) t[i] = __builtin_nontemporal_load((const f32x4*)(wp + (size_t)(4 * i) * N));
#pragma unroll
    for (int i = 0; i < 16; ++i) { LAS float* sp = scr + ((lane >> 4) + 4 * i) * 65 + (lane & 15) * 4; sp[0] = t[i].x; sp[1] = t[i].y; sp[2] = t[i].z; sp[3] = t[i].w; }
    LDS_WAIT(); asm volatile("" ::: "memory");
    const int c = lane & 7;
#pragma unroll
    for (int j = 0; j < 8; ++j) { const int n = (lane >> 3) + 8 * j; const LAS float* s = scr + (8 * c) * 65 + n;
        v4u o; o.x = cvtpk(s[0 * 65], s[1 * 65]); o.y = cvtpk(s[2 * 65], s[3 * 65]); o.z = cvtpk(s[4 * 65], s[5 * 65]); o.w = cvtpk(s[6 * 65], s[7 * 65]);
        __builtin_nontemporal_store(o, (v4u*)(dst + (size_t)n * dpitch + 8 * c)); }
    LDS_WAIT(); asm volatile("" ::: "memory");
}

DI unsigned pk4f8(float a, float b, float c, float d) { unsigned w = 0u; w = __builtin_amdgcn_cvt_pk_fp8_f32(a, b, w, false); w = __builtin_amdgcn_cvt_pk_fp8_f32(c, d, w, true); return w; }
DI void transpose_item_f8(const float* W, int N, int k0, int n0, unsigned char* dst, int dpitch, LAS float* scr  , int lane) {
    f32x4 t[16];
    const float* wp = W + (size_t)(k0 + (lane >> 4)) * N + n0 + (lane & 15) * 4;
#pragma unroll
    for (int i = 0; i < 16; ++i) t[i] = __builtin_nontemporal_load((const f32x4*)(wp + (size_t)(4 * i) * N));
#pragma unroll
    for (int i = 0; i < 16; ++i) { LAS float* sp = scr + ((lane >> 4) + 4 * i) * 65 + (lane & 15) * 4; sp[0] = t[i].x * WSCALE; sp[1] = t[i].y * WSCALE; sp[2] = t[i].z * WSCALE; sp[3] = t[i].w * WSCALE; }
    LDS_WAIT(); asm volatile("" ::: "memory");
    const int c = lane & 3;
#pragma unroll
    for (int j = 0; j < 4; ++j) { const int n = (lane >> 2) + 16 * j; const LAS float* s = scr + (16 * c) * 65 + n;
        v4u o; o.x = pk4f8(s[0 * 65], s[1 * 65], s[2 * 65], s[3 * 65]); o.y = pk4f8(s[4 * 65], s[5 * 65], s[6 * 65], s[7 * 65]);
        o.z = pk4f8(s[8 * 65], s[9 * 65], s[10 * 65], s[11 * 65]); o.w = pk4f8(s[12 * 65], s[13 * 65], s[14 * 65], s[15 * 65]);
        __builtin_nontemporal_store(o, (v4u*)(dst + (size_t)n * dpitch + 16 * c)); }
    LDS_WAIT(); asm volatile("" ::: "memory");
}

constexpr int MOE_ITEMS = 3 * 16 * 512;
DI void convert_moe_item(const Params& p, int l, int it, LAS float* scr, int lane) {
    const int kind = it >> 13, r = it & 8191, mat = l * 16 + (r >> 9), rr = r & 511;
    if (kind < 2) { const int kb = rr >> 5, nb = rr & 31, n0 = 64 * nb; const float* src = (kind ? p.in[23] : p.in[22]) + (size_t)mat * 1024 * 2048;
        const int drow = mat * 4096 + (n0 >> 7) * 256 + (n0 & 127) + (kind ? 128 : 0);
        if (MOE_FP8) transpose_item_f8(src, 2048, 64 * kb, n0, (unsigned char*)(p.ws + WS_WGU) + (size_t)drow * 1024 + 64 * kb, 1024, scr, lane);
        else transpose_item(src, 2048, 64 * kb, n0, (bf16*)(p.ws + WS_WGU) + (size_t)drow * 1024 + 64 * kb, 1024, scr, lane); }
    else { const int kb = rr >> 4, nb = rr & 15; const float* src = p.in[24] + (size_t)mat * 2048 * 1024;
        if (MOE_FP8) transpose_item_f8(src, 1024, 64 * kb, 64 * nb, (unsigned char*)(p.ws + WS_WD) + (size_t)(mat * 1024 + 64 * nb) * 2048 + 64 * kb, 2048, scr, lane);
        else transpose_item(src, 1024, 64 * kb, 64 * nb, (bf16*)(p.ws + WS_WD) + (size_t)(mat * 1024 + 64 * nb) * 2048 + 64 * kb, 2048, scr, lane); }
}
struct SlotPlan { int base[6], nidle[6], q[6], covered[2]; };
DI SlotPlan make_slot_plan(int G) {
    SlotPlan sp; const int nunits[6] = {330, 264, 64, 576, 594, 32}; const int qq[6] = {40, 40, 40, 32, 32, 32};
#pragma unroll
    for (int st = 0; st < 2; ++st) { int acc = 0;
#pragma unroll
        for (int k = 3 * st; k < 3 * st + 3; ++k) { const int rounds = (nunits[k] + G - 1) / G; const int busy = nunits[k] - (rounds - 1) * G; const int ni = G - busy; sp.nidle[k] = ni; sp.base[k] = acc;
            sp.q[k] = qq[k]; acc += (ni > 0 ? ni : 0) * qq[k]; if (acc > MOE_ITEMS) acc = MOE_ITEMS; }
        sp.covered[st] = acc; }
    return sp;
}
DI void convert_slot(const Ctx& C, const Params& p, int k, int c) {
    const SlotPlan sp = make_slot_plan(C.G);
    const int ii = c - (C.G - sp.nidle[k]); if (ii < 0) return;
    const int first = sp.base[k] + ii * sp.q[k]; int last = first + sp.q[k]; if (last > MOE_ITEMS) last = MOE_ITEMS;
    LAS float* scr = (LAS float*)(C.lds + C.wave * 16640);
    for (int it = first + C.wave; it < last; it += NWAVES) convert_moe_item(p, k < 3 ? 0 : 1, it, scr, C.lane);
}

DI void ph0_prologue(const Ctx& C, const Params& p) {
    unsigned char* ws = p.ws;
    float* MOD = (float*)(ws + WS_MOD);
    {
        LAS float* sv = (LAS float*)(C.lds);
        LAS float* red = (LAS float*)(C.lds + 12288);
        for (int i = C.tid; i < 3 * 1024; i += NTHR) { const int r = i >> 10, k = i & 1023; const float cv = (r < 2) ? p.in[1][r * 1024 + k] : p.in[3][k]; sv[i] = cv / (1.f + __expf(-cv)); }
        __syncthreads();
        for (int item = C.vcu; item < 192; item += C.G) {
            const int l = item / 96, n0 = (item % 96) * 64;
            const float* W = p.in[4] + (size_t)l * 1024 * 6144 + n0 + C.lane;
            float a0 = 0.f, a1 = 0.f, a2 = 0.f;
            const int kb = C.wave * 128;
#pragma unroll 32
            for (int k = 0; k < 128; ++k) { const float w = __builtin_nontemporal_load(W + (size_t)(kb + k) * 6144); a0 += sv[kb + k] * w; a1 += sv[1024 + kb + k] * w; a2 += sv[2048 + kb + k] * w; }
            red[(C.wave * 3 + 0) * 64 + C.lane] = a0; red[(C.wave * 3 + 1) * 64 + C.lane] = a1; red[(C.wave * 3 + 2) * 64 + C.lane] = a2;
            __syncthreads();
            if (C.tid < 192) { const int r = C.tid >> 6, ln = C.tid & 63; float s = 0.f;
#pragma unroll
                for (int w = 0; w < 8; ++w) s += red[(w * 3 + r) * 64 + ln];
                MOD[(size_t)(l * 3 + r) * 6144 + n0 + ln] = s + p.in[5][l * 6144 + n0 + ln]; }
            __syncthreads();
        }
        __syncthreads();
    }
    {
        float* COS = (float*)(ws + WS_COS); float* SIN = (float*)(ws + WS_SIN);
        for (int i = C.vcu * NTHR + C.tid; i < SEQ * 32; i += C.G * NTHR) {
            const int t = i >> 5, j = i & 31; const int pos = (j < 16) ? (t >> 6) : (t & 63); const int fi = j & 15;
            const float freq = powf(10000.0f, -(float)fi / 16.0f); const float ang = (float)pos * freq;
            COS[i] = cosf(ang); SIN[i] = sinf(ang);
        }
    }
    {
        LAS float* scr = (LAS float*)(C.lds + C.wave * 16640);
        bf16* WABIN = (bf16*)(ws + WS_WABIN); bf16* WABOUT = (bf16*)(ws + WS_WABOUT);
        bf16* WCDIN = (bf16*)(ws + WS_WCDIN); bf16* WCDOUT = (bf16*)(ws + WS_WCDOUT); bf16* WGU = (bf16*)(ws + WS_WGU); bf16* WD = (bf16*)(ws + WS_WD);
        constexpr int I0 = 16 * 20, I1 = 8 * 16, I2 = 16 * 36, I3 = 16 * 16, I4 = 1024, I5 = 0, I6 = 16 * 512, I7 = 16 * 512, I8 = 16 * 512;
        constexpr int NITEMS = I0 + I1 + I2 + I3 + I4 + I5;
        const int rot = (C.G >= 192 ? 192 : C.G) * NWAVES;
        for (int it = (C.gw + C.NGW - rot) % C.NGW; it < NITEMS; it += C.NGW) {
            int r = it;
            if (r < I4) {
                const int g = r >> 8, cb = (r >> 4) & 15, nb = r & 15, c0 = 8 * cb, n0 = 64 * nb;
                const float* Wg = p.in[13] + (size_t)g * 128 * 128 + (size_t)c0 * 128; const float* bs = p.in[14] + g * 128; const float* Wo = p.in[10] + (size_t)(512 + g * 128) * 1024 + n0 + C.lane;
                float a8[8];
#pragma unroll
                for (int ci = 0; ci < 8; ++ci) a8[ci] = 0.f;
#pragma unroll 32
                for (int d = 0; d < 128; ++d) { const float w = Wo[(size_t)d * 1024] * bs[d];
#pragma unroll
                    for (int ci = 0; ci < 8; ++ci) a8[ci] += Wg[ci * 128 + d] * w; }
                v4u o; o.x = cvtpk(a8[0], a8[1]); o.y = cvtpk(a8[2], a8[3]); o.z = cvtpk(a8[4], a8[5]); o.w = cvtpk(a8[6], a8[7]);
                *(v4u*)(WABOUT + (size_t)(n0 + C.lane) * 1024 + 512 + g * 128 + c0) = o; continue; } r -= I4;
            if (r < I0) { const int kb = r / 20, nb = r % 20; transpose_item(p.in[9], 1280, 64 * kb, 64 * nb, WABIN + (size_t)(64 * nb) * 1024 + 64 * kb, 1024, scr, C.lane); continue; } r -= I0;
            if (r < I1) { const int kb = r / 16, nb = r % 16; transpose_item(p.in[10], 1024, 64 * kb, 64 * nb, WABOUT + (size_t)(64 * nb) * 1024 + 64 * kb, 1024, scr, C.lane); continue; } r -= I1;
            if (r < I2) { const int kb = r / 36, nb = r % 36; transpose_item_f8(p.in[15], 2304, 64 * kb, 64 * nb, (unsigned char*)WCDIN + (size_t)(64 * nb) * 1024 + 64 * kb, 1024, scr, C.lane); continue; } r -= I2;
            if (r < I3) { const int kb = r / 16, nb = r % 16; transpose_item(p.in[16], 1024, 64 * kb, 64 * nb, WCDOUT + (size_t)(64 * nb) * 1024 + 64 * kb, 1024, scr, C.lane); continue; } r -= I3;
        }
        { const SlotPlan sp = make_slot_plan(C.G);
          const int n0 = MOE_ITEMS - sp.covered[0], n1 = MOE_ITEMS - sp.covered[1];
          for (int it = C.gw; it < n0 + n1; it += C.NGW) { if (it < n0) convert_moe_item(p, 0, sp.covered[0] + it, scr, C.lane); else convert_moe_item(p, 1, sp.covered[1] + (it - n0), scr, C.lane); } }
    }
}

DI void load_row(const float* src, int lane, f32x4 (&v)[4]) {
#pragma unroll
    for (int j = 0; j < 4; ++j) v[j] = __builtin_nontemporal_load((const f32x4*)src + lane + 64 * j);
}
DI void load_row_h(const bf16* src, int lane, f32x4 (&v)[4]) {
#pragma unroll
    for (int j = 0; j < 4; ++j) { const v2u w = __builtin_nontemporal_load((const v2u*)src + lane + 64 * j); v[j] = (f32x4){__uint_as_float(w.x << 16), __uint_as_float(w.x & 0xffff0000u), __uint_as_float(w.y << 16), __uint_as_float(w.y & 0xffff0000u)}; }
}
DI float row_rstd(const f32x4 (&v)[4], float eps, int lane) {
    float s = 0.f;
#pragma unroll
    for (int j = 0; j < 4; ++j) s += (v[j].x * v[j].x + v[j].y * v[j].y) + (v[j].z * v[j].z + v[j].w * v[j].w);
    s = wave_sum(s, lane);
    return rsqrtf(s * (1.0f / 1024.0f) + eps);
}
template <bool OUT_FP8 = false>
DI void modulate_row(f32x4 (&v)[4], const float* g, const float* shift, const float* scale, bf16* dst, int lane) {
    const float rstd = row_rstd(v, 1e-6f, lane);
#pragma unroll
    for (int j = 0; j < 4; ++j) {
        const f32x4 gg = ((const f32x4*)g)[lane + 64 * j], sh = ((const f32x4*)shift)[lane + 64 * j], sc = ((const f32x4*)scale)[lane + 64 * j];
        v[j] = v[j] * rstd * gg * (sc + 1.0f) + sh;
        if (OUT_FP8) ((unsigned*)dst)[lane + 64 * j] = pk4f8(v[j].x, v[j].y, v[j].z, v[j].w);
        else { v2u w; w.x = cvtpk(v[j].x, v[j].y); w.y = cvtpk(v[j].z, v[j].w); ((v2u*)dst)[lane + 64 * j] = w; }
    }
}

DI bool trip_rows(const Ctx& C, int nrows, int t, int (&rr)[2], bool& dup) {
    if (nrows == NROW && (NLAT % (2 * C.NGW)) == 0) {
        const int nm = NLAT / (2 * C.NGW); dup = false;
        if (t < nm) { rr[0] = C.gw + t * 2 * C.NGW; rr[1] = rr[0] + C.NGW; return true; }
        const int j = C.vcu + C.G * (C.wave + NWAVES * (t - nm));
        if (j < BATCH * LC / 2) { rr[0] = NLAT + 2 * j; rr[1] = rr[0] + 1; return true; }
        return false;
    }
    const int r0 = C.gw + t * 2 * C.NGW; if (r0 >= nrows) return false;
    rr[0] = r0; rr[1] = r0 + C.NGW; dup = rr[1] >= nrows; if (dup) rr[1] = r0; return true;
}

DI void mod0_load(const Ctx& C, const Params& p, const int (&rr)[2], f32x4 (&v)[2][4]) {
#pragma unroll
    for (int q = 0; q < 2; ++q) { const int r = rr[q]; const float* src = r < NLAT ? p.in[0] + (size_t)r * DM : p.in[2] + (size_t)(r - NLAT) * DM; load_row(src, C.lane, v[q]); }
}
DI void mod0_finish(const Ctx& C, const Params& p, const int (&rr)[2], f32x4 (&v)[2][4]) {
    const float* MOD = (const float*)(p.ws + WS_MOD); bf16* XN = (bf16*)(p.ws + WS_XN);
#pragma unroll
    for (int q = 0; q < 2; ++q) { const int r = rr[q]; const int mi = r < NLAT ? (r >> 13) : 2; const float* mp = MOD + (size_t)(0 * 3 + mi) * 6144;
        modulate_row(v[q], p.in[6], mp, mp + 1024, XN + (size_t)r * DM, C.lane); }
}
DI void ph_modulate0(const Ctx& C, const Params& p) {
    int ra[2], rb[2]; bool da, db; f32x4 va[2][4], vb[2][4];
    bool ha = trip_rows(C, NROW, 0, ra, da); if (ha) mod0_load(C, p, ra, va);
    for (int t = 0; ha; t += 2) {
        const bool hb = trip_rows(C, NROW, t + 1, rb, db); if (hb) mod0_load(C, p, rb, vb);
        mod0_finish(C, p, ra, va);
        if (!hb) break;
        ha = trip_rows(C, NROW, t + 2, ra, da); if (ha) mod0_load(C, p, ra, va);
        mod0_finish(C, p, rb, vb);
    }
}

struct HeadRegs { v2u a, b; };
DI HeadRegs heads8_load(const bf16* src, int nheads, int lane) {
    const int hd = lane >> 3, hdc = hd < nheads ? hd : nheads - 1, j0 = (lane & 7) * 4;
    HeadRegs h; h.a = *(const v2u*)(src + hdc * 64 + j0); h.b = *(const v2u*)(src + hdc * 64 + 32 + j0); return h;
}
DI void heads8_finish(const HeadRegs h, int nheads, bool donorm, const f32x4 g1, const f32x4 g2, bool dorope, const f32x4 c, const f32x4 sv, float scale, bf16* dst, int lane) {
    const int hd = lane >> 3, j0 = (lane & 7) * 4;
    float x1[4] = {__uint_as_float(h.a.x << 16), __uint_as_float(h.a.x & 0xffff0000u), __uint_as_float(h.a.y << 16), __uint_as_float(h.a.y & 0xffff0000u)};
    float x2[4] = {__uint_as_float(h.b.x << 16), __uint_as_float(h.b.x & 0xffff0000u), __uint_as_float(h.b.y << 16), __uint_as_float(h.b.y & 0xffff0000u)};
    if (donorm) { float ss = 0.f;
#pragma unroll
        for (int i = 0; i < 4; ++i) ss += x1[i] * x1[i] + x2[i] * x2[i];
        ss += shx(ss, 1, lane); ss += shx(ss, 2, lane); ss += shx(ss, 4, lane);
        const float rs = rsqrtf(ss * (1.0f / 64.0f) + 1e-6f);
#pragma unroll
        for (int i = 0; i < 4; ++i) { x1[i] *= rs * g1[i]; x2[i] *= rs * g2[i]; } }
    if (dorope) {
#pragma unroll
        for (int i = 0; i < 4; ++i) { const float o1 = x1[i] * c[i] - x2[i] * sv[i], o2 = x1[i] * sv[i] + x2[i] * c[i]; x1[i] = o1; x2[i] = o2; } }
    if (hd < nheads) { v2u o1, o2; o1.x = cvtpk(x1[0] * scale, x1[1] * scale); o1.y = cvtpk(x1[2] * scale, x1[3] * scale); o2.x = cvtpk(x2[0] * scale, x2[1] * scale); o2.y = cvtpk(x2[2] * scale, x2[3] * scale);
        *(v2u*)(dst + hd * 64 + j0) = o1; *(v2u*)(dst + hd * 64 + 32 + j0) = o2; }
}

DI void ph_post0(const Ctx& C, const Params& p) {
    const bf16* P = (const bf16*)(p.ws + WS_P); bf16* QA = (bf16*)(p.ws + WS_QA); bf16* KA = (bf16*)(p.ws + WS_KA); bf16* VA = (bf16*)(p.ws + WS_VTA); bf16* CATB = (bf16*)(p.ws + WS_CAT) + 512;
    const float* COS = (const float*)(p.ws + WS_COS); const float* SIN = (const float*)(p.ws + WS_SIN);
    const int j0 = (C.lane & 7) * 4;
    const f32x4 qg1 = *(const f32x4*)(p.in[11] + j0), qg2 = *(const f32x4*)(p.in[11] + 32 + j0), kg1 = *(const f32x4*)(p.in[12] + j0), kg2 = *(const f32x4*)(p.in[12] + 32 + j0);
    for (int t = 0; ; ++t) {
        int rr[2]; bool dup; if (!trip_rows(C, NROW, t, rr, dup)) break;
        bool isctx[2]; int bb[2], pos[2], kk[2]; const bf16* prow[2];
#pragma unroll
        for (int q = 0; q < 2; ++q) { const int r = rr[q]; isctx[q] = r >= NLAT; bb[q] = isctx[q] ? ((r - NLAT) >> 8) : (r >> 13); pos[q] = isctx[q] ? ((r - NLAT) & 255) : (r & 8191);
            kk[q] = isctx[q] ? pos[q] : LC + pos[q]; prow[q] = P + (size_t)r * 1280; }
        HeadRegs hq[2], hk[2]; v4u vc[2], uu[2]; f32x4 c4[2], s4[2];
#pragma unroll
        for (int q = 0; q < 2; ++q) { hq[q] = heads8_load(prow[q], 8, C.lane); hk[q] = heads8_load(prow[q] + 512, 2, C.lane);
            vc[q] = *(const v4u*)(prow[q] + 640 + (C.lane & 15) * 8); uu[q] = *(const v4u*)(prow[q] + 768 + C.lane * 8);
            const size_t tp = (size_t)(isctx[q] ? 0 : pos[q]) * 32 + j0; c4[q] = *(const f32x4*)(COS + tp); s4[q] = *(const f32x4*)(SIN + tp); }
        const int c0 = C.lane * 8, g = C.lane >> 4, w = 2 << g;
        int lo[2], hi[2]; float s[2][8];
#pragma unroll
        for (int q = 0; q < 2; ++q) { const int L = isctx[q] ? LC : SEQ; lo[q] = max(pos[q] - (w >> 1), 0); hi[q] = min(pos[q] - (w >> 1) + w, L);
#pragma unroll
            for (int i = 0; i < 8; ++i) s[q][i] = 0.f; }
#pragma unroll
        for (int bt = 0; bt < 2; ++bt) {
            if (bt == 1 && !__any((lo[0] + 8 < hi[0]) || (lo[1] + 8 < hi[1]))) break;
            v4u vv[2][8];
#pragma unroll
            for (int q = 0; q < 2; ++q) { const size_t rowbase = (size_t)rr[q] - pos[q];
#pragma unroll
                for (int k = 0; k < 8; ++k) { const int rw = min(lo[q] + 8 * bt + k, hi[q] - 1); vv[q][k] = *(const v4u*)(P + (rowbase + rw) * 1280 + 768 + c0); } }
            if (bt == 0) {
#pragma unroll
                for (int q = 0; q < 2; ++q) {
                    heads8_finish(hq[q], 8, true, qg1, qg2, !isctx[q], c4[q], s4[q], QSCALE, QA + (size_t)rr[q] * 512, C.lane);
                    heads8_finish(hk[q], 2, true, kg1, kg2, !isctx[q], c4[q], s4[q], 1.0f, KA + ((size_t)bb[q] * KT + kk[q]) * 128, C.lane);
                    if (C.lane < 16) *(v4u*)(VA + ((size_t)bb[q] * KT + kk[q]) * 128 + C.lane * 8) = vc[q]; }
            }
#pragma unroll
            for (int q = 0; q < 2; ++q)
#pragma unroll
                for (int k = 0; k < 8; ++k) { const float wgt = (lo[q] + 8 * bt + k < hi[q]) ? 1.0f : 0.0f;
#pragma unroll
                    for (int i = 0; i < 4; ++i) { s[q][2 * i] += wgt * __uint_as_float(vv[q][k][i] << 16); s[q][2 * i + 1] += wgt * __uint_as_float(vv[q][k][i] & 0xffff0000u); } }
        }
#pragma unroll
        for (int q = 0; q < 2; ++q) { const float inv = 1.0f / (float)(hi[q] - lo[q]); v4u o;
#pragma unroll
            for (int i = 0; i < 4; ++i) o[i] = cvtpk(s[q][2 * i] * inv - __uint_as_float(uu[q][i] << 16), s[q][2 * i + 1] * inv - __uint_as_float(uu[q][i] & 0xffff0000u));
            *(v4u*)(CATB + (size_t)rr[q] * 1024 + c0) = o; }
    }
}

struct P1Trip { int rr[2]; bool dup; HeadRegs hcq[2], hck[2], hdq[2], hdk[2]; v4u vc[2]; f32x4 c4[2], s4[2]; };
DI void p1_load(const Ctx& C, const bf16* P, const float* COS, const float* SIN, P1Trip& T) {
    const int j0 = (C.lane & 7) * 4;
#pragma unroll
    for (int q = 0; q < 2; ++q) { const int r = T.rr[q]; const bool isctx = r >= NLAT; const int pos = isctx ? ((r - NLAT) & 255) : (r & 8191); const bf16* prow = P + (size_t)r * 2304;
        T.hcq[q] = heads8_load(prow, 4, C.lane); T.hck[q] = heads8_load(prow + 256, 4, C.lane); T.hdq[q] = heads8_load(prow + 1536, 8, C.lane); T.hdk[q] = heads8_load(prow + 2048, 2, C.lane);
        T.vc[q] = *(const v4u*)(prow + 2176 + (C.lane & 15) * 8);
        const size_t tp = (size_t)(isctx ? 0 : pos) * 32 + j0; T.c4[q] = *(const f32x4*)(COS + tp); T.s4[q] = *(const f32x4*)(SIN + tp); }
}
DI void p1_finish(const Ctx& C, bf16* P, bf16* KA, bf16* VTA, const P1Trip& T) {
    const f32x4 one = (f32x4){1.f, 1.f, 1.f, 1.f};
#pragma unroll
    for (int q = 0; q < 2; ++q) { if (q == 1 && T.dup) break;
        const int r = T.rr[q]; const bool isctx = r >= NLAT; const int bb = isctx ? ((r - NLAT) >> 8) : (r >> 13); const int pos = isctx ? ((r - NLAT) & 255) : (r & 8191);
        const int kk = isctx ? pos : LC + pos; bf16* prow = P + (size_t)r * 2304;
        if (!isctx) { heads8_finish(T.hcq[q], 4, false, one, one, true, T.c4[q], T.s4[q], 1.0f, prow, C.lane); heads8_finish(T.hdq[q], 8, false, one, one, true, T.c4[q], T.s4[q], QSCALE, prow + 1536, C.lane); }
        heads8_finish(T.hck[q], 4, false, one, one, !isctx, T.c4[q], T.s4[q], 0.125f, prow + 256, C.lane);
        heads8_finish(T.hdk[q], 2, false, one, one, !isctx, T.c4[q], T.s4[q], 1.0f, KA + ((size_t)bb * KT + kk) * 128, C.lane);
        if (C.lane < 16) *(v4u*)(VTA + ((size_t)bb * KT + kk) * 128 + C.lane * 8) = T.vc[q]; }
}
DI void ph_post1(const Ctx& C, const Params& p) {
    bf16* P = (bf16*)(p.ws + WS_P); bf16* KA = (bf16*)(p.ws + WS_KA); bf16* VTA = (bf16*)(p.ws + WS_VTA);
    const float* COS = (const float*)(p.ws + WS_COS); const float* SIN = (const float*)(p.ws + WS_SIN);
    P1Trip A, B;
    bool ha = trip_rows(C, NROW, 0, A.rr, A.dup); if (ha) p1_load(C, P, COS, SIN, A);
    for (int t = 0; ha; t += 2) {
        const bool hb = trip_rows(C, NROW, t + 1, B.rr, B.dup); if (hb) p1_load(C, P, COS, SIN, B);
        p1_finish(C, P, KA, VTA, A);
        if (!hb) break;
        ha = trip_rows(C, NROW, t + 2, A.rr, A.dup); if (ha) p1_load(C, P, COS, SIN, A);
        p1_finish(C, P, KA, VTA, B);
    }
}

DI void ph_attn_dense(const Ctx& C, const Params& p, unsigned char* lds_raw) {
    typedef attn_body::bf16 abf;
    const abf* QA = (const abf*)(p.ws + WS_QA); const abf* KA = (const abf*)(p.ws + WS_KA); const abf* VA = (const abf*)(p.ws + WS_VTA); abf* CAT = (abf*)(p.ws + WS_CAT);
    for (int u = C.vcu; u < 512 + 16; u += C.G) {
        if (u < 512) { const int qb = u & 31, h = (u >> 5) & 7, b = u >> 8; const size_t row0 = (size_t)b * SEQ + 256 * qb; const size_t kv0 = (size_t)b * KT * 128 + (h >> 2) * 64;
            attn_body::attn_unit<8, false>(QA + row0 * 512 + h * 64, 512, KA + kv0, VA + kv0, 128, KT / 64, CAT + row0 * 1024 + h * 64, 1024, (char*)lds_raw, 0, 0, 0.f); }
        else { const int v = u - 512; const int h = v & 7, b = v >> 3; const size_t row0 = (size_t)NLAT + b * LC; const size_t kv0 = (size_t)b * KT * 128 + (h >> 2) * 64;
            attn_body::attn_unit<8, false>(QA + row0 * 512 + h * 64, 512, KA + kv0, VA + kv0, 128, LC / 64, CAT + row0 * 1024 + h * 64, 1024, (char*)lds_raw, 0, 0, 0.f); }
    }
}
DI void ph_attn_window(const Ctx& C, const Params& p, unsigned char* lds_raw) {
    typedef attn_body::bf16 abf;
    const abf* P = (const abf*)(p.ws + WS_P); const abf* KA = (const abf*)(p.ws + WS_KA); const abf* VA = (const abf*)(p.ws + WS_VTA); abf* CAT = (abf*)(p.ws + WS_CAT);
    for (int u = C.vcu; u < 512; u += C.G) {
        const int qb = u & 31, h = (u >> 5) & 7, b = u >> 8; const int q0 = 256 * qb; const size_t row0 = (size_t)b * SEQ + q0; const size_t kv0 = (size_t)b * KT * 128 + (h >> 2) * 64;
        const int lo = max(q0 - 128, 0), hi = min(q0 + 384, SEQ);
        attn_body::attn_unit<8, true>(P + row0 * 2304 + 1536 + h * 64, 2304, KA + kv0, VA + kv0, 128, 4 + (hi - lo) / 64, CAT + row0 * 1024 + 512 + h * 64, 1024, (char*)lds_raw, lo, q0, p.in[20][h] * LOG2E);
    }
}

DI void ph_ffn_norm_router(const Ctx& C, const Params& p, int l, int nrows) {
    const float* MOD = (const float*)(p.ws + WS_MOD); unsigned char* XN8 = p.ws + WS_XN; const bf16* X1 = (const bf16*)(p.ws + WS_X1); float* AFFT = (float*)(p.ws + WS_AFFT);
    LAS bf16* Bh = (LAS bf16*)C.lds;
    LAS bf16* Bl = Bh + 16384;
    LAS float* GS = (LAS float*)(C.lds + 65536);
    LAS float* SH = GS + 1024;
    LAS float* cb = SH + 1024;
    const int G = C.G, w = C.vcu;
    int mi, t0, t1, rbase;
    { const int gc = nrows == NROW ? (G >= 32 ? G / 32 : 1) : 0, gl = (G - gc) / 2;
      if (w < gl) { mi = 0; rbase = 0; t0 = (w * 512) / gl; t1 = ((w + 1) * 512) / gl; }
      else if (nrows != NROW || w < 2 * gl) { const int n = nrows == NROW ? gl : G - gl, i = w - gl; mi = 1; rbase = SEQ; t0 = (i * 512) / n; t1 = ((i + 1) * 512) / n; }
      else { const int n = G - 2 * gl, i = w - 2 * gl; mi = 2; rbase = NLAT; t0 = (i * 32) / n; t1 = ((i + 1) * 32) / n; } }
    const float* mp = MOD + (size_t)(l * 3 + mi) * 6144; const float* gw = p.in[7] + l * 1024; const float* shp = mp + 3 * 1024; const float* scp = mp + 4 * 1024;
    const float* RW = p.in[21] + (size_t)l * 1024 * 16;
    const int wv = __builtin_amdgcn_readfirstlane(C.wave);
    const int row = C.lane & 15, kg = C.lane >> 4;
    unsigned xo = (unsigned)(row * 1024 + 32 * kg); asm volatile("" : "+v"(xo));
    v4u xq[8][4];
    int t = t0 + wv;
    if (t < t1) { const bf16* xt = X1 + (size_t)(rbase + 16 * t) * DM;
#pragma unroll
        for (int q = 0; q < 8; ++q)
#pragma unroll
            for (int c = 0; c < 4; ++c) xq[q][c] = __builtin_nontemporal_load((const v4u*)(xt + xo + 128 * q + 8 * c)); }
    { float wr[32];
#pragma unroll
      for (int it = 0; it < 32; ++it) wr[it] = RW[C.tid + NTHR * it];
#pragma unroll
      for (int h = 0; h < 2; ++h) { const int k = C.tid + NTHR * h; GS[k] = gw[k] * (scp[k] + 1.0f); SH[k] = shp[k]; }
      __syncthreads();
      float cacc = 0.f;
      unsigned tq = (unsigned)C.tid; asm volatile("" : "+v"(tq));
      const unsigned e = tq & 15u, kb = tq >> 4;
      unsigned ob = ((((kb >> 3) * 4u) * 16u + e) * 8u + (kb & 7u)); asm volatile("" : "+v"(ob));
#pragma unroll
      for (int it = 0; it < 32; ++it) {
          const float gk = GS[kb + 32 * it], shk = SH[kb + 32 * it];
          const float bf = gk * wr[it]; const unsigned short hi = f2bf(bf); const unsigned short lo = f2bf(bf - bf2f(hi));
          const int o = ((4 * (it >> 2)) * 4 + (it & 3)) * 16 * 8;
          Bh[ob + o] = hi; Bl[ob + o] = lo; cacc += shk * wr[it]; }
      cacc += shx(cacc, 16, C.lane); cacc += shx(cacc, 32, C.lane);
      if (C.lane < 16) cb[wv * 16 + C.lane] = cacc; }
    __syncthreads();
    float cbias = 0.f;
#pragma unroll
    for (int ww = 0; ww < 8; ++ww) cbias += cb[ww * 16 + row];
    while (t < t1) {
        const int r0 = rbase + 16 * t;
        f32x4 acc = (f32x4){0.f, 0.f, 0.f, 0.f}; float ssq = 0.f;
        int ln = C.lane; asm volatile("" : "+v"(ln));
        unsigned lb = (unsigned)ln * 8u;
#pragma unroll
        for (int q = 0; q < 8; ++q)
#pragma unroll
            for (int c = 0; c < 4; ++c) {
                const bf16x8 bh = *(const LAS bf16x8*)(Bh + lb + (4 * q + c) * 512), bl = *(const LAS bf16x8*)(Bl + lb + (4 * q + c) * 512);
                const bf16x8 a = __builtin_bit_cast(bf16x8, xq[q][c]);
                acc = __builtin_amdgcn_mfma_f32_16x16x32_bf16(a, bh, acc, 0, 0, 0);
                acc = __builtin_amdgcn_mfma_f32_16x16x32_bf16(a, bl, acc, 0, 0, 0);
#pragma unroll
                for (int d = 0; d < 4; ++d) { const float x0 = __uint_as_float(xq[q][c][d] << 16), x1 = __uint_as_float(xq[q][c][d] & 0xffff0000u); ssq += x0 * x0 + x1 * x1; }
            }
        ssq += shx(ssq, 16, ln); ssq += shx(ssq, 32, ln);
        const float rstd = rsqrtf(ssq * (1.0f / 1024.0f) + 1e-6f);
        f32x4 af;
#pragma unroll
        for (int i = 0; i < 4; ++i) {
            const float rs = __builtin_bit_cast(float, __builtin_amdgcn_ds_bpermute((((ln >> 4) * 4 + i) << 2), __builtin_bit_cast(int, rstd)));
            const float lgt = acc[i] * rs + cbias;
            float mx = lgt; mx = fmaxf(mx, shx(mx, 1, ln)); mx = fmaxf(mx, shx(mx, 2, ln)); mx = fmaxf(mx, shx(mx, 4, ln)); mx = fmaxf(mx, shx(mx, 8, ln));
            const float ex = __expf(lgt - mx);
            float den = ex; den += shx(den, 1, ln); den += shx(den, 2, ln); den += shx(den, 4, ln); den += shx(den, 8, ln);
            af[i] = ex / den;
        }
        *(f32x4*)(AFFT + (size_t)row * NROW + r0 + 4 * kg) = af;
        unsigned char* ho = XN8 + (size_t)r0 * DM;
#pragma unroll
        for (int q = 0; q < 8; ++q)
#pragma unroll
            for (int c = 0; c < 4; ++c) asm volatile("" : "+v"(xq[q][c]));
        unsigned go = (unsigned)(32 * (ln >> 4));
#pragma unroll
        for (int q = 0; q < 8; ++q) {
            v4u o0, o1;
#pragma unroll
            for (int c = 0; c < 4; ++c) {
                const f32x4 g0 = *(const LAS f32x4*)(GS + go + 128 * q + 8 * c), g1 = *(const LAS f32x4*)(GS + go + 128 * q + 8 * c + 4);
                const f32x4 s0 = *(const LAS f32x4*)(SH + go + 128 * q + 8 * c), s1 = *(const LAS f32x4*)(SH + go + 128 * q + 8 * c + 4);
                const v4u xx = xq[q][c];
                const float h0 = __uint_as_float(xx.x << 16) * rstd * g0.x + s0.x, h1 = __uint_as_float(xx.x & 0xffff0000u) * rstd * g0.y + s0.y;
                const float h2 = __uint_as_float(xx.y << 16) * rstd * g0.z + s0.z, h3 = __uint_as_float(xx.y & 0xffff0000u) * rstd * g0.w + s0.w;
                const float h4 = __uint_as_float(xx.z << 16) * rstd * g1.x + s1.x, h5 = __uint_as_float(xx.z & 0xffff0000u) * rstd * g1.y + s1.y;
                const float h6 = __uint_as_float(xx.w << 16) * rstd * g1.z + s1.z, h7 = __uint_as_float(xx.w & 0xffff0000u) * rstd * g1.w + s1.w;
                const unsigned p0 = pk4f8(h0, h1, h2, h3), p1 = pk4f8(h4, h5, h6, h7);
                if (c == 0) { o0.x = p0; o0.y = p1; } else if (c == 1) { o0.z = p0; o0.w = p1; } else if (c == 2) { o1.x = p0; o1.y = p1; } else { o1.z = p0; o1.w = p1; }
            }
            *(v4u*)(ho + xo + 128 * q) = o0; *(v4u*)(ho + xo + 128 * q + 16) = o1;
        }
        t += 8;
        if (t < t1) { const bf16* xt = X1 + (size_t)(rbase + 16 * t) * DM;
#pragma unroll
            for (int q = 0; q < 8; ++q)
#pragma unroll
                for (int c = 0; c < 4; ++c) xq[q][c] = __builtin_nontemporal_load((const v4u*)(xt + xo + 128 * q + 8 * c)); }
    }
    __syncthreads();
}

DI int block_exscan_i(int v, LAS int* wt  , int wave, int lane, int& tot) {
    int x = v;
#pragma unroll
    for (int o = 1; o < 64; o <<= 1) { const int y = __builtin_amdgcn_ds_bpermute(((lane - o) & 63) << 2, x); if (lane >= o) x += y; }
    __syncthreads();
    if (lane == 63) wt[wave] = x;
    __syncthreads();
    int base = 0; tot = 0;
#pragma unroll
    for (int w = 0; w < 8; ++w) { const int t = wt[w]; tot += t; if (w < wave) base += t; }
    return base + x - v;
}

DI void ph_select(const Ctx& C, const Params& p, int nsets, int RPE) {
    const float* AFFT = (const float*)(p.ws + WS_AFFT); int* SLOT = (int*)(p.ws + WS_SLOT); int* IDX = (int*)(p.ws + WS_IDX); float* GATEV = (float*)(p.ws + WS_GATEV);
    LAS int* red = (LAS int*)C.lds; LAS int* wt = (LAS int*)(C.lds + 256);
    { const int nvalid = nsets == 4 ? 2112 : 2048, npad = RPE - nvalid;
      for (int i = C.vcu * NTHR + C.tid; i < NEXP * npad; i += C.G * NTHR) { const int e = i / npad, j = i % npad; IDX[e * RPE + nvalid + j] = 0; GATEV[e * RPE + nvalid + j] = 0.f; } }
    for (int task = C.vcu; task < nsets * NEXP; task += C.G) {
        const int set = task >> 4, e = task & 15;
        const int n = set < 2 ? SEQ : LC, cap = set < 2 ? 1024 : 32;
        const int rowbase = set < 2 ? set * SEQ : NLAT + (set - 2) * LC;
        const int slotbase = set < 2 ? set * 1024 : 2048 + (set - 2) * 32;
        unsigned key[16];
        const int tok0 = C.tid * 16;
#pragma unroll
        for (int q = 0; q < 4; ++q) { v4u kv = (v4u){0u, 0u, 0u, 0u}; if (tok0 + 4 * q < n) kv = *(const v4u*)(AFFT + (size_t)e * NROW + rowbase + tok0 + 4 * q); key[4 * q] = kv.x; key[4 * q + 1] = kv.y; key[4 * q + 2] = kv.z; key[4 * q + 3] = kv.w; }
        unsigned prefix = 0u;
        __syncthreads();
        for (int bit = 30; bit >= 0; --bit) {
            const unsigned cand = prefix | (1u << bit); int cnt = 0;
#pragma unroll
            for (int i = 0; i < 16; ++i) cnt += __popcll(__ballot(key[i] >= cand));
            if (C.lane == 0) red[(bit & 1) * 8 + C.wave] = cnt;
            __syncthreads();
            int total = 0;
#pragma unroll
            for (int w = 0; w < 8; ++w) total += red[(bit & 1) * 8 + w];
            if (total >= cap) prefix = cand;
        }
        const unsigned T = prefix;
        int gtc = 0, eqc = 0;
#pragma unroll
        for (int i = 0; i < 16; ++i) { gtc += (key[i] > T) ? 1 : 0; eqc += (key[i] == T) ? 1 : 0; }
        int totgt, toteq;
        (void)block_exscan_i(gtc, wt, C.wave, C.lane, totgt);
        int eqrank = block_exscan_i(eqc, wt, C.wave, C.lane, toteq);
        const int need_eq = cap - totgt;
        unsigned selmask = 0u; int selc = 0;
#pragma unroll
        for (int i = 0; i < 16; ++i) { bool s = key[i] > T; if (key[i] == T) { s = eqrank < need_eq; ++eqrank; } if (s) { selmask |= 1u << i; ++selc; } }
        int totsel;
        int slot = block_exscan_i(selc, wt, C.wave, C.lane, totsel);
#pragma unroll
        for (int i = 0; i < 16; ++i) { const int tok = tok0 + i;
            if (tok < n) { const int row = rowbase + tok;
                if (selmask & (1u << i)) { const int sp = slotbase + slot; SLOT[(size_t)row * 16 + e] = sp; IDX[e * RPE + sp] = row; GATEV[e * RPE + sp] = __uint_as_float(key[i]); ++slot; }
                else SLOT[(size_t)row * 16 + e] = -1; } }
        __syncthreads();
    }
}

DI void ph_combine(const Ctx& C, const Params& p, int l, int nrows, int RPE) {
    const float* MOD = (const float*)(p.ws + WS_MOD); const bf16* X1 = (const bf16*)(p.ws + WS_X1); const int* SLOT = (const int*)(p.ws + WS_SLOT); const bf16* Y = (const bf16*)(p.ws + WS_XS);
    bf16* X2 = (bf16*)(p.ws + WS_X2); bf16* XN = (bf16*)(p.ws + WS_XN);
    int svn[2]; f32x4 vn[2][4];
    int rrn[2]; bool dupn; bool more = trip_rows(C, nrows, 0, rrn, dupn);
    if (more) {
#pragma unroll
        for (int q = 0; q < 2; ++q) { const int r = rrn[q]; svn[q] = (C.lane < 16) ? SLOT[(size_t)r * 16 + C.lane] : -1; load_row_h(X1 + (size_t)r * DM, C.lane, vn[q]); } }
    for (int t = 0; more; ++t) {
        int rr[2] = {rrn[0], rrn[1]};
        int sv[2]; f32x4 v[2][4], acc[2][4];
#pragma unroll
        for (int q = 0; q < 2; ++q) { sv[q] = svn[q];
#pragma unroll
            for (int j = 0; j < 4; ++j) v[q][j] = vn[q][j]; }
        { more = trip_rows(C, nrows, t + 1, rrn, dupn);
          if (more) {
#pragma unroll
            for (int q = 0; q < 2; ++q) { const int r = rrn[q]; svn[q] = (C.lane < 16) ? SLOT[(size_t)r * 16 + C.lane] : -1; load_row_h(X1 + (size_t)r * DM, C.lane, vn[q]); } } }
        unsigned msk[2]; const v2u* yp[2][4]; float fw[2][4];
#pragma unroll
        for (int q = 0; q < 2; ++q) { msk[q] = (unsigned)__ballot(sv[q] >= 0);
#pragma unroll
            for (int k = 0; k < 4; ++k) { const bool has = msk[q] != 0u; const int e = has ? __builtin_amdgcn_readfirstlane(__builtin_ctz(msk[q])) : 0; const int sl = __builtin_amdgcn_readlane(sv[q], e);
                yp[q][k] = has ? (const v2u*)(Y + ((size_t)e * RPE + sl) * DM) : (const v2u*)Y; fw[q][k] = has ? 1.0f : 0.0f; if (has) msk[q] &= msk[q] - 1; } }
        v2u w[2][4][4];
#pragma unroll
        for (int q = 0; q < 2; ++q)
#pragma unroll
            for (int k = 0; k < 4; ++k)
#pragma unroll
                for (int j = 0; j < 4; ++j) w[q][k][j] = __builtin_nontemporal_load(yp[q][k] + C.lane + 64 * j);
#pragma unroll
        for (int q = 0; q < 2; ++q)
#pragma unroll
            for (int j = 0; j < 4; ++j) { f32x4 a = (f32x4){0.f, 0.f, 0.f, 0.f};
#pragma unroll
                for (int k = 0; k < 4; ++k) { const float f = fw[q][k]; const v2u ww = w[q][k][j];
                    a.x += f * __uint_as_float(ww.x << 16); a.y += f * __uint_as_float(ww.x & 0xffff0000u); a.z += f * __uint_as_float(ww.y << 16); a.w += f * __uint_as_float(ww.y & 0xffff0000u); }
                acc[q][j] = a; }
#pragma unroll
        for (int q = 0; q < 2; ++q)
            while (msk[q]) { const int e = __builtin_amdgcn_readfirstlane(__builtin_ctz(msk[q])); msk[q] &= msk[q] - 1; const int sl = __builtin_amdgcn_readlane(sv[q], e);
                const v2u* y0 = (const v2u*)(Y + ((size_t)e * RPE + sl) * DM);
#pragma unroll
                for (int j = 0; j < 4; ++j) { const v2u ww = __builtin_nontemporal_load(y0 + C.lane + 64 * j);
                    acc[q][j].x += __uint_as_float(ww.x << 16); acc[q][j].y += __uint_as_float(ww.x & 0xffff0000u); acc[q][j].z += __uint_as_float(ww.y << 16); acc[q][j].w += __uint_as_float(ww.y & 0xffff0000u); } }
#pragma unroll
        for (int q = 0; q < 2; ++q) { const int r = rr[q]; const int mi = r < NLAT ? (r >> 13) : 2;
            const float* g2 = MOD + (size_t)(l * 3 + mi) * 6144 + 5 * 1024;
#pragma unroll
            for (int j = 0; j < 4; ++j) v[q][j] = v[q][j] + ((const f32x4*)g2)[C.lane + 64 * j] * acc[q][j];
            if (l == 0) {
#pragma unroll
                for (int j = 0; j < 4; ++j) { v2u w; w.x = cvtpk(v[q][j].x, v[q][j].y); w.y = cvtpk(v[q][j].z, v[q][j].w); __builtin_nontemporal_store(w, (v2u*)(X2 + (size_t)r * DM) + C.lane + 64 * j); }
                const float* mp = MOD + (size_t)(1 * 3 + mi) * 6144;
                modulate_row<true>(v[q], p.in[6] + 1024, mp, mp + 1024, (bf16*)((unsigned char*)XN + (size_t)r * DM), C.lane);
            } else {
                const float rstd = row_rstd(v[q], 1e-6f, C.lane);
#pragma unroll
                for (int j = 0; j < 4; ++j) __builtin_nontemporal_store(v[q][j] * rstd * ((const f32x4*)p.in[8])[C.lane + 64 * j], (f32x4*)(p.out + (size_t)r * DM) + C.lane + 64 * j);
            }
        }
    }
}

constexpr int RT = 128;
constexpr int TP = 136;
DI float ret_lg2(const float* e, int hh) { return log1pf(-exp2f(-e[hh])) * LOG2E; }

DI void ph_ret_chunk_states(const Ctx& C, const Params& p) {
    const bf16* P = (const bf16*)(p.ws + WS_P); float* SCH = (float*)(p.ws + WS_SCH);
    constexpr int TP2 = 264;
    LAS bf16* Ktf = (LAS bf16*)C.lds; LAS bf16* Ktb = Ktf + 64 * TP2; LAS bf16* Vt = Ktb + 64 * TP2;
    const int r32 = C.lane & 31, hi = C.lane >> 5;
    for (int u = C.vcu; u < 2 * 4 * 33 * 2; u += C.G) {
        const int vh = u & 1, rest = u >> 1, cc = rest % 33, hh = (rest / 33) & 3, b = rest / 132;
        const size_t row0 = cc < 32 ? (size_t)b * SEQ + cc * 256 : (size_t)NLAT + b * LC;
        const float lgf = ret_lg2(p.in[17], hh), lgb = ret_lg2(p.in[18], hh);
        v4u kv4[4], vv4[4];
        const int pp = C.tid & 255, dq = C.tid >> 8;
        const bf16* pr = P + (row0 + pp) * 2304;
#pragma unroll
        for (int k = 0; k < 4; ++k) kv4[k] = *(const v4u*)(pr + 256 + hh * 64 + (dq + 2 * k) * 8);
#pragma unroll
        for (int k = 0; k < 4; ++k) vv4[k] = *(const v4u*)(pr + 512 + hh * 128 + vh * 64 + (dq + 2 * k) * 8);
        const float wf = exp2f(lgf * (float)(255 - pp)), wb = exp2f(lgb * (float)pp);
#pragma unroll
        for (int k = 0; k < 4; ++k) { const int d0 = (dq + 2 * k) * 8; const v4u kv = kv4[k];
#pragma unroll
            for (int i = 0; i < 4; ++i) { const float k0 = __uint_as_float(kv[i] << 16), k1 = __uint_as_float(kv[i] & 0xffff0000u);
                Ktf[(d0 + 2 * i) * TP2 + pp] = f2bf(k0 * wf); Ktf[(d0 + 2 * i + 1) * TP2 + pp] = f2bf(k1 * wf); Ktb[(d0 + 2 * i) * TP2 + pp] = f2bf(k0 * wb); Ktb[(d0 + 2 * i + 1) * TP2 + pp] = f2bf(k1 * wb); } }
#pragma unroll
        for (int k = 0; k < 4; ++k) { const int v0 = (dq + 2 * k) * 8; const v4u vv = vv4[k];
#pragma unroll
            for (int i = 0; i < 4; ++i) { Vt[(v0 + 2 * i) * TP2 + pp] = (bf16)(vv[i] & 0xffffu); Vt[(v0 + 2 * i + 1) * TP2 + pp] = (bf16)(vv[i] >> 16); } }
        __syncthreads();
        const int db = C.wave & 1, vb = (C.wave >> 1) & 1, dir = C.wave >> 2;
        const LAS bf16* Kt = dir == 0 ? Ktf : Ktb;
        f32x16 sa;
#pragma unroll
        for (int i = 0; i < 16; ++i) sa[i] = 0.f;
#pragma unroll
        for (int ks = 0; ks < 16; ++ks) {
            const bf16x8 ak = *(const LAS bf16x8*)(Kt + (32 * db + r32) * TP2 + 16 * ks + 8 * hi);
            const bf16x8 bv = *(const LAS bf16x8*)(Vt + (32 * vb + r32) * TP2 + 16 * ks + 8 * hi);
            sa = MFMA32(ak, bv, sa);
        }
        float* os = SCH + ((((size_t)dir * 2 + b) * 4 + hh) * 33 + cc) * 8192;
#pragma unroll
        for (int i = 0; i < 16; ++i) { const int d = 32 * db + crow(i, hi); os[d * 128 + vh * 64 + 32 * vb + r32] = sa[i]; }
        __syncthreads();
    }
}

DI void ph_ret_scan(const Ctx& C, const Params& p) {
    const float* SCH = (const float*)(p.ws + WS_SCH); float* RST = (float*)(p.ws + WS_RST);
    for (int i = C.vcu * NTHR + C.tid; i < 2 * 2 * 4 * 8192; i += C.G * NTHR) {
        const int el = i & 8191, hh = (i >> 13) & 3, b = (i >> 15) & 1, dir = i >> 16;
        const float g256 = exp2f(ret_lg2(dir == 0 ? p.in[17] : p.in[18], hh) * 256.0f);
        const float* S = SCH + (((size_t)dir * 2 + b) * 4 + hh) * 33 * 8192 + el;
        float* R = RST + (((size_t)dir * 2 + b) * 4 + hh) * 32 * 8192 + el;
        const long step = dir == 0 ? 8192 : -8192;
        const float* Sp = S + (dir == 0 ? 0 : (size_t)31 * 8192); float* Rp = R + (dir == 0 ? 0 : (size_t)31 * 8192);
        float st = __builtin_nontemporal_load(S + 32 * 8192);
#pragma unroll 1
        for (int c0 = 0; c0 < 32; c0 += 16) {
            float sv[16];
#pragma unroll
            for (int j = 0; j < 16; ++j) sv[j] = __builtin_nontemporal_load(Sp + j * step);
#pragma unroll
            for (int j = 0; j < 16; ++j) { Rp[j * step] = st; st = st * g256 + sv[j]; }
            Sp += 16 * step; Rp += 16 * step;
        }
    }
}

DI void ph_ret_output(const Ctx& C, const Params& p) {
    const bf16* P = (const bf16*)(p.ws + WS_P); const float* RST = (const float*)(p.ws + WS_RST); bf16* CAT = (bf16*)(p.ws + WS_CAT);
    constexpr int T2 = 256, KP = 72, VP = 260;
    LAS bf16* Ks = (LAS bf16*)C.lds;
    LAS bf16* Vt = Ks + T2 * KP;
    LAS bf16* Rtf = Vt + 128 * VP;
    LAS bf16* Rtb = Rtf + 128 * 72;
    const int r32 = C.lane & 31, hi = C.lane >> 5;
    const float* gn = p.in[19];
    for (int u = C.vcu; u < 2 * 4 * 32; u += C.G) {
        const int c2 = u & 31, hh = (u >> 5) & 3, b = u >> 7;
        const size_t row0 = (size_t)b * SEQ + c2 * T2;
        const float lgf = ret_lg2(p.in[17], hh), lgb = ret_lg2(p.in[18], hh);
        const float* Rf = RST + ((((size_t)0 * 2 + b) * 4 + hh) * 32 + c2) * 8192; const float* Rb = RST + ((((size_t)1 * 2 + b) * 4 + hh) * 32 + c2) * 8192;
        const int pl = 32 * C.wave + r32;
        const bf16* Pu = P + row0 * 2304 + hh * 64;
        unsigned tq = (unsigned)C.tid; asm volatile("" : "+v"(tq));
        unsigned gK = (tq >> 3) * 2304u + 256u + (tq & 7u) * 8u;            asm volatile("" : "+v"(gK));
        unsigned gV = (tq & 255u) * 2304u + 512u + (tq >> 8) * 8u;          asm volatile("" : "+v"(gV));
        unsigned gR = (tq & 63u) * 128u + (tq >> 6) * 4u;                   asm volatile("" : "+v"(gR));
        unsigned gQ = (unsigned)pl * 2304u + 8u * (unsigned)hi;             asm volatile("" : "+v"(gQ));
        unsigned lK = (tq >> 3) * (unsigned)KP + (tq & 7u) * 8u;            asm volatile("" : "+v"(lK));
        unsigned lV = (tq >> 8) * 8u * (unsigned)VP + (tq & 255u);          asm volatile("" : "+v"(lV));
        unsigned lR = (tq >> 6) * 4u * 72u + (tq & 63u);                    asm volatile("" : "+v"(lR));
        v4u kk4[4], vv8[8]; f32x4 ra[4], rb4[4]; bf16x8 qf[4];
#pragma unroll
        for (int k = 0; k < 4; ++k) kk4[k] = *(const v4u*)((Pu + (size_t)k * 64 * 2304) + gK);
        { const bf16* Pv = Pu + hh * 64;
#pragma unroll
          for (int k = 0; k < 8; ++k) vv8[k] = *(const v4u*)(Pv + gV + 16 * k); }
#pragma unroll
        for (int k = 0; k < 4; ++k) { ra[k] = *(const f32x4*)(Rf + gR + 32 * k); rb4[k] = *(const f32x4*)(Rb + gR + 32 * k); }
#pragma unroll
        for (int d0 = 0; d0 < 4; ++d0) qf[d0] = *(const bf16x8*)(Pu + gQ + 16 * d0);
#pragma unroll
        for (int k = 0; k < 4; ++k) *(LAS v4u*)(Ks + lK + 64 * k * KP) = kk4[k];
#pragma unroll
        for (int k = 0; k < 8; ++k) { const v4u vv = vv8[k];
#pragma unroll
            for (int i = 0; i < 4; ++i) { Vt[lV + (16 * k + 2 * i) * VP] = (bf16)(vv[i] & 0xffffu); Vt[lV + (16 * k + 2 * i + 1) * VP] = (bf16)(vv[i] >> 16); } }
#pragma unroll
        for (int k = 0; k < 4; ++k) {
#pragma unroll
            for (int i = 0; i < 4; ++i) { Rtf[lR + (32 * k + i) * 72] = f2bf(ra[k][i]); Rtb[lR + (32 * k + i) * 72] = f2bf(rb4[k][i]); } }
        __syncthreads();
        unsigned lKr = (unsigned)(r32 * KP + 8 * hi);  asm volatile("" : "+v"(lKr));
        unsigned lVr = (unsigned)(r32 * VP + 4 * hi);  asm volatile("" : "+v"(lVr));
        unsigned lRr = (unsigned)(r32 * 72 + 8 * hi);  asm volatile("" : "+v"(lRr));
        f32x16 o[4];
#pragma unroll
        for (int vb = 0; vb < 4; ++vb)
#pragma unroll
            for (int i = 0; i < 16; ++i) o[vb][i] = 0.f;
        const float gf1 = __builtin_amdgcn_exp2f(-lgf), gf8 = __builtin_amdgcn_exp2f(-8.0f * lgf), hf = __builtin_amdgcn_exp2f(-lgf * (float)(4 * hi));
        const float gb1 = __builtin_amdgcn_exp2f(lgb), gb8 = __builtin_amdgcn_exp2f(8.0f * lgb), hb = __builtin_amdgcn_exp2f(lgb * (float)(4 * hi));
#pragma unroll 1
        for (int sb = 0; sb < 8; ++sb) {
            bf16x8 kf[4];
#pragma unroll
            for (int d0 = 0; d0 < 4; ++d0) kf[d0] = *(const LAS bf16x8*)(Ks + lKr + 32 * sb * KP + 16 * d0);
            f32x16 st;
#pragma unroll
            for (int i = 0; i < 16; ++i) st[i] = 0.f;
#pragma unroll
            for (int d0 = 0; d0 < 4; ++d0) st = MFMA32(kf[d0], qf[d0], st);
            {
                const float af = __builtin_amdgcn_exp2f(lgf * (float)(pl - 32 * sb)) * hf, ab = __builtin_amdgcn_exp2f(lgb * (float)(32 * sb - pl)) * hb;
                const int dq0 = pl - 32 * sb - 4 * hi;
                float fm = af, bm = ab;
#pragma unroll
                for (int m = 0; m < 4; ++m) {
                    float fj = fm, bj = bm;
#pragma unroll
                    for (int j = 0; j < 4; ++j) { st[4 * m + j] *= (dq0 - (j + 8 * m) >= 0) ? fj : bj; fj *= gf1; bj *= gb1; }
                    fm *= gf8; bm *= gb8; }
            }
#pragma unroll
            for (int ks = 0; ks < 2; ++ks) {
                v4u pw; pw.x = cvtpk(st[8 * ks + 0], st[8 * ks + 1]); pw.y = cvtpk(st[8 * ks + 2], st[8 * ks + 3]); pw.z = cvtpk(st[8 * ks + 4], st[8 * ks + 5]); pw.w = cvtpk(st[8 * ks + 6], st[8 * ks + 7]);
                const bf16x8 pa = __builtin_bit_cast(bf16x8, pw);
                const int s0 = 32 * sb + 16 * ks;
#pragma unroll
                for (int vb = 0; vb < 4; ++vb) { const LAS bf16* vp = Vt + lVr + s0 + 32 * vb * VP; const v2u lo = *(const LAS v2u*)vp, hh2 = *(const LAS v2u*)(vp + 8);
                    v4u vw; vw.x = lo.x; vw.y = lo.y; vw.z = hh2.x; vw.w = hh2.y; o[vb] = MFMA32(pa, __builtin_bit_cast(bf16x8, vw), o[vb]); }
            }
        }
        {
            const float xf = exp2f(lgf * (float)(pl + 1)), xb = exp2f(lgb * (float)(T2 - pl));
#pragma unroll
            for (int d0 = 0; d0 < 4; ++d0) {
                const v4u qw = __builtin_bit_cast(v4u, qf[d0]); v4u af, ab;
#pragma unroll
                for (int i = 0; i < 4; ++i) { const float q0 = __uint_as_float(qw[i] << 16), q1 = __uint_as_float(qw[i] & 0xffff0000u); af[i] = cvtpk(q0 * xf, q1 * xf); ab[i] = cvtpk(q0 * xb, q1 * xb); }
                const bf16x8 aF = __builtin_bit_cast(bf16x8, af), aB = __builtin_bit_cast(bf16x8, ab);
#pragma unroll
                for (int vb = 0; vb < 4; ++vb) { const bf16x8 rf = *(const LAS bf16x8*)(Rtf + lRr + 32 * vb * 72 + 16 * d0); const bf16x8 rb = *(const LAS bf16x8*)(Rtb + lRr + 32 * vb * 72 + 16 * d0);
                    o[vb] = MFMA32(aF, rf, o[vb]); o[vb] = MFMA32(aB, rb, o[vb]); }
            }
        }
        {
            int ln2 = C.lane; asm volatile("" : "+v"(ln2));
            const int r32 = ln2 & 31, hi = ln2 >> 5;
            float gnv[4];
#pragma unroll
            for (int vb = 0; vb < 4; ++vb) gnv[vb] = gn[hh * 128 + 32 * vb + r32];
            unsigned gpk[32];
            { const bf16* gu = P + row0 * 2304 + 1024 + hh * 128; unsigned gl = (unsigned)((32 * C.wave + 4 * hi) * 2304 + r32); asm volatile("" : "+v"(gl));
#pragma unroll
              for (int i = 0; i < 16; ++i) { const bf16* gp = (gu + ((i & 3) + 8 * (i >> 2)) * 2304) + gl; gpk[2 * i] = (unsigned)gp[0] | ((unsigned)gp[32] << 16); gpk[2 * i + 1] = (unsigned)gp[64] | ((unsigned)gp[96] << 16); } }
            float mu[16], var[16];
            unsigned ol = (unsigned)((32 * C.wave + 4 * hi) * 1024 + r32); asm volatile("" : "+v"(ol));
#pragma unroll
            for (int i = 0; i < 16; ++i) mu[i] = (o[0][i] + o[1][i]) + (o[2][i] + o[3][i]);
#pragma unroll
            for (int ofs = 1; ofs < 32; ofs <<= 1) {
#pragma unroll
                for (int i = 0; i < 16; ++i) mu[i] += shx(mu[i], ofs, C.lane); }
#pragma unroll
            for (int i = 0; i < 16; ++i) { mu[i] *= (1.0f / 128.0f); float a = 0.f;
#pragma unroll
                for (int vb = 0; vb < 4; ++vb) { o[vb][i] -= mu[i]; a += o[vb][i] * o[vb][i]; }
                var[i] = a; }
#pragma unroll
            for (int ofs = 1; ofs < 32; ofs <<= 1) {
#pragma unroll
                for (int i = 0; i < 16; ++i) var[i] += shx(var[i], ofs, C.lane); }
#pragma unroll
            for (int i = 0; i < 16; ++i) { const float rs = rsqrtf(var[i] * (1.0f / 128.0f) + 1e-5f);
                bf16* op = (CAT + row0 * 1024 + hh * 128 + ((i & 3) + 8 * (i >> 2)) * 1024) + ol;
#pragma unroll
                for (int vb = 0; vb < 4; ++vb) { const unsigned gw2 = gpk[2 * i + (vb >> 1)]; const float g = (vb & 1) ? __uint_as_float(gw2 & 0xffff0000u) : __uint_as_float(gw2 << 16);
                    op[32 * vb] = f2bf(o[vb][i] * rs * gnv[vb] * (g / (1.f + __expf(-g)))); } }
        }
        __syncthreads();
    }
}

typedef __attribute__((address_space(1))) unsigned gu32;
#define XB_TMO      128
#define XB_XCNT(j)  (256  + 64 * (j))
#define XB_XSUB(j)  (1280 + 64 * (j))
#define XB_XGEN(j)  (2304 + 64 * (j))
#define XB_TOP      3328
#define XB_TOPGEN   3392
#define XCD_BAR_WORDS 3456
#define XB_SPIN_CAP (1u << 18)

__device__ __forceinline__ unsigned xb_ld(unsigned* p)              { return __hip_atomic_load(p, __ATOMIC_RELAXED, __HIP_MEMORY_SCOPE_AGENT); }
__device__ __forceinline__ unsigned xb_add(unsigned* p, unsigned v) { return __hip_atomic_fetch_add(p, v, __ATOMIC_RELAXED, __HIP_MEMORY_SCOPE_AGENT); }
__device__ __forceinline__ unsigned xb_xcc_id() { return (unsigned)__builtin_amdgcn_s_getreg((3 << 11) | 20) & 0xFu; }
#define XB_SPIN(cond, bar) do { unsigned _sp = 0; while (cond) { __builtin_amdgcn_s_sleep(1); \
    if ((++_sp & 255u) == 0u) { if (xb_ld(&(bar)[XB_TMO])) break; if (_sp > XB_SPIN_CAP) { atomicAdd(&(bar)[XB_TMO], 1u); break; } } } } while (0)

struct XcdBarrier {
    unsigned* bar; unsigned x;
    volatile LAS unsigned* st;
};

__device__ __forceinline__ XcdBarrier xcd_barrier_post(unsigned* bar, volatile LAS unsigned* st) {
    XcdBarrier b; b.bar = bar; b.x = xb_xcc_id(); b.st = st;
    if (threadIdx.x == 0) (void)xb_add(&bar[XB_XCNT(b.x)], 1u);
    return b;
}
__device__ __forceinline__ void xcd_barrier_complete(unsigned* bar, unsigned x, unsigned& nloc, unsigned& nx) {
    const unsigned G = gridDim.x * gridDim.y * gridDim.z;
    unsigned sum, cnt, mine, sp = 0u;
    for (;;) {
        sum = 0u; cnt = 0u; mine = 0u;
#pragma unroll
        for (unsigned j = 0; j < 16; ++j) { const unsigned c = xb_ld(&bar[XB_XCNT(j)]); sum += c; cnt += (c > 0u) ? 1u : 0u; mine = (j == x) ? c : mine; }
        if (sum == G) break;
        __builtin_amdgcn_s_sleep(1);
        if ((++sp & 255u) == 0u) { if (xb_ld(&bar[XB_TMO])) break; if (sp > XB_SPIN_CAP) { atomicAdd(&bar[XB_TMO], 1u); break; } }
    }
    nloc = mine > 0u ? mine : 1u; nx = cnt > 0u ? cnt : 1u;
}

__device__ __forceinline__ void xcd_barrier(const XcdBarrier& b) {
    asm volatile("s_waitcnt vmcnt(0)" ::: "memory");
    __syncthreads();
    if (threadIdx.x == 0) {
        unsigned* bar = b.bar;
        __builtin_amdgcn_s_waitcnt(0);
        unsigned nloc = b.st[0], nx = b.st[1];
        if (nloc == 0u) { xcd_barrier_complete(bar, b.x, nloc, nx); b.st[0] = nloc; b.st[1] = nx; }
        const unsigned old = xb_add(&bar[XB_XSUB(b.x)], 1u);
        const unsigned gen = old / nloc;
        if (old + 1u == (gen + 1u) * nloc) {
            __builtin_amdgcn_fence(__ATOMIC_RELEASE, "agent");
            asm volatile("s_waitcnt vmcnt(0)" ::: "memory");
            const unsigned og = xb_add(&bar[XB_TOP], 1u);
            const unsigned target = (og / nx + 1u) * nx;
            if (og + 1u != target) XB_SPIN(xb_ld(&bar[XB_TOP]) < target, bar);
            __builtin_amdgcn_fence(__ATOMIC_ACQUIRE, "agent");
            xb_add(&bar[XB_XGEN(b.x)], 1u);
            asm volatile("s_waitcnt vmcnt(0)" ::: "memory");
        } else {
            XB_SPIN(xb_ld(&bar[XB_XGEN(b.x)]) == gen, bar);
            __builtin_amdgcn_fence(__ATOMIC_ACQUIRE, "agent");
            asm volatile("s_waitcnt vmcnt(0)" ::: "memory");
        }
    }
    __syncthreads();
}

__global__ void __launch_bounds__(NTHR, 2) fwd_megakernel(Params p_unused) {
    extern __shared__ __attribute__((aligned(16))) unsigned char lds_raw[];
    {
        volatile LAS unsigned* st = (volatile LAS unsigned*)((LAS unsigned char*)lds_raw + LDS_MISC);
        if (threadIdx.x < 8) st[threadIdx.x] = 0u;
        __syncthreads();
        KP kp0 = (KP)__builtin_amdgcn_kernarg_segment_ptr();
        (void)xcd_barrier_post((unsigned*)(kp0->ws + WS_CTL), st);
    }
#define GRID_SYNC() do { KP kpb = (KP)__builtin_amdgcn_kernarg_segment_ptr(); asm volatile("" : "+s"(kpb) :: "memory"); XcdBarrier bb; bb.bar = (unsigned*)(kpb->ws + WS_CTL); bb.x = xb_xcc_id(); \
        bb.st = (volatile LAS unsigned*)((LAS unsigned char*)lds_raw + LDS_MISC); xcd_barrier(bb); } while (0)
#define ENV() Params p; Ctx C; env(p, C, lds_raw); unsigned char* ws = p.ws; LAS unsigned char* ring = C.lds; (void)ws; (void)ring

    { ENV(); ph0_prologue(C, p); }
    GRID_SYNC();
    { ENV(); ph_modulate0(C, p); }
    GRID_SYNC();
    {
        ENV();
        pg8::Gemm g{(const pg8::bf16_t*)(ws + WS_XN), (const pg8::bf16_t*)(ws + WS_WABIN), NROW, 1280, 1024}; pg8::StaticOrder S; S.init(NROW, 1280, C.G, (int)blockIdx.x);
        pg8::EpiStoreBf16 E{(pg8::bf16_t*)(ws + WS_P), 1280, 0, nullptr, 1.0f};
        pg8::gemm_phase<pg8::EpiStoreBf16, pg8::StaticOrder, true, true>(ring, g, S, E);
    }
    { ENV(); convert_slot(C, p, 0, (int)blockIdx.x); }
    GRID_SYNC();
    { ENV(); ph_post0(C, p); }
    GRID_SYNC();
    { ENV(); ph_attn_dense(C, p, lds_raw); }
    GRID_SYNC();
    {
        ENV();
        pg8::Gemm g{(const pg8::bf16_t*)(ws + WS_CAT), (const pg8::bf16_t*)(ws + WS_WABOUT), NROW, 1024, 1024}; pg8::StaticOrder S; S.init(NROW, 1024, C.G, (int)blockIdx.x);
        pg8::EpiResid<false> E{p.in[0], p.in[2], (const float*)(ws + WS_MOD), 2, (pg8::bf16_t*)(ws + WS_X1)};
        pg8::gemm_phase<pg8::EpiResid<false>, pg8::StaticOrder, true, true>(ring, g, S, E);
    }
    { ENV(); convert_slot(C, p, 1, (int)blockIdx.x); }
    GRID_SYNC();
    { ENV(); ph_ffn_norm_router(C, p, 0, NROW); }
    GRID_SYNC();
    { ENV(); ph_select(C, p, 4, 2304); }
    { ENV(); convert_slot(C, p, 2, C.vcu); }
    GRID_SYNC();
    {
        ENV();
        pg8::Gemm g{(const pg8::bf16_t*)(ws + WS_XN), (const pg8::bf16_t*)(ws + WS_WGU), NEXP * 2304, NEXP * 4096, 512}; pg8::MoeOrder S; S.init(9, 16, NEXP, C.G, C.vcu);
        LAS unsigned* gtab = (LAS unsigned*)(C.lds + 131072);
        { const int* IDX = (const int*)(ws + WS_IDX); pg8::Unit u; for (int i = 0; S.next(i, u); ++i) if (C.tid < 256) gtab[i * 256 + C.tid] = (unsigned)IDX[u.pm * 256 + C.tid] * 1024u; }
        __syncthreads();
        pg8::EpiSwiGLU8 E{(unsigned char*)(ws + WS_ACT), WINV};
        pg8::gemm_phase<pg8::EpiSwiGLU8, pg8::MoeOrder, true, true, true, true>(ring, g, S, E, gtab);
    }
    GRID_SYNC();
    {
        ENV();
        pg8::Gemm g{(const pg8::bf16_t*)(ws + WS_ACT), (const pg8::bf16_t*)(ws + WS_WD), NEXP * 2304, NEXP * 1024, 1024}; pg8::MoeOrder S; S.init(9, 4, NEXP, C.G, C.vcu);
        pg8::EpiDown E{(pg8::bf16_t*)(ws + WS_XS), (const float*)(ws + WS_GATEV), WINV};
        pg8::gemm_phase<pg8::EpiDown, pg8::MoeOrder, true, true, true>(ring, g, S, E);
    }
    { ENV(); convert_slot(C, p, 3, C.vcu); }
    GRID_SYNC();
    { ENV(); ph_combine(C, p, 0, NROW, 2304); }
    GRID_SYNC();
    {
        ENV();
        pg8::Gemm g{(const pg8::bf16_t*)(ws + WS_XN), (const pg8::bf16_t*)(ws + WS_WCDIN), NROW, 2304, 512}; pg8::StaticOrder S; S.init(NROW, 2304, C.G, (int)blockIdx.x);
        pg8::EpiStoreBf16 E{(pg8::bf16_t*)(ws + WS_P), 2304, 0, nullptr, WINV};
        pg8::gemm_phase<pg8::EpiStoreBf16, pg8::StaticOrder, true, true, true>(ring, g, S, E);
    }
    { ENV(); convert_slot(C, p, 4, (int)blockIdx.x); }
    GRID_SYNC();
    { ENV(); ph_post1(C, p); }
    GRID_SYNC();
    { ENV(); ph_ret_chunk_states(C, p); }
    GRID_SYNC();
    { ENV(); ph_ret_scan(C, p); }
    GRID_SYNC();
    { ENV(); ph_ret_output(C, p); }
    { ENV(); ph_attn_window(C, p, lds_raw); }
    GRID_SYNC();
    {
        ENV();
        pg8::Gemm g{(const pg8::bf16_t*)(ws + WS_CAT), (const pg8::bf16_t*)(ws + WS_WCDOUT), NLAT, 1024, 1024}; pg8::StaticOrder S; S.init(NLAT, 1024, C.G, (int)blockIdx.x);
        pg8::EpiResid<true> E{(const void*)(ws + WS_X2), (const void*)((const pg8::bf16_t*)(ws + WS_X2) + (size_t)NLAT * DM), (const float*)(ws + WS_MOD) + 3 * 6144, 2, (pg8::bf16_t*)(ws + WS_X1)};
        pg8::gemm_phase<pg8::EpiResid<true>, pg8::StaticOrder, true, true>(ring, g, S, E);
    }
    GRID_SYNC();
    { ENV(); ph_ffn_norm_router(C, p, 1, NLAT); }
    GRID_SYNC();
    { ENV(); ph_select(C, p, 2, 2048); }
    { ENV(); convert_slot(C, p, 5, C.vcu); }
    GRID_SYNC();
    {
        ENV();
        pg8::Gemm g{(const pg8::bf16_t*)(ws + WS_XN), (const pg8::bf16_t*)(ws + WS_WGU + (size_t)NEXP * 4096 * 1024), NEXP * 2048, NEXP * 4096, 512}; pg8::MoeOrder S; S.init(8, 16, NEXP, C.G, C.vcu);
        LAS unsigned* gtab = (LAS unsigned*)(C.lds + 131072);
        { const int* IDX = (const int*)(ws + WS_IDX); pg8::Unit u; for (int i = 0; S.next(i, u); ++i) if (C.tid < 256) gtab[i * 256 + C.tid] = (unsigned)IDX[u.pm * 256 + C.tid] * 1024u; }
        __syncthreads();
        pg8::EpiSwiGLU8 E{(unsigned char*)(ws + WS_ACT), WINV};
        pg8::gemm_phase<pg8::EpiSwiGLU8, pg8::MoeOrder, true, true, true, true>(ring, g, S, E, gtab);
    }
    GRID_SYNC();
    {
        ENV();
        pg8::Gemm g{(const pg8::bf16_t*)(ws + WS_ACT), (const pg8::bf16_t*)(ws + WS_WD + (size_t)NEXP * 1024 * 2048), NEXP * 2048, NEXP * 1024, 1024}; pg8::MoeOrder S; S.init(8, 4, NEXP, C.G, C.vcu);
        pg8::EpiDown E{(pg8::bf16_t*)(ws + WS_XS), (const float*)(ws + WS_GATEV), WINV};
        pg8::gemm_phase<pg8::EpiDown, pg8::MoeOrder, true, true, true>(ring, g, S, E);
    }
    GRID_SYNC();
    { ENV(); ph_combine(C, p, 1, NLAT, 2048); }
}

extern "C" void kernel_launch(void* const* d_in, const int* in_sizes, int n_in, void* d_out, int out_size, void* d_ws, size_t ws_size, hipStream_t stream) {
    static int grid = 0;
    if (grid == 0) {
        if (n_in != 25 || ws_size < WS_END) { fprintf(stderr, "kernel_launch: unexpected inputs (n_in %d, ws %zu)\n", n_in, ws_size); grid = -1; return; }
        int dev = 0, cus = 0, per_cu = 0;
        if (hipGetDevice(&dev) != hipSuccess || hipDeviceGetAttribute(&cus, hipDeviceAttributeMultiprocessorCount, dev) != hipSuccess) { grid = -1; return; }
        if (hipFuncSetAttribute((const void*)fwd_megakernel, hipFuncAttributeMaxDynamicSharedMemorySize, LDS_BYTES) != hipSuccess) { fprintf(stderr, "kernel_launch: hipFuncSetAttribute failed\n"); grid = -1; return; }
        if (hipOccupancyMaxActiveBlocksPerMultiprocessor(&per_cu, (const void*)fwd_megakernel, NTHR, LDS_BYTES) != hipSuccess || per_cu < 1) { fprintf(stderr, "kernel_launch: occupancy query says %d\n", per_cu); (void)hipGetLastError(); grid = -1; return; }
        grid = cus;
    }
    if (grid < 0) return;
    if (hipMemsetAsync((char*)d_ws + WS_CTL, 0, CTL_BYTES, stream) != hipSuccess) { fprintf(stderr, "kernel_launch: hipMemsetAsync failed\n"); return; }
    Params prm{};
    for (int i = 0; i < 25; ++i) prm.in[i] = (const float*)d_in[i];
    prm.out = (float*)d_out; prm.ws = (unsigned char*)d_ws; prm.pad = 0ull;
    void* args[] = {&prm};
    hipError_t e = hipLaunchCooperativeKernel((const void*)fwd_megakernel, dim3(grid), dim3(NTHR), args, LDS_BYTES, stream);
    if (e != hipSuccess) fprintf(stderr, "kernel_launch: cooperative launch failed: %s (grid %d)\n", hipGetErrorString(e), grid);
}
```
